# Optimizing an MI355X kernel written in HIP

```python
import math
import jax, jax.numpy as jnp
from jax import lax
import numpy as np

D_MODEL = 1024
BATCH = 8
SEQ = 4096
DEPTH = 1

MLA_HEADS = 8
QK_NOPE = 64
QK_ROPE = 32
V_HEAD = 64
Q_LORA = 256
KV_LORA = 128
ROPE_THETA = 10000.0
Q_BLOCK = 128
MLA_WIDTH = MLA_HEADS * V_HEAD
RWKV_HEADS = 8
RWKV_HEAD = 64
RWKV_WIDTH = RWKV_HEADS * RWKV_HEAD
DECAY_LORA = 64
A_LORA = 64
GATE_LORA = 128
GN_EPS = 64e-5
N_BRANCHES = 2
MIX_WIDTH = MLA_WIDTH + RWKV_WIDTH
FFN_HIDDEN = 2816
CONV_WIDTH = 3
NORM_EPS = 1e-6
MLA_COLS = Q_LORA + KV_LORA + QK_ROPE
RWKV_COLS = 3 * RWKV_WIDTH + A_LORA + 2 * DECAY_LORA + 2 * GATE_LORA
GATE_COLS = N_BRANCHES * D_MODEL
IN_COLS = MLA_COLS + RWKV_COLS + GATE_COLS

kernel_name = "hybrid_mla_rwkv7_gated_encoder"


def _split(t, sizes):
    out, start = [], 0
    for s in sizes:
        out.append(t[..., start:start + s])
        start += s
    return out


def rms_norm(t, g, eps=NORM_EPS):
    tf = t.astype(jnp.float32)
    y = tf * lax.rsqrt(jnp.mean(tf * tf, axis=-1, keepdims=True) + eps)
    return (y * g.astype(jnp.float32)).astype(t.dtype)


def rope(t, cos, sin):
    half = t.shape[-1] // 2
    t1, t2 = t[..., :half], t[..., half:]
    return jnp.concatenate([t1 * cos - t2 * sin, t2 * cos + t1 * sin], axis=-1)


def centered_shift(u, mu_prev, mu_next):
    zero = jnp.zeros_like(u[:, :1])
    prev = jnp.concatenate([zero, u[:, :-1]], axis=1)
    nxt = jnp.concatenate([u[:, 1:], zero], axis=1)
    return u + mu_prev * (prev - u) + mu_next * (nxt - u)


def dwconv_centered(u, w, b):
    up = jnp.pad(u, ((0, 0), (1, 1), (0, 0)))
    return up[:, :-2] * w[0] + up[:, 1:-1] * w[1] + up[:, 2:] * w[2] + b


def blocked_mla_attention(q_nope, q_rope, k_nope, k_rope, v):
    B, S, H, _ = q_nope.shape
    nb = S // Q_BLOCK
    scale = 1.0 / math.sqrt(QK_NOPE + QK_ROPE)
    qn = jnp.moveaxis(q_nope.reshape(B, nb, Q_BLOCK, H, QK_NOPE), 1, 0)
    qr = jnp.moveaxis(q_rope.reshape(B, nb, Q_BLOCK, H, QK_ROPE), 1, 0)

    def one_block(args):
        qn_b, qr_b = args
        s = (jnp.einsum('bqhd,bkhd->bhqk', qn_b, k_nope)
             + jnp.einsum('bqhd,bkd->bhqk', qr_b, k_rope))
        p = jax.nn.softmax(s.astype(jnp.float32) * scale, axis=-1)
        return jnp.einsum('bhqk,bkhd->bqhd', p.astype(v.dtype), v)

    o = lax.map(one_block, (qn, qr))
    return jnp.moveaxis(o, 0, 1).reshape(B, S, H * V_HEAD)


def mla_branch(cols, cos, sin, q_a_norm_g, kv_a_norm_g, w_uq, w_ukv, qn_g, qr_g, kn_g, kr_g):
    B, S, _ = cols.shape
    c_q, c_kv, k_rope = _split(cols, [Q_LORA, KV_LORA, QK_ROPE])
    c_q = rms_norm(c_q, q_a_norm_g)
    c_kv = rms_norm(c_kv, kv_a_norm_g)
    q = (c_q @ w_uq).reshape(B, S, MLA_HEADS, QK_NOPE + QK_ROPE)
    kv = (c_kv @ w_ukv).reshape(B, S, MLA_HEADS, QK_NOPE + V_HEAD)
    q_nope, q_rope = q[..., :QK_NOPE], q[..., QK_NOPE:]
    k_nope, v = kv[..., :QK_NOPE], kv[..., QK_NOPE:]
    q_nope = rms_norm(q_nope, qn_g)
    k_nope = rms_norm(k_nope, kn_g)
    q_rope = rope(rms_norm(q_rope, qr_g), cos[:, :, None, :], sin[:, :, None, :])
    k_rope = rope(rms_norm(k_rope, kr_g), cos, sin)
    return blocked_mla_attention(q_nope, q_rope, k_nope, k_rope, v)


def wkv7_scan(r, w, k, v, a, b, reverse):
    B, S, H, N = r.shape
    xs = tuple(jnp.moveaxis(t.astype(jnp.float32), 1, 0) for t in (r, w, k, v, a, b))

    def step(state, inp):
        r_t, w_t, k_t, v_t, a_t, b_t = inp
        sa = jnp.einsum('bhvk,bhk->bhv', state, a_t)
        state = (state * w_t[:, :, None, :] + sa[..., None] * b_t[:, :, None, :]
                 + v_t[..., None] * k_t[:, :, None, :])
        return state, jnp.einsum('bhvk,bhk->bhv', state, r_t)

    s0 = jnp.zeros((B, H, N, N), jnp.float32)
    _, out = lax.scan(step, s0, xs, reverse=reverse)
    return jnp.moveaxis(out, 0, 1)


def head_group_norm(o, g, b):
    mu = jnp.mean(o, axis=-1, keepdims=True)
    var = jnp.mean(jnp.square(o - mu), axis=-1, keepdims=True)
    y = (o - mu) * lax.rsqrt(var + GN_EPS)
    return (y * g.astype(jnp.float32).reshape(RWKV_HEADS, RWKV_HEAD)
            + b.astype(jnp.float32).reshape(RWKV_HEADS, RWKV_HEAD))


def rwkv7_branch(cols, shift_mu, w0, w2, a0, a2, g2, k_k, k_a, r_k, ln_g, ln_b):
    B, S, _ = cols.shape
    u = centered_shift(cols, shift_mu[0], shift_mu[1])
    r, k, v, a_lo, dlo_f, dlo_b, glo_f, glo_b = _split(
        u, [RWKV_WIDTH, RWKV_WIDTH, RWKV_WIDTH, A_LORA, DECAY_LORA, DECAY_LORA, GATE_LORA, GATE_LORA])
    heads = lambda t: t.reshape(B, S, RWKV_HEADS, RWKV_HEAD)
    a = jax.nn.sigmoid(a0 + a_lo @ a2)
    kkf = heads(k * k_k).astype(jnp.float32)
    kk = kkf / jnp.maximum(jnp.sqrt(jnp.sum(kkf * kkf, axis=-1, keepdims=True)), 1e-12)
    k = k * (1.0 + (a - 1.0) * k_a)
    rh, kh, vh, ah = heads(r), heads(k), heads(v), heads(a)
    bonus = (jnp.sum(rh * kh * r_k, axis=-1, keepdims=True) * vh).astype(jnp.float32)
    b_vec = kk * ah.astype(jnp.float32)

    def direction(dlo, glo, w0_d, w2_d, g2_d, reverse):
        w = -jax.nn.softplus(-(w0_d + jnp.tanh(dlo) @ w2_d)) - 0.5
        decay = jnp.exp(-jnp.exp(w.astype(jnp.float32)))
        o = wkv7_scan(rh, heads(decay), kh, vh, -kk, b_vec, reverse)
        o = (head_group_norm(o, ln_g, ln_b) + bonus).reshape(B, S, RWKV_WIDTH)
        g = jax.nn.sigmoid(glo) @ g2_d
        return o.astype(cols.dtype) * g

    fwd = direction(dlo_f, glo_f, w0[0], w2[0], g2[0], False)
    bwd = direction(dlo_b, glo_b, w0[1], w2[1], g2[1], True)
    return fwd + bwd


def setup_inputs(seed: int = 0) -> dict:
    key = jax.random.key(seed)
    ks = iter(jax.random.split(key, 40))
    nrm = lambda shape, s: jax.random.normal(next(ks), shape, jnp.float32) * s
    gain = lambda shape: 1.0 + nrm(shape, 0.05)
    L, D = DEPTH, D_MODEL
    x = jax.random.normal(next(ks), (BATCH, SEQ, D), jnp.float32)
    offs = jax.random.randint(next(ks), (BATCH, 1), 0, 2048, dtype=jnp.int32)
    positions = offs + jnp.arange(SEQ, dtype=jnp.int32)[None, :]
    return {
        "x": x,
        "positions": positions,
        "norm_mix_g": gain((L, D)),
        "w_in": nrm((L, D, IN_COLS), D ** -0.5),
        "b_gate": nrm((L, N_BRANCHES, D), 0.1),
        "q_a_norm_g": gain((L, Q_LORA)),
        "kv_a_norm_g": gain((L, KV_LORA)),
        "w_uq": nrm((L, Q_LORA, MLA_HEADS * (QK_NOPE + QK_ROPE)), Q_LORA ** -0.5),
        "w_ukv": nrm((L, KV_LORA, MLA_HEADS * (QK_NOPE + V_HEAD)), KV_LORA ** -0.5),
        "qn_norm_g": gain((L, QK_NOPE)),
        "qr_norm_g": gain((L, QK_ROPE)),
        "kn_norm_g": gain((L, QK_NOPE)),
        "kr_norm_g": gain((L, QK_ROPE)),
        "shift_mu": jax.random.uniform(next(ks), (L, 2, RWKV_COLS), jnp.float32, 0.0, 0.5),
        "w0": jax.random.uniform(next(ks), (L, 2, RWKV_WIDTH), jnp.float32, -6.0, -1.0),
        "w2": nrm((L, 2, DECAY_LORA, RWKV_WIDTH), 0.1 * DECAY_LORA ** -0.5),
        "a0": nrm((L, RWKV_WIDTH), 0.1),
        "a2": nrm((L, A_LORA, RWKV_WIDTH), 0.5 * A_LORA ** -0.5),
        "g2": nrm((L, 2, GATE_LORA, RWKV_WIDTH), GATE_LORA ** -0.5),
        "k_k": 0.85 + nrm((L, RWKV_WIDTH), 0.05),
        "k_a": gain((L, RWKV_WIDTH)),
        "r_k": nrm((L, RWKV_HEADS, RWKV_HEAD), 0.1),
        "ln_x_g": gain((L, RWKV_WIDTH)),
        "ln_x_b": nrm((L, RWKV_WIDTH), 0.02),
        "w_o": nrm((L, MIX_WIDTH, D), MLA_WIDTH ** -0.5),
        "w_merge": nrm((L, D, D), D ** -0.5),
        "norm_ffn_g": gain((L, D)),
        "w_ffn_gate": nrm((L, D, FFN_HIDDEN), D ** -0.5),
        "w_ffn_up": nrm((L, D, FFN_HIDDEN), D ** -0.5),
        "ffn_conv_w": nrm((L, CONV_WIDTH, FFN_HIDDEN), CONV_WIDTH ** -0.5),
        "ffn_conv_b": nrm((L, FFN_HIDDEN), 0.02),
        "w_ffn_down": nrm((L, FFN_HIDDEN, D), FFN_HIDDEN ** -0.5),
    }


def reference(x, positions, norm_mix_g, w_in, b_gate, q_a_norm_g, kv_a_norm_g, w_uq, w_ukv,
              qn_norm_g, qr_norm_g, kn_norm_g, kr_norm_g, shift_mu, w0, w2, a0, a2, g2,
              k_k, k_a, r_k, ln_x_g, ln_x_b, w_o, w_merge, norm_ffn_g, w_ffn_gate, w_ffn_up,
              ffn_conv_w, ffn_conv_b, w_ffn_down):
    B, S, D = x.shape
    inv_freq = ROPE_THETA ** (-jnp.arange(0, QK_ROPE, 2, dtype=jnp.float32) / QK_ROPE)
    ang = positions.astype(jnp.float32)[..., None] * inv_freq
    cos, sin = jnp.cos(ang).astype(x.dtype), jnp.sin(ang).astype(x.dtype)

    for l in range(DEPTH):
        h = rms_norm(x, norm_mix_g[l])
        proj = h @ w_in[l]
        mla_cols, rw_cols, gate_cols = _split(proj, [MLA_COLS, RWKV_COLS, GATE_COLS])
        o_a = mla_branch(mla_cols, cos, sin, q_a_norm_g[l], kv_a_norm_g[l], w_uq[l], w_ukv[l],
                         qn_norm_g[l], qr_norm_g[l], kn_norm_g[l], kr_norm_g[l])
        o_b = rwkv7_branch(rw_cols, shift_mu[l], w0[l], w2[l], a0[l], a2[l], g2[l],
                           k_k[l], k_a[l], r_k[l], ln_x_g[l], ln_x_b[l])
        w_o_l = w_o[l]
        y_a = o_a @ w_o_l[:MLA_WIDTH]
        y_b = o_b @ w_o_l[MLA_WIDTH:]
        gates = jax.nn.sigmoid(gate_cols.reshape(B, S, N_BRANCHES, D) + b_gate[l])
        x = x + (gates[:, :, 0] * y_a + gates[:, :, 1] * y_b) @ w_merge[l]
        h = rms_norm(x, norm_ffn_g[l])
        gp = dwconv_centered(h @ w_ffn_gate[l], ffn_conv_w[l], ffn_conv_b[l])
        x = x + (jax.nn.silu(gp) * (h @ w_ffn_up[l])) @ w_ffn_down[l]
    return x
```

```cpp
#include <hip/hip_runtime.h>
#include <hip/hip_cooperative_groups.h>
#include <cstdio>
#include <cstdint>
namespace cg = cooperative_groups;
namespace pg8 {
#define PG8_LAS __attribute__((address_space(3)))
typedef unsigned short bf16_t;
typedef short bf16x8 __attribute__((ext_vector_type(8)));
typedef float f32x4 __attribute__((ext_vector_type(4)));
typedef unsigned u32x4 __attribute__((ext_vector_type(4)));
constexpr int BM = 256, BK = 64, HALF = 128, HTB = HALF * BK * 2  , STAGE_BYTES = 8 * HTB, NXCD = 8, WGM = 8;

__host__ __device__ __forceinline__ int lds_byte(int r, int c) { const int st = (r >> 4) * 2 + (c >> 5), rr = r & 15, cc = c & 31, ob = rr * 64 + cc * 2; return st * 1024 + (ob ^ (((ob >> 9) & 1) << 5)); }
__host__ __device__ __forceinline__ void stage_rc(int b, int& R, int& C) { const int st = b / 1024, sb = b % 1024, swz = sb ^ (((sb >> 9) & 1) << 5); R = (st >> 1) * 16 + swz / 64; C = (st & 1) * 32 + (swz % 64) / 2; }
__host__ __device__ __forceinline__ int perm32(int rho) { const int n = rho >> 4, i = rho & 15; return 8 * (i >> 2) + 4 * n + (i & 3); }

struct Unit { int pm, pn; };
struct Gemm { const bf16_t* A; const bf16_t* Bt; int M, N, K, lda, ldb; };

struct StaticOrder {
    int nM, nN, nwg, G, c;
    __host__ __device__ void init(int M, int N, int G_, int c_) { nM = M / BM; nN = N / BM; nwg = nM * nN; G = G_; c = c_; }
    __host__ __device__ bool next(int i, Unit& u) const {
        const long L = (long)i * G + c; if (L >= nwg) return false;
        int wgid = (int)L; { const int q = nwg / NXCD, r = nwg % NXCD, xcd = wgid % NXCD, off = wgid / NXCD; wgid = (xcd < r ? xcd * (q + 1) : r * (q + 1) + (xcd - r) * q) + off; }
        const int nig = WGM * nN, gid = wgid / nig, fm = gid * WGM, gsz = (nM - fm) < WGM ? (nM - fm) : WGM;
        u.pm = fm + ((wgid % nig) % gsz); u.pn = (wgid % nig) / gsz; return true;
    }
    __device__ __forceinline__ void a_ready(const Unit&) const {}
    __device__ __forceinline__ void done(const Unit&) const {}
};

__device__ __forceinline__ unsigned cvt_pk_bf16(float lo, float hi) { unsigned r; asm volatile("v_cvt_pk_bf16_f32 %0, %1, %2" : "=v"(r) : "v"(lo), "v"(hi)); return r; }
template <class Epi, class Sched, bool ALIGN_EPI = false, bool SP2 = false>
__device__ __forceinline__ void gemm_phase(PG8_LAS unsigned char* lds, const Gemm g, const Sched& S, const Epi& E) {
    const int tid = threadIdx.x, wid = __builtin_amdgcn_readfirstlane(tid >> 6), lane = tid & 63, wr = wid >> 2, wc = wid & 3, fr = lane & 15, fq = lane >> 4;
    const int K = g.K, nt = K / BK;
    unsigned voffA[2], voffB[2];
#pragma unroll
    for (int i = 0; i < 2; ++i) { int R, C; stage_rc(tid * 16 + i * 8192, R, C); const int Rb = Epi::PERM ? ((R & ~31) + perm32(R & 31)) : R;
        voffA[i] = (unsigned)(R * g.lda + C) * 2u; voffB[i] = (unsigned)(Rb * g.ldb + C) * 2u; }
    const size_t kstep = (size_t)(BK * 2);
    const size_t hstepA = (size_t)HALF * g.lda * 2, hstepB = (size_t)HALF * g.ldb * 2;
    const size_t tstepA = 2 * hstepA, tstepB = 2 * hstepB;
    const unsigned ldsw = (unsigned)wid * 1024u;
    const int aoff = lds_byte(wr * 64 + fr, fq * 8), boff = lds_byte(wc * 32 + fr, fq * 8);
#define PG8_SA(b, h) (((b) * 2 + (h)) * HTB)
#define PG8_SB(b, h) ((4 + (b) * 2 + (h)) * HTB)
#define PG8_STAGE(bufoff, gbase, voff) do { _Pragma("unroll") for (int _i = 0; _i < 2; ++_i) \
        __builtin_amdgcn_global_load_lds((const unsigned*)((const char*)(gbase) + (voff)[_i]), (PG8_LAS unsigned*)(lds + (bufoff) + ldsw + _i * 8192), 16, 0, 0); } while (0)
#define PG8_LDA(dst, b, h) do { _Pragma("unroll") for (int m = 0; m < 4; ++m) _Pragma("unroll") for (int k = 0; k < 2; ++k) dst[m][k] = *(const PG8_LAS bf16x8*)(lds + PG8_SA(b, h) + aoff + m * 2048 + k * 1024); } while (0)
#define PG8_LDB(dst, b, h) do { _Pragma("unroll") for (int n = 0; n < 2; ++n) _Pragma("unroll") for (int k = 0; k < 2; ++k) dst[n][k] = *(const PG8_LAS bf16x8*)(lds + PG8_SB(b, h) + boff + n * 2048 + k * 1024); } while (0)
#define PG8_MMA(ai, bj, At, Bt) do { __builtin_amdgcn_s_setprio(1); _Pragma("unroll") for (int m = 0; m < 4; ++m) _Pragma("unroll") for (int n = 0; n < 2; ++n) _Pragma("unroll") for (int k = 0; k < 2; ++k) \
        acc[ai][bj][m][n] = __builtin_amdgcn_mfma_f32_16x16x32_bf16(Bt[n][k], At[m][k], acc[ai][bj][m][n], 0, 0, 0); __builtin_amdgcn_s_setprio(0); } while (0)
#define PG8_WAIT_V(n) asm volatile("s_waitcnt vmcnt(" #n ")" ::: "memory")
#define PG8_WAIT_L(n) asm volatile("s_waitcnt lgkmcnt(" #n ")" ::: "memory")
#define PG8_BAR __builtin_amdgcn_s_barrier()
#define PG8_SCHED __builtin_amdgcn_sched_barrier(0)
    Unit cur, nxt; int ui = 0;
    if (!S.next(0, cur)) return;
    f32x4 acc[2][2][4][2];
#pragma unroll
    for (int a = 0; a < 2; ++a)
#pragma unroll
        for (int b = 0; b < 2; ++b)
#pragma unroll
            for (int m = 0; m < 4; ++m)
#pragma unroll
                for (int n = 0; n < 2; ++n) acc[a][b][m][n] = (f32x4){0.f, 0.f, 0.f, 0.f};
    bf16x8 At[4][2], B0[2][2], B1[2][2];
    const char* cA = (const char*)g.A + (size_t)cur.pm * tstepA; const char* cB = (const char*)g.Bt + (size_t)cur.pn * tstepB;
    S.a_ready(cur);
    if constexpr (SP2) {
        PG8_STAGE(PG8_SB(0, 0), cB, voffB); PG8_STAGE(PG8_SB(0, 1), cB + hstepB, voffB); PG8_STAGE(PG8_SA(0, 0), cA, voffA); PG8_STAGE(PG8_SA(0, 1), cA + hstepA, voffA);
        if (wr == 1) PG8_BAR;
        PG8_WAIT_V(2); PG8_BAR;
        PG8_STAGE(PG8_SB(1, 0), cB + kstep, voffB); PG8_STAGE(PG8_SA(1, 0), cA + kstep, voffA); PG8_STAGE(PG8_SB(1, 1), cB + hstepB + kstep, voffB);
        PG8_WAIT_V(6); PG8_BAR;
    } else {
        PG8_STAGE(PG8_SB(0, 0), cB, voffB); PG8_STAGE(PG8_SA(0, 0), cA, voffA); PG8_STAGE(PG8_SB(0, 1), cB + hstepB, voffB); PG8_STAGE(PG8_SA(0, 1), cA + hstepA, voffA);
        if (wr == 1) PG8_BAR;
        PG8_WAIT_V(4); PG8_BAR;
        PG8_STAGE(PG8_SB(1, 0), cB + kstep, voffB); PG8_STAGE(PG8_SA(1, 0), cA + kstep, voffA); PG8_STAGE(PG8_SB(1, 1), cB + hstepB + kstep, voffB);
        PG8_WAIT_V(6); PG8_BAR;
    }
    for (;;) {
        const bool has_next = S.next(ui + 1, nxt);
        const char* nA = has_next ? (const char*)g.A + (size_t)nxt.pm * tstepA : cA; const char* nB = has_next ? (const char*)g.Bt + (size_t)nxt.pn * tstepB : cB;
        for (int t = 0; t < nt; t += 2) {
            const bool last = (t == nt - 2);
            const char* a1 = cA + (size_t)(t + 1) * kstep;
            const char* a2 = last ? nA : cA + (size_t)(t + 2) * kstep; const char* b2 = last ? nB : cB + (size_t)(t + 2) * kstep;
            const char* a3 = a2 + kstep; const char* b3 = b2 + kstep;
            if (last && has_next) S.a_ready(nxt);
            if constexpr (SP2) {
            PG8_LDB(B0, 0, 0); PG8_LDB(B1, 0, 1); PG8_SCHED; PG8_LDA(At, 0, 0); PG8_STAGE(PG8_SA(1, 1), a1 + hstepA, voffA);
            PG8_WAIT_V(8); PG8_WAIT_L(0); PG8_BAR; PG8_MMA(0, 0, At, B0); PG8_MMA(0, 1, At, B1); PG8_BAR; PG8_SCHED;
            PG8_LDA(At, 0, 1); PG8_STAGE(PG8_SB(0, 0), b2, voffB); PG8_STAGE(PG8_SB(0, 1), b2 + hstepB, voffB); PG8_STAGE(PG8_SA(0, 0), a2, voffA);
            PG8_WAIT_V(8); PG8_WAIT_L(0); PG8_BAR; PG8_MMA(1, 0, At, B0); PG8_MMA(1, 1, At, B1); PG8_BAR; PG8_SCHED;
            PG8_LDB(B0, 1, 0); PG8_LDB(B1, 1, 1); PG8_SCHED; PG8_LDA(At, 1, 0); PG8_STAGE(PG8_SA(0, 1), a2 + hstepA, voffA);
            PG8_WAIT_V(8); PG8_WAIT_L(0); PG8_BAR; PG8_MMA(0, 0, At, B0); PG8_MMA(0, 1, At, B1); PG8_BAR; PG8_SCHED;
            PG8_LDA(At, 1, 1); PG8_STAGE(PG8_SB(1, 0), b3, voffB); PG8_STAGE(PG8_SB(1, 1), b3 + hstepB, voffB); PG8_STAGE(PG8_SA(1, 0), a3, voffA);
            PG8_WAIT_V(8); PG8_WAIT_L(0); PG8_BAR; PG8_MMA(1, 0, At, B0); PG8_MMA(1, 1, At, B1); PG8_BAR; PG8_SCHED;
            } else {
            PG8_LDB(B0, 0, 0); PG8_SCHED; PG8_LDA(At, 0, 0); PG8_STAGE(PG8_SA(1, 1), a1 + hstepA, voffA);
            PG8_WAIT_L(8); PG8_BAR; PG8_WAIT_L(0); PG8_MMA(0, 0, At, B0); PG8_BAR; PG8_SCHED;
            PG8_LDB(B1, 0, 1); PG8_STAGE(PG8_SB(0, 0), b2, voffB);
            PG8_BAR; PG8_WAIT_L(0); PG8_MMA(0, 1, At, B1); PG8_BAR;
            PG8_LDA(At, 0, 1); PG8_STAGE(PG8_SA(0, 0), a2, voffA);
            PG8_BAR; PG8_WAIT_L(0); PG8_MMA(1, 0, At, B0); PG8_BAR; PG8_SCHED;
            PG8_STAGE(PG8_SB(0, 1), b2 + hstepB, voffB);
            PG8_WAIT_V(6); PG8_BAR; PG8_MMA(1, 1, At, B1); PG8_BAR;
            PG8_LDB(B0, 1, 0); PG8_SCHED; PG8_LDA(At, 1, 0); PG8_STAGE(PG8_SA(0, 1), a2 + hstepA, voffA);
            PG8_WAIT_L(8); PG8_BAR; PG8_WAIT_L(0); PG8_MMA(0, 0, At, B0); PG8_BAR; PG8_SCHED;
            PG8_LDB(B1, 1, 1); PG8_STAGE(PG8_SB(1, 0), b3, voffB);
            PG8_BAR; PG8_WAIT_L(0); PG8_MMA(0, 1, At, B1); PG8_BAR;
            PG8_LDA(At, 1, 1); PG8_STAGE(PG8_SA(1, 0), a3, voffA);
            PG8_BAR; PG8_WAIT_L(0); PG8_MMA(1, 0, At, B0); PG8_BAR; PG8_SCHED;
            PG8_STAGE(PG8_SB(1, 1), b3 + hstepB, voffB);
            PG8_WAIT_V(6); PG8_BAR; PG8_MMA(1, 1, At, B1); PG8_BAR;
            }
        }
        if constexpr (ALIGN_EPI) { if (wr == 0) PG8_BAR; }
        if constexpr (!Epi::AFTER_DRAIN) { E(acc, cur, wr, wc, fr, fq); S.done(cur); }
        if (!has_next) break;
#pragma unroll
        for (int a = 0; a < 2; ++a)
#pragma unroll
            for (int b = 0; b < 2; ++b)
#pragma unroll
                for (int m = 0; m < 4; ++m)
#pragma unroll
                    for (int n = 0; n < 2; ++n) acc[a][b][m][n] = (f32x4){0.f, 0.f, 0.f, 0.f};
        cur = nxt; cA = nA; cB = nB; ++ui;
        if constexpr (ALIGN_EPI) { if (wr == 1) PG8_BAR; }
    }
    PG8_WAIT_V(0);
    if constexpr (!ALIGN_EPI) { if (wr == 0) PG8_BAR; }
    PG8_BAR;
    if constexpr (Epi::AFTER_DRAIN) { E.fused(acc, cur, wr, wc, fr, fq, lds, wid, lane); S.done(cur); }
#undef PG8_SA
#undef PG8_SB
#undef PG8_STAGE
#undef PG8_LDA
#undef PG8_LDB
#undef PG8_MMA
#undef PG8_WAIT_V
#undef PG8_WAIT_L
#undef PG8_BAR
#undef PG8_SCHED
}
}

#define GAS __attribute__((address_space(1)))
#define LAS __attribute__((address_space(3)))
typedef unsigned short bf16;
typedef unsigned v4u __attribute__((ext_vector_type(4)));
typedef unsigned v2u __attribute__((ext_vector_type(2)));
typedef float f32x4 __attribute__((ext_vector_type(4)));
typedef float f32x2 __attribute__((ext_vector_type(2)));
typedef float f32x16 __attribute__((ext_vector_type(16)));
typedef short bf16x8 __attribute__((ext_vector_type(8)));

constexpr int NTOK = 32768, SEQ = 4096, DM = 1024;
constexpr size_t MiB = 1u << 20;
constexpr size_t WS_WIN = 1 * MiB, WS_WUQ = 10 * MiB, WS_WUKV = 10 * MiB + 512 * 1024, WS_WL1 = 10 * MiB + 768 * 1024, WS_WL2 = 11 * MiB, WS_WGF = 11 * MiB + 128 * 1024,
                 WS_WGB = 11 * MiB + 256 * 1024, WS_WO = 12 * MiB, WS_WM = 14 * MiB, WS_WGU = 16 * MiB, WS_WD = 27 * MiB;
constexpr size_t WS_XN = 33 * MiB, WS_PR = 97 * MiB, WS_PM = 225 * MiB, WS_RKV = 257 * MiB, WS_LI = 353 * MiB, WS_SG = 369 * MiB, WS_VT = 385 * MiB, WS_OF = 417 * MiB, WS_OB = 449 * MiB;
constexpr size_t WS_ASIG = 33 * MiB, WS_DECF = 65 * MiB, WS_DECB = 97 * MiB, WS_Q = 129 * MiB, WS_K = 177 * MiB, WS_OA = 225 * MiB, WS_OBC = 65 * MiB, WS_M = 97 * MiB, WS_GU = 97 * MiB, WS_ACT = 273 * MiB;
constexpr size_t WS_END = 481 * MiB, WS_RSQ = 65536;
constexpr int LDS_BYTES = 135168;
constexpr float LOG2E = 1.4426950408889634f;
constexpr float QSCALE = 0.10206207261596575f * 1.4426950408889634f;

struct Args { const float* in[32]; float* out; unsigned char* ws; int ph_lo, ph_hi; };

typedef __bf16 bf16x2_t __attribute__((ext_vector_type(2)));
__device__ __forceinline__ unsigned pk2(float lo, float hi) { unsigned r; asm volatile("v_cvt_pk_bf16_f32 %0, %1, %2" : "=v"(r) : "v"(lo), "v"(hi)); return r; }
__device__ __forceinline__ unsigned pk2s(float lo, float hi) { const f32x2 v = {lo, hi}; return __builtin_bit_cast(unsigned, __builtin_convertvector(v, bf16x2_t)); }
__device__ __forceinline__ float bflo(unsigned u) { return __uint_as_float(u << 16); }
__device__ __forceinline__ float bfhi(unsigned u) { return __uint_as_float(u & 0xffff0000u); }
__device__ __forceinline__ float bf1(bf16 b) { return __uint_as_float((unsigned)b << 16); }
__device__ __forceinline__ float fexp(float x) { return __builtin_amdgcn_exp2f(x * LOG2E); }
__device__ __forceinline__ float sigm(float x) { return __builtin_amdgcn_rcpf(1.f + fexp(-x)); }
__device__ __forceinline__ float ftanh(float x) { return 1.f - 2.f * __builtin_amdgcn_rcpf(1.f + fexp(2.f * x)); }
__device__ __forceinline__ float wave_sum(float v) {
#pragma unroll
    for (int o = 1; o < 64; o <<= 1) v += __shfl_xor(v, o);
    return v;
}
template <int CTRL> __device__ __forceinline__ float dppf(float x) { return __int_as_float(__builtin_amdgcn_update_dpp(0, __float_as_int(x), CTRL, 0xf, 0xf, true)); }
__device__ __forceinline__ float red8(float x) { x += dppf<0xB1>(x); x += dppf<0x4E>(x); x += dppf<0x141>(x); return x; }
__device__ __forceinline__ int crow(int r, int hi) { return (r & 3) + 8 * (r >> 2) + 4 * hi; }

struct Frame {
    LAS unsigned char* lds;
    int tid, lane, wave, G, bid;
    const float* in[32]; float* out; unsigned char* ws;
};

__device__ __forceinline__ void tr_item(const float* W, int ldn, int nblk, bf16* WT, int ldk, LAS float* scr, int item, int lane, const float* ksc = nullptr) {
    const int kb = item / nblk, nb = item % nblk, k0 = 64 * kb, n0 = 32 * nb;
#pragma unroll 8
    for (int i = 0; i < 32; ++i) { const int kk = 2 * i + (lane >> 5); float w_ = W[(size_t)(k0 + kk) * ldn + n0 + (lane & 31)]; if (ksc) w_ *= ksc[k0 + kk]; scr[kk * 33 + (lane & 31)] = w_; }
    asm volatile("s_waitcnt lgkmcnt(0)" ::: "memory");
    const int c = lane & 7;
#pragma unroll
    for (int j = 0; j < 4; ++j) { const int n = (lane >> 3) + 8 * j; const LAS float* s = scr + (8 * c) * 33 + n;
        v4u o; o.x = pk2(s[0 * 33], s[1 * 33]); o.y = pk2(s[2 * 33], s[3 * 33]); o.z = pk2(s[4 * 33], s[5 * 33]); o.w = pk2(s[6 * 33], s[7 * 33]);
        *(v4u*)(WT + (size_t)(n0 + n) * ldk + k0 + 8 * c) = o; }
    asm volatile("s_waitcnt lgkmcnt(0)" ::: "memory");
}
__device__ __forceinline__ void rms_row(const float* xrow, const float* g, bf16* orow, int lane) {
    const f32x4* xr = (const f32x4*)xrow + lane; const f32x4* gr = (const f32x4*)g + lane;
    f32x4 v[4]; float s = 0.f;
#pragma unroll
    for (int j = 0; j < 4; ++j) { v[j] = xr[64 * j]; s += (v[j].x * v[j].x + v[j].y * v[j].y) + (v[j].z * v[j].z + v[j].w * v[j].w); }
    const float rstd = 1.f / sqrtf(wave_sum(s) * (1.f / 1024.f) + 1e-6f);
    v2u* o8 = (v2u*)orow + lane;
#pragma unroll
    for (int j = 0; j < 4; ++j) { const f32x4 gg = gr[64 * j]; v2u o; o.x = pk2(v[j].x * rstd * gg.x, v[j].y * rstd * gg.y); o.y = pk2(v[j].z * rstd * gg.z, v[j].w * rstd * gg.w); o8[64 * j] = o; }
}
__device__ __forceinline__ void zero_fill(Frame& F, bf16* p, int rows, int cols, int ld) {
    const int cpr = cols / 8, n = rows * cpr;
    for (int i = F.bid * 512 + F.tid; i < n; i += F.G * 512) { const int r = i / cpr, c = i % cpr; *(v4u*)(p + (size_t)r * ld + 8 * c) = (v4u){0u, 0u, 0u, 0u}; }
}
__device__ __forceinline__ void p0_prologue(Frame& F) {
    LAS float* scr = (LAS float*)(F.lds + F.wave * 16384);
    const int gw = F.bid * 8 + F.wave, NGW = F.G * 8;
    unsigned char* ws = F.ws;
    bf16* WIN = (bf16*)(ws + WS_WIN);
    constexpr int J0 = 16 * 13, J1 = J0 + 16 * 62, J2 = J1 + 16 * 64, J3 = J2 + 4 * 24, J4 = J3 + 2 * 32, J5 = J4 + 16, J6 = J5 + 16, J7 = J6 + 16, J8 = J7 + 32, J9 = J8 + 32,
                  J10 = J9 + 512, J11 = J10 + 512, J12 = J11 + 1408, J13 = J12 + 1408, J14 = J13 + 1408;
    for (int it = gw; it < J14; it += NGW) {
        if (it < J0) tr_item(F.in[3], 4448, 13, WIN + (size_t)4096 * 1024, 1024, scr, it, F.lane);
        else if (it < J1) tr_item(F.in[3] + 416, 4448, 62, WIN + (size_t)2048 * 1024, 1024, scr, it - J0, F.lane);
        else if (it < J2) tr_item(F.in[3] + 2400, 4448, 64, WIN, 1024, scr, it - J1, F.lane);
        else if (it < J3) tr_item(F.in[7], 768, 24, (bf16*)(ws + WS_WUQ), 256, scr, it - J2, F.lane);
        else if (it < J4) tr_item(F.in[8], 1024, 32, (bf16*)(ws + WS_WUKV), 128, scr, it - J3, F.lane);
        else if (it < J5) tr_item(F.in[17], 512, 16, (bf16*)(ws + WS_WL1), 128, scr, it - J4, F.lane);
        else if (it < J6) tr_item(F.in[15], 512, 16, (bf16*)(ws + WS_WL1) + 512 * 128 + 64, 128, scr, it - J5, F.lane);
        else if (it < J7) tr_item(F.in[15] + 64 * 512, 512, 16, (bf16*)(ws + WS_WL2), 128, scr, it - J6, F.lane);
        else if (it < J8) tr_item(F.in[18], 512, 16, (bf16*)(ws + WS_WGF), 128, scr, it - J7, F.lane);
        else if (it < J9) tr_item(F.in[18] + 128 * 512, 512, 16, (bf16*)(ws + WS_WGB), 128, scr, it - J8, F.lane);
        else if (it < J10) tr_item(F.in[24], 1024, 32, (bf16*)(ws + WS_WO), 1024, scr, it - J9, F.lane);
        else if (it < J11) tr_item(F.in[25], 1024, 32, (bf16*)(ws + WS_WM), 1024, scr, it - J10, F.lane);
        else if (it < J12) tr_item(F.in[27], 2816, 88, (bf16*)(ws + WS_WGU), 1024, scr, it - J11, F.lane, F.in[26]);
        else if (it < J13) tr_item(F.in[28], 2816, 88, (bf16*)(ws + WS_WGU) + (size_t)2816 * 1024, 1024, scr, it - J12, F.lane, F.in[26]);
        else tr_item(F.in[31], 1024, 32, (bf16*)(ws + WS_WD), 2816, scr, it - J13, F.lane);
    }
    zero_fill(F, WIN + (size_t)4032 * 1024, 64, 1024, 1024);
    zero_fill(F, WIN + (size_t)4512 * 1024, 96, 1024, 1024);
    zero_fill(F, (bf16*)(ws + WS_WL1) + 64, 512, 64, 128);
    zero_fill(F, (bf16*)(ws + WS_WL1) + 512 * 128, 512, 64, 128);
    zero_fill(F, (bf16*)(ws + WS_WL2) + 64, 512, 64, 128);
    for (int i = F.bid * 512 + F.tid; i < NTOK; i += F.G * 512) ((float*)(ws + WS_RSQ))[i] = 0.f;
    for (int m = gw; m < NTOK; m += NGW) rms_row(F.in[0] + (size_t)m * DM, F.in[2], (bf16*)(ws + WS_XN) + (size_t)m * DM, F.lane);
}

template <class Fn> struct Epi8 {
    static constexpr bool PERM = true, AFTER_DRAIN = false; Fn f;
    __device__ __forceinline__ void operator()(const pg8::f32x4 (&acc)[2][2][4][2], const pg8::Unit& u, int wr, int wc, int fr, int fq) const {
#pragma unroll
        for (int ai = 0; ai < 2; ++ai)
#pragma unroll
            for (int m = 0; m < 4; ++m)
#pragma unroll
                for (int bj = 0; bj < 2; ++bj) f(u.pm * 256 + ai * 128 + wr * 64 + m * 16 + fr, u.pn * 256 + bj * 128 + wc * 32 + 8 * fq, acc[ai][bj][m][0], acc[ai][bj][m][1]);
    }
};
__device__ __forceinline__ v4u pack8(f32x4 a, f32x4 b) { v4u w; w.x = pk2(a[0], a[1]); w.y = pk2(a[2], a[3]); w.z = pk2(b[0], b[1]); w.w = pk2(b[2], b[3]); return w; }
__device__ __forceinline__ void unpack8(v4u w, f32x4& a, f32x4& b) { a = (f32x4){bflo(w.x), bfhi(w.x), bflo(w.y), bfhi(w.y)}; b = (f32x4){bflo(w.z), bfhi(w.z), bflo(w.w), bfhi(w.w)}; }

struct FnIn {
    bf16* PG; bf16* PR; bf16* PM; const float* bg;
    __device__ __forceinline__ void operator()(int row, int col, f32x4 a, f32x4 b) const {
        if (col < 2048) { const f32x4 b0 = *(const f32x4*)(bg + col), b1 = *(const f32x4*)(bg + col + 4);
#pragma unroll
            for (int i = 0; i < 4; ++i) { a[i] = sigm(a[i] + b0[i]); b[i] = sigm(b[i] + b1[i]); }
            *(v4u*)(PG + (size_t)row * 2048 + col) = pack8(a, b); }
        else if (col < 4096) *(v4u*)(PR + (size_t)row * 2048 + (col - 2048)) = pack8(a, b);
        else *(v4u*)(PM + (size_t)row * 512 + (col - 4096)) = pack8(a, b);
    }
};
__device__ __forceinline__ float logdecay(float z) {
    const float x = -z, sp = fmaxf(x, 0.f) + __builtin_amdgcn_logf(1.f + fexp(-fabsf(x))) * 0.6931471805599453f;
    return -fexp(-sp - 0.5f);
}
struct FnLora1 {
    bf16* ASIG; bf16* DEC; const float* a0; const float* w0;
    __device__ __forceinline__ void operator()(int row, int col, f32x4 a, f32x4 b) const {
        if (col < 512) { const f32x4 b0 = *(const f32x4*)(a0 + col), b1 = *(const f32x4*)(a0 + col + 4);
#pragma unroll
            for (int i = 0; i < 4; ++i) { a[i] = sigm(a[i] + b0[i]); b[i] = sigm(b[i] + b1[i]); }
            *(v4u*)(ASIG + (size_t)row * 512 + col) = pack8(a, b); }
        else { const int c = col - 512; const f32x4 b0 = *(const f32x4*)(w0 + c), b1 = *(const f32x4*)(w0 + c + 4);
#pragma unroll
            for (int i = 0; i < 4; ++i) { a[i] = logdecay(a[i] + b0[i]); b[i] = logdecay(b[i] + b1[i]); }
            *(v4u*)(DEC + (size_t)row * 512 + c) = pack8(a, b); }
    }
};
struct FnLora2 {
    bf16* DEC; const float* w0;
    __device__ __forceinline__ void operator()(int row, int col, f32x4 a, f32x4 b) const {
        const f32x4 b0 = *(const f32x4*)(w0 + col), b1 = *(const f32x4*)(w0 + col + 4);
#pragma unroll
        for (int i = 0; i < 4; ++i) { a[i] = logdecay(a[i] + b0[i]); b[i] = logdecay(b[i] + b1[i]); }
        *(v4u*)(DEC + (size_t)row * 512 + col) = pack8(a, b);
    }
};
template <int ACC> struct FnMulAcc {
    bf16* O; int ldo; const bf16* S; int lds_; int soff;
    __device__ __forceinline__ void operator()(int row, int col, f32x4 a, f32x4 b) const {
        f32x4 s0, s1; unpack8(*(const v4u*)(S + (size_t)row * lds_ + soff + col), s0, s1);
        a = a * s0; b = b * s1;
        if (ACC) { f32x4 o0, o1; unpack8(*(const v4u*)(O + (size_t)row * ldo + col), o0, o1); a = a + o0; b = b + o1; }
        *(v4u*)(O + (size_t)row * ldo + col) = pack8(a, b);
    }
};
struct FnResid {
    const float* base; float* out;
    __device__ __forceinline__ void operator()(int row, int col, f32x4 a, f32x4 b) const {
        const size_t o = (size_t)row * 1024 + col; const f32x4 x0 = *(const f32x4*)(base + o), x1 = *(const f32x4*)(base + o + 4);
        *(f32x4*)(out + o) = x0 + a; *(f32x4*)(out + o + 4) = x1 + b;
    }
};
struct FnStore {
    bf16* O; int ldo;
    __device__ __forceinline__ void operator()(int row, int col, f32x4 a, f32x4 b) const { *(v4u*)(O + (size_t)row * ldo + col) = pack8(a, b); }
};
struct FnResidNorm {
    const float* base; float* out; bf16* XB; float* rsq;
    __device__ __forceinline__ void operator()(int row, int col, f32x4 a, f32x4 b) const {
        const size_t o = (size_t)row * 1024 + col; const f32x4 x0 = *(const f32x4*)(base + o) + a, x1 = *(const f32x4*)(base + o + 4) + b;
        *(v4u*)(XB + o) = pack8(x0, x1);
        float ss = (x0[0] * x0[0] + x0[1] * x0[1]) + (x0[2] * x0[2] + x0[3] * x0[3]) + (x1[0] * x1[0] + x1[1] * x1[1]) + (x1[2] * x1[2] + x1[3] * x1[3]);
        ss += __shfl_xor(ss, 16); ss += __shfl_xor(ss, 32);
        if (((col >> 3) & 3) == 0) atomicAdd(rsq + row, ss);
    }
};
struct FnResidBf {
    const bf16* XB; float* out;
    __device__ __forceinline__ void operator()(int row, int col, f32x4 a, f32x4 b) const {
        const size_t o = (size_t)row * 1024 + col; f32x4 x0, x1; unpack8(*(const v4u*)(XB + o), x0, x1);
        *(f32x4*)(out + o) = x0 + a; *(f32x4*)(out + o + 4) = x1 + b;
    }
};
struct FnStoreScaled {
    bf16* O; int ldo; const float* rsq;
    __device__ __forceinline__ void operator()(int row, int col, f32x4 a, f32x4 b) const { const float rs = 1.f / sqrtf(rsq[row] * (1.f / 1024.f) + 1e-6f); *(v4u*)(O + (size_t)row * ldo + col) = pack8(a * rs, b * rs); }
};
struct FnConvAct {
    const bf16* G; bf16* ACT; const float* cw; const float* cb; const float* rsq;
    __device__ __forceinline__ void operator()(int row, int col, f32x4 a, f32x4 b) const {
        { const float rs = 1.f / sqrtf(rsq[row] * (1.f / 1024.f) + 1e-6f); a = a * rs; b = b * rs; }
        const int s = row & (SEQ - 1); const bf16* g = G + (size_t)row * 2816 + col;
        f32x4 c0, c1, p0 = {0.f, 0.f, 0.f, 0.f}, p1 = p0, n0 = p0, n1 = p0;
        unpack8(*(const v4u*)g, c0, c1);
        if (s > 0) unpack8(*(const v4u*)(g - 2816), p0, p1);
        if (s < SEQ - 1) unpack8(*(const v4u*)(g + 2816), n0, n1);
        const f32x4 wa0 = *(const f32x4*)(cw + col), wa1 = *(const f32x4*)(cw + col + 4), wb0 = *(const f32x4*)(cw + 2816 + col), wb1 = *(const f32x4*)(cw + 2816 + col + 4),
                    wc0 = *(const f32x4*)(cw + 5632 + col), wc1 = *(const f32x4*)(cw + 5632 + col + 4), bb0 = *(const f32x4*)(cb + col), bb1 = *(const f32x4*)(cb + col + 4);
        f32x4 g0 = p0 * wa0 + c0 * wb0 + n0 * wc0 + bb0, g1 = p1 * wa1 + c1 * wb1 + n1 * wc1 + bb1;
#pragma unroll
        for (int i = 0; i < 4; ++i) { g0[i] = g0[i] * sigm(g0[i]) * a[i]; g1[i] = g1[i] * sigm(g1[i]) * b[i]; }
        *(v4u*)(ACT + (size_t)row * 2816 + col) = pack8(g0, g1);
    }
};
template <class Fn> __device__ __forceinline__ void run_gemm(Frame& F, const bf16* A, int lda, const bf16* Bt, int ldb, int N, int K, const Fn& fn) {
    asm volatile("" : "+s"(K));
    pg8::Gemm g{A, Bt, NTOK, N, K, lda, ldb}; pg8::StaticOrder S; S.init(NTOK, N, F.G, F.bid);
    Epi8<Fn> E{fn};
    pg8::gemm_phase<Epi8<Fn>, pg8::StaticOrder, true, true>(F.lds, g, S, E);
}

__device__ __forceinline__ void p2_shift(Frame& F) {
    const bf16* PR = (const bf16*)(F.ws + WS_PR); bf16* RKV = (bf16*)(F.ws + WS_RKV); bf16* LI = (bf16*)(F.ws + WS_LI); bf16* SG = (bf16*)(F.ws + WS_SG);
    const float* mu = F.in[13];
    for (int idx = F.bid * 512 + F.tid; idx < NTOK * 256; idx += F.G * 512) {
        const int m = idx >> 8, ch = idx & 255, s = m & (SEQ - 1), c = ch * 8;
        if (ch >= 248) { *(v4u*)(LI + (size_t)m * 256 + 192 + (ch - 248) * 8) = (v4u){0u, 0u, 0u, 0u}; continue; }
        const bf16* p = PR + (size_t)m * 2048 + c;
        f32x4 c0, c1, p0 = {0.f, 0.f, 0.f, 0.f}, p1 = p0, n0 = p0, n1 = p0;
        unpack8(*(const v4u*)p, c0, c1);
        if (s > 0) unpack8(*(const v4u*)(p - 2048), p0, p1);
        if (s < SEQ - 1) unpack8(*(const v4u*)(p + 2048), n0, n1);
        const f32x4 mp0 = *(const f32x4*)(mu + c), mp1 = *(const f32x4*)(mu + c + 4), mn0 = *(const f32x4*)(mu + 1984 + c), mn1 = *(const f32x4*)(mu + 1984 + c + 4);
        f32x4 u0 = c0 + mp0 * (p0 - c0) + mn0 * (n0 - c0), u1 = c1 + mp1 * (p1 - c1) + mn1 * (n1 - c1);
        if (c < 1536) *(v4u*)(RKV + (size_t)m * 1536 + c) = pack8(u0, u1);
        else if (c < 1600) *(v4u*)(LI + (size_t)m * 256 + (c - 1536)) = pack8(u0, u1);
        else if (c < 1728) {
#pragma unroll
            for (int i = 0; i < 4; ++i) { u0[i] = ftanh(u0[i]); u1[i] = ftanh(u1[i]); }
            *(v4u*)(LI + (size_t)m * 256 + 64 + (c - 1600)) = pack8(u0, u1); }
        else {
#pragma unroll
            for (int i = 0; i < 4; ++i) { u0[i] = sigm(u0[i]); u1[i] = sigm(u1[i]); }
            *(v4u*)(SG + (size_t)m * 256 + (c - 1728)) = pack8(u0, u1); }
    }
}

__device__ __forceinline__ void p5_gn(Frame& F) {
    const bf16* RKV = (const bf16*)(F.ws + WS_RKV); const bf16* ASIG = (const bf16*)(F.ws + WS_ASIG); bf16* OF = (bf16*)(F.ws + WS_OF); bf16* OB = (bf16*)(F.ws + WS_OB);
    const float *k_a = F.in[20], *r_k = F.in[21], *lng = F.in[22], *lnb = F.in[23];
    for (int idx = F.bid * 512 + F.tid; idx < NTOK * 64; idx += F.G * 512) {
        const int m = idx >> 6, c = (idx & 63) * 8;
        float r[8], k[8], v[8], a[8], of[8], ob[8];
        { f32x4 x0, x1; unpack8(*(const v4u*)(RKV + (size_t)m * 1536 + c), x0, x1); for (int i = 0; i < 4; ++i) { r[i] = x0[i]; r[4 + i] = x1[i]; }
          unpack8(*(const v4u*)(RKV + (size_t)m * 1536 + 512 + c), x0, x1); for (int i = 0; i < 4; ++i) { k[i] = x0[i]; k[4 + i] = x1[i]; }
          unpack8(*(const v4u*)(RKV + (size_t)m * 1536 + 1024 + c), x0, x1); for (int i = 0; i < 4; ++i) { v[i] = x0[i]; v[4 + i] = x1[i]; }
          unpack8(*(const v4u*)(ASIG + (size_t)m * 512 + c), x0, x1); for (int i = 0; i < 4; ++i) { a[i] = x0[i]; a[4 + i] = x1[i]; }
          unpack8(*(const v4u*)(OF + (size_t)m * 512 + c), x0, x1); for (int i = 0; i < 4; ++i) { of[i] = x0[i]; of[4 + i] = x1[i]; }
          unpack8(*(const v4u*)(OB + (size_t)m * 512 + c), x0, x1); for (int i = 0; i < 4; ++i) { ob[i] = x0[i]; ob[4 + i] = x1[i]; } }
        float bs = 0.f, sf = 0.f, sb = 0.f;
#pragma unroll
        for (int i = 0; i < 8; ++i) { const float kp = k[i] * (1.f + (a[i] - 1.f) * k_a[c + i]); bs += r[i] * kp * r_k[c + i]; sf += of[i]; sb += ob[i]; }
        bs = red8(bs); const float muf = red8(sf) * (1.f / 64.f), mub = red8(sb) * (1.f / 64.f);
        float qf = 0.f, qb = 0.f;
#pragma unroll
        for (int i = 0; i < 8; ++i) { of[i] -= muf; ob[i] -= mub; qf += of[i] * of[i]; qb += ob[i] * ob[i]; }
        const float rf = 1.f / sqrtf(red8(qf) * (1.f / 64.f) + 64e-5f), rb = 1.f / sqrtf(red8(qb) * (1.f / 64.f) + 64e-5f);
        f32x4 o0, o1, o2, o3;
#pragma unroll
        for (int i = 0; i < 4; ++i) {
            o0[i] = of[i] * rf * lng[c + i] + lnb[c + i] + bs * v[i];             o1[i] = of[4 + i] * rf * lng[c + 4 + i] + lnb[c + 4 + i] + bs * v[4 + i];
            o2[i] = ob[i] * rb * lng[c + i] + lnb[c + i] + bs * v[i];             o3[i] = ob[4 + i] * rb * lng[c + 4 + i] + lnb[c + 4 + i] + bs * v[4 + i]; }
        *(v4u*)(OF + (size_t)m * 512 + c) = pack8(o0, o1); *(v4u*)(OB + (size_t)m * 512 + c) = pack8(o2, o3);
    }
}

__device__ __forceinline__ void p11_conv(Frame& F) {
    bf16* GU = (bf16*)(F.ws + WS_GU); const float* cw = F.in[29]; const float* cb = F.in[30];
    for (int idx = F.bid * 512 + F.tid; idx < NTOK * 352; idx += F.G * 512) {
        const int m = idx / 352, c = (idx - m * 352) * 8, s = m & (SEQ - 1);
        bf16* g = GU + (size_t)m * 5632 + c;
        f32x4 c0, c1, p0 = {0.f, 0.f, 0.f, 0.f}, p1 = p0, n0 = p0, n1 = p0, u0, u1;
        unpack8(*(const v4u*)g, c0, c1); unpack8(*(const v4u*)(g + 2816), u0, u1);
        if (s > 0) unpack8(*(const v4u*)(g - 5632), p0, p1);
        if (s < SEQ - 1) unpack8(*(const v4u*)(g + 5632), n0, n1);
        const f32x4 wa0 = *(const f32x4*)(cw + c), wa1 = *(const f32x4*)(cw + c + 4), wb0 = *(const f32x4*)(cw + 2816 + c), wb1 = *(const f32x4*)(cw + 2816 + c + 4),
                    wc0 = *(const f32x4*)(cw + 5632 + c), wc1 = *(const f32x4*)(cw + 5632 + c + 4), bb0 = *(const f32x4*)(cb + c), bb1 = *(const f32x4*)(cb + c + 4);
        f32x4 g0 = p0 * wa0 + c0 * wb0 + n0 * wc0 + bb0, g1 = p1 * wa1 + c1 * wb1 + n1 * wc1 + bb1;
#pragma unroll
        for (int i = 0; i < 4; ++i) { g0[i] = g0[i] * sigm(g0[i]) * u0[i]; g1[i] = g1[i] * sigm(g1[i]) * u1[i]; }
        *(v4u*)(g + 2816) = pack8(g0, g1);
    }
}

#define MFMA32(a, b, c) __builtin_amdgcn_mfma_f32_32x32x16_bf16((a), (b), (c), 0, 0, 0)
__device__ __forceinline__ float ssq8(v4u w) { float a0 = bflo(w.x), a1 = bfhi(w.x), a2 = bflo(w.y), a3 = bfhi(w.y), a4 = bflo(w.z), a5 = bfhi(w.z), a6 = bflo(w.w), a7 = bfhi(w.w);
    return (a0 * a0 + a1 * a1) + (a2 * a2 + a3 * a3) + (a4 * a4 + a5 * a5) + (a6 * a6 + a7 * a7); }
__device__ __forceinline__ v4u scale8(v4u w, float rs, const float* g) { const f32x4 g0 = *(const f32x4*)g, g1 = *(const f32x4*)(g + 4); v4u o;
    o.x = pk2(bflo(w.x) * rs * g0[0], bfhi(w.x) * rs * g0[1]); o.y = pk2(bflo(w.y) * rs * g0[2], bfhi(w.y) * rs * g0[3]);
    o.z = pk2(bflo(w.z) * rs * g1[0], bfhi(w.z) * rs * g1[1]); o.w = pk2(bflo(w.w) * rs * g1[2], bfhi(w.w) * rs * g1[3]); return o; }
__device__ __forceinline__ float rope_inv_freq(int e, int hi) {
    constexpr float T[16] = {1.000000000e+00f, 5.623413324e-01f, 3.162277639e-01f, 1.778279394e-01f, 1.000000015e-01f, 5.623413250e-02f, 3.162277490e-02f, 1.778279431e-02f,
                             9.999999776e-03f, 5.623413250e-03f, 3.162277630e-03f, 1.778279431e-03f, 1.000000047e-03f, 5.623413017e-04f, 3.162277571e-04f, 1.778279402e-04f};
    const int i0 = (e & 3) + 8 * (e >> 2); return hi ? T[i0 + 4] : T[i0]; }
__device__ __forceinline__ void mla_item(Frame& F, int item) {
    const int tile = item >> 1, hg = item & 1, lane = F.lane, r32 = lane & 31, hi = lane >> 5;
    const int m = tile * 256 + F.wave * 32 + r32, b = m >> 12, s = m & (SEQ - 1);
    const bf16* PM = (const bf16*)(F.ws + WS_PM) + (size_t)m * 512;
    bf16* Qo = (bf16*)(F.ws + WS_Q); bf16* Ko = (bf16*)(F.ws + WS_K); bf16* VTo = (bf16*)(F.ws + WS_VT);
    v4u cq[16], ckv[8];
    float sq = 0.f, skv = 0.f;
#pragma unroll
    for (int i = 0; i < 16; ++i) { cq[i] = *(const v4u*)(PM + 16 * i + 8 * hi); sq += ssq8(cq[i]); }
#pragma unroll
    for (int i = 0; i < 8; ++i) { ckv[i] = *(const v4u*)(PM + 256 + 16 * i + 8 * hi); skv += ssq8(ckv[i]); }
    sq += __shfl_xor(sq, 32); skv += __shfl_xor(skv, 32);
    const float rq = 1.f / sqrtf(sq * (1.f / 256.f) + 1e-6f), rkv = 1.f / sqrtf(skv * (1.f / 128.f) + 1e-6f);
#pragma unroll
    for (int i = 0; i < 16; ++i) cq[i] = scale8(cq[i], rq, F.in[5] + 16 * i + 8 * hi);
#pragma unroll
    for (int i = 0; i < 8; ++i) ckv[i] = scale8(ckv[i], rkv, F.in[6] + 16 * i + 8 * hi);
    float cs[8], sn[8];
    { const float pos = (float)((const int*)F.in[1])[m];
#pragma unroll
      for (int e = 0; e < 8; ++e) { const float inv = rope_inv_freq(e, hi); const float ang = pos * inv;
          const float kq = rintf(ang * 0.15915494309189535f); float rr = fmaf(-kq, 6.28125f, ang); rr = fmaf(-kq, 1.9353071795864769e-3f, rr);
          rr *= 0.15915494309189535f; sn[e] = __builtin_amdgcn_sinf(rr); cs[e] = __builtin_amdgcn_cosf(rr); } }
    { float t1[8], t2[8];
      const v2u a0 = *(const v2u*)(PM + 384 + 4 * hi), a1 = *(const v2u*)(PM + 384 + 8 + 4 * hi), b0 = *(const v2u*)(PM + 384 + 16 + 4 * hi), b1 = *(const v2u*)(PM + 384 + 24 + 4 * hi);
      t1[0] = bflo(a0.x); t1[1] = bfhi(a0.x); t1[2] = bflo(a0.y); t1[3] = bfhi(a0.y); t1[4] = bflo(a1.x); t1[5] = bfhi(a1.x); t1[6] = bflo(a1.y); t1[7] = bfhi(a1.y);
      t2[0] = bflo(b0.x); t2[1] = bfhi(b0.x); t2[2] = bflo(b0.y); t2[3] = bfhi(b0.y); t2[4] = bflo(b1.x); t2[5] = bfhi(b1.x); t2[6] = bflo(b1.y); t2[7] = bfhi(b1.y);
      float ss = 0.f;
#pragma unroll
      for (int e = 0; e < 8; ++e) ss += t1[e] * t1[e] + t2[e] * t2[e];
      ss += __shfl_xor(ss, 32);
      const float rs = 1.f / sqrtf(ss * (1.f / 32.f) + 1e-6f);
      float o1[8], o2[8];
#pragma unroll
      for (int e = 0; e < 8; ++e) { const int i = crow(e, hi); const float x1 = t1[e] * rs * F.in[12][i], x2 = t2[e] * rs * F.in[12][i + 16]; o1[e] = x1 * cs[e] - x2 * sn[e]; o2[e] = x2 * cs[e] + x1 * sn[e]; }
#pragma unroll
      for (int hh = 0; hh < 4; ++hh) { bf16* kp = Ko + ((size_t)(b * 8 + hg * 4 + hh) * SEQ + s) * 96 + 64;
          *(v2u*)(kp + 4 * hi) = (v2u){pk2s(o1[0], o1[1]), pk2s(o1[2], o1[3])}; *(v2u*)(kp + 8 + 4 * hi) = (v2u){pk2s(o1[4], o1[5]), pk2s(o1[6], o1[7])};
          *(v2u*)(kp + 16 + 4 * hi) = (v2u){pk2s(o2[0], o2[1]), pk2s(o2[2], o2[3])}; *(v2u*)(kp + 24 + 4 * hi) = (v2u){pk2s(o2[4], o2[5]), pk2s(o2[6], o2[7])}; } }
    const bf16* WUQ = (const bf16*)(F.ws + WS_WUQ); const bf16* WUKV = (const bf16*)(F.ws + WS_WUKV);
    LAS unsigned char* lq = F.lds; LAS unsigned char* lkv = F.lds + 96 * 528;
    for (int hh = 0; hh < 4; ++hh) {
        const int h = hg * 4 + hh;
        __syncthreads();
        { const v4u* src = (const v4u*)(WUQ + (size_t)h * 96 * 256);
#pragma unroll
          for (int j = 0; j < 6; ++j) { const int i = j * 512 + F.tid; *(LAS v4u*)(lq + (i >> 5) * 528 + (i & 31) * 16) = src[i]; }
          const v4u* src2 = (const v4u*)(WUKV + (size_t)h * 128 * 128);
#pragma unroll
          for (int j = 0; j < 4; ++j) { const int i = j * 512 + F.tid; *(LAS v4u*)(lkv + (i >> 4) * 272 + (i & 15) * 16) = src2[i]; } }
        __syncthreads();
        const size_t rowq = ((size_t)(b * 8 + h) * SEQ + s) * 96;
        f32x16 qa[3];
#pragma unroll
        for (int j = 0; j < 3; ++j) { qa[j] = (f32x16){};
#pragma unroll
            for (int i = 0; i < 16; ++i) { const bf16x8 a = *(const LAS bf16x8*)(lq + (32 * j + r32) * 528 + 32 * i + 16 * hi); qa[j] = MFMA32(a, __builtin_bit_cast(bf16x8, cq[i]), qa[j]); } }
        { float ss = 0.f;
#pragma unroll
          for (int r = 0; r < 16; ++r) ss += qa[0][r] * qa[0][r] + qa[1][r] * qa[1][r];
          ss += __shfl_xor(ss, 32);
          const float rs = QSCALE / sqrtf(ss * (1.f / 64.f) + 1e-6f);
#pragma unroll
          for (int j = 0; j < 2; ++j)
#pragma unroll
              for (int g4 = 0; g4 < 4; ++g4) { const int col = 32 * j + 8 * g4 + 4 * hi; const f32x4 gg = *(const f32x4*)(F.in[9] + col);
                  *(v2u*)(Qo + rowq + col) = (v2u){pk2s(qa[j][4 * g4] * rs * gg[0], qa[j][4 * g4 + 1] * rs * gg[1]), pk2s(qa[j][4 * g4 + 2] * rs * gg[2], qa[j][4 * g4 + 3] * rs * gg[3])}; }
          float s2 = 0.f;
#pragma unroll
          for (int r = 0; r < 16; ++r) s2 += qa[2][r] * qa[2][r];
          s2 += __shfl_xor(s2, 32);
          const float r2 = 1.f / sqrtf(s2 * (1.f / 32.f) + 1e-6f);
          float o1[8], o2[8];
#pragma unroll
          for (int e = 0; e < 8; ++e) { const int i = crow(e, hi); const float x1 = qa[2][e] * r2 * F.in[10][i], x2 = qa[2][e + 8] * r2 * F.in[10][i + 16];
              o1[e] = (x1 * cs[e] - x2 * sn[e]) * QSCALE; o2[e] = (x2 * cs[e] + x1 * sn[e]) * QSCALE; }
          bf16* qp = Qo + rowq + 64;
          *(v2u*)(qp + 4 * hi) = (v2u){pk2s(o1[0], o1[1]), pk2s(o1[2], o1[3])}; *(v2u*)(qp + 8 + 4 * hi) = (v2u){pk2s(o1[4], o1[5]), pk2s(o1[6], o1[7])};
          *(v2u*)(qp + 16 + 4 * hi) = (v2u){pk2s(o2[0], o2[1]), pk2s(o2[2], o2[3])}; *(v2u*)(qp + 24 + 4 * hi) = (v2u){pk2s(o2[4], o2[5]), pk2s(o2[6], o2[7])}; }
        f32x16 ka[2];
#pragma unroll
        for (int j = 0; j < 2; ++j) { ka[j] = (f32x16){};
#pragma unroll
            for (int i = 0; i < 8; ++i) { const bf16x8 a = *(const LAS bf16x8*)(lkv + (32 * j + r32) * 272 + 32 * i + 16 * hi); ka[j] = MFMA32(a, __builtin_bit_cast(bf16x8, ckv[i]), ka[j]); } }
        { float ss = 0.f;
#pragma unroll
          for (int r = 0; r < 16; ++r) ss += ka[0][r] * ka[0][r] + ka[1][r] * ka[1][r];
          ss += __shfl_xor(ss, 32);
          const float rs = 1.f / sqrtf(ss * (1.f / 64.f) + 1e-6f);
#pragma unroll
          for (int j = 0; j < 2; ++j)
#pragma unroll
              for (int g4 = 0; g4 < 4; ++g4) { const int col = 32 * j + 8 * g4 + 4 * hi; const f32x4 gg = *(const f32x4*)(F.in[11] + col);
                  *(v2u*)(Ko + rowq + col) = (v2u){pk2s(ka[j][4 * g4] * rs * gg[0], ka[j][4 * g4 + 1] * rs * gg[1]), pk2s(ka[j][4 * g4 + 2] * rs * gg[2], ka[j][4 * g4 + 3] * rs * gg[3])}; } }
#pragma unroll
        for (int j = 0; j < 2; ++j) { f32x16 va = (f32x16){};
#pragma unroll
            for (int i = 0; i < 8; ++i) { const bf16x8 a = *(const LAS bf16x8*)(lkv + (64 + 32 * j + r32) * 272 + 32 * i + 16 * hi); va = MFMA32(a, __builtin_bit_cast(bf16x8, ckv[i]), va); }
#pragma unroll
            for (int r = 0; r < 16; r += 2) { const unsigned w = pk2s(va[r], va[r + 1]); const int d = 32 * j + crow(r, hi);
                VTo[((size_t)(b * 8 + h) * 64 + d) * SEQ + s] = (bf16)(w & 0xffffu); VTo[((size_t)(b * 8 + h) * 64 + d + 1) * SEQ + s] = (bf16)(w >> 16); } }
    }
    __syncthreads();
}

constexpr int AK_STRIDE = 208, AV_STRIDE = 136, AK_BYTES = 64 * AK_STRIDE, AV_BYTES = 64 * AV_STRIDE, AV_OFF = 2 * AK_BYTES;
__device__ __forceinline__ void attn_unit(Frame& F, int bh, int qb) {
    const int tid = F.tid, lane = F.lane, wid = F.wave, r32 = lane & 31, hi = lane >> 5;
    const bf16* Qp = (const bf16*)(F.ws + WS_Q) + ((size_t)bh * SEQ + qb * 256 + wid * 32 + r32) * 96;
    const bf16* Kb = (const bf16*)(F.ws + WS_K) + (size_t)bh * SEQ * 96; const bf16* Vb = (const bf16*)(F.ws + WS_VT) + (size_t)bh * 64 * SEQ;
    LAS unsigned char* lds = F.lds;
    bf16x8 qf[6];
#pragma unroll
    for (int d0 = 0; d0 < 6; ++d0) qf[d0] = *(const bf16x8*)(Qp + 16 * d0 + 8 * hi);
    const int kl0 = (tid / 12) * AK_STRIDE + (tid % 12) * 16, i1 = 512 + tid, kl1 = (i1 / 12) * AK_STRIDE + (i1 % 12) * 16;
    const int vd = tid >> 3, vc = tid & 7, vl = AV_OFF + vd * AV_STRIDE + vc * 16;
    const v4u* kg = (const v4u*)Kb; const bf16* vg = Vb + (size_t)vd * SEQ + vc * 8;
    v4u sk0, sk1 = {0u, 0u, 0u, 0u}, sv;
    sk0 = kg[tid]; if (tid < 256) sk1 = kg[512 + tid]; sv = *(const v4u*)vg;
    __syncthreads();
    *(LAS v4u*)(lds + kl0) = sk0; if (tid < 256) *(LAS v4u*)(lds + kl1) = sk1;
    *(LAS v2u*)(lds + vl) = (v2u){sv.x, sv.y}; *(LAS v2u*)(lds + vl + 8) = (v2u){sv.z, sv.w};
    __syncthreads();
    float mrun = -1e30f, lrun = 0.f;
    f32x16 o0 = (f32x16){}, o1 = (f32x16){};
    for (int t = 0; t < 64; ++t) {
        const int cur = t & 1, nxt = cur ^ 1;
        if (t + 1 < 64) { const v4u* kgn = kg + (size_t)(t + 1) * 768; sk0 = kgn[tid]; if (tid < 256) sk1 = kgn[512 + tid]; sv = *(const v4u*)(vg + (t + 1) * 64); }
        const LAS unsigned char* kb_ = lds + cur * AK_BYTES; const LAS unsigned char* vb_ = lds + AV_OFF + cur * AV_BYTES;
        f32x16 p0 = (f32x16){}, p1 = (f32x16){};
#pragma unroll
        for (int d0 = 0; d0 < 6; ++d0) {
            const bf16x8 a0 = *(const LAS bf16x8*)(kb_ + r32 * AK_STRIDE + 32 * d0 + 16 * hi), a1 = *(const LAS bf16x8*)(kb_ + (32 + r32) * AK_STRIDE + 32 * d0 + 16 * hi);
            p0 = MFMA32(a0, qf[d0], p0); p1 = MFMA32(a1, qf[d0], p1); }
        float mx = fmaxf(p0[0], p1[0]);
#pragma unroll
        for (int r = 1; r < 16; ++r) mx = fmaxf(mx, fmaxf(p0[r], p1[r]));
        mx = fmaxf(mx, __shfl_xor(mx, 32));
        const float mnew = fmaxf(mrun, mx), alpha = __builtin_amdgcn_exp2f(mrun - mnew);
        mrun = mnew;
        float ls = 0.f;
#pragma unroll
        for (int r = 0; r < 16; ++r) { p0[r] = __builtin_amdgcn_exp2f(p0[r] - mnew); p1[r] = __builtin_amdgcn_exp2f(p1[r] - mnew); ls += p0[r] + p1[r]; }
        lrun = lrun * alpha + ls;
#pragma unroll
        for (int r = 0; r < 16; ++r) { o0[r] *= alpha; o1[r] *= alpha; }
        v4u pb[4];
        pb[0] = (v4u){pk2(p0[0], p0[1]), pk2(p0[2], p0[3]), pk2(p0[4], p0[5]), pk2(p0[6], p0[7])};
        pb[1] = (v4u){pk2(p0[8], p0[9]), pk2(p0[10], p0[11]), pk2(p0[12], p0[13]), pk2(p0[14], p0[15])};
        pb[2] = (v4u){pk2(p1[0], p1[1]), pk2(p1[2], p1[3]), pk2(p1[4], p1[5]), pk2(p1[6], p1[7])};
        pb[3] = (v4u){pk2(p1[8], p1[9]), pk2(p1[10], p1[11]), pk2(p1[12], p1[13]), pk2(p1[14], p1[15])};
#pragma unroll
        for (int sl = 0; sl < 4; ++sl) {
            const LAS unsigned char* va = vb_ + r32 * AV_STRIDE + 2 * (16 * sl + 4 * hi);
            const v2u x0 = *(const LAS v2u*)va, x1 = *(const LAS v2u*)(va + 16), y0 = *(const LAS v2u*)(va + 32 * AV_STRIDE), y1 = *(const LAS v2u*)(va + 32 * AV_STRIDE + 16);
            const bf16x8 pbf = __builtin_bit_cast(bf16x8, pb[sl]);
            o0 = MFMA32(__builtin_bit_cast(bf16x8, ((v4u){x0.x, x0.y, x1.x, x1.y})), pbf, o0);
            o1 = MFMA32(__builtin_bit_cast(bf16x8, ((v4u){y0.x, y0.y, y1.x, y1.y})), pbf, o1); }
        if (t + 1 < 64) { LAS unsigned char* kn = lds + nxt * AK_BYTES; LAS unsigned char* vn = lds + nxt * AV_BYTES;
            *(LAS v4u*)(kn + kl0) = sk0; if (tid < 256) *(LAS v4u*)(kn + kl1) = sk1;
            *(LAS v2u*)(vn + vl) = (v2u){sv.x, sv.y}; *(LAS v2u*)(vn + vl + 8) = (v2u){sv.z, sv.w}; }
        __syncthreads();
    }
    lrun += __shfl_xor(lrun, 32);
    const float inv = 1.f / lrun;
    const int b = bh >> 3, h = bh & 7;
    bf16* op = (bf16*)(F.ws + WS_OA) + ((size_t)b * SEQ + qb * 256 + wid * 32 + r32) * 512 + h * 64;
#pragma unroll
    for (int g4 = 0; g4 < 4; ++g4) {
        *(v2u*)(op + 8 * g4 + 4 * hi) = (v2u){pk2(o0[4 * g4] * inv, o0[4 * g4 + 1] * inv), pk2(o0[4 * g4 + 2] * inv, o0[4 * g4 + 3] * inv)};
        *(v2u*)(op + 32 + 8 * g4 + 4 * hi) = (v2u){pk2(o1[4 * g4] * inv, o1[4 * g4 + 1] * inv), pk2(o1[4 * g4 + 2] * inv, o1[4 * g4 + 3] * inv)}; }
}

constexpr int SC_STEP = 1408, SC_BUF = 32 * SC_STEP, SC_OB = 2 * SC_BUF;
__device__ __forceinline__ float ffma_s(float a, float b, float c) { float d; asm("v_fma_f32 %0, %1, %2, %3" : "=v"(d) : "v"(a), "v"(b), "v"(c)); return d; }
__device__ __forceinline__ float fmul_s(float a, float b) { float d; asm("v_mul_f32_e32 %0, %1, %2" : "=v"(d) : "v"(a), "v"(b)); return d; }
__device__ __forceinline__ void scan_item(Frame& F, int item) {
    const int b = item >> 5, h = (item >> 2) & 7, dir = (item >> 1) & 1, half = item & 1;
    const int tid = F.tid, lane = F.lane, wid = F.wave;
    LAS unsigned char* lds = F.lds;
    const bf16* RKV = (const bf16*)(F.ws + WS_RKV); const bf16* ASIG = (const bf16*)(F.ws + WS_ASIG);
    const bf16* DEC = (const bf16*)(F.ws + (dir ? WS_DECB : WS_DECF)); bf16* OUT = (bf16*)(F.ws + (dir ? WS_OB : WS_OF));
    const bool loader = wid >= 4;
    const int lt = tid - 256, lj = lt >> 3, lg = lt & 7;
    float kk8[8], ka8[8];
    if (loader) {
#pragma unroll
        for (int i = 0; i < 8; ++i) { kk8[i] = F.in[19][h * 64 + 8 * lg + i]; ka8[i] = F.in[20][h * 64 + 8 * lg + i]; } }
    auto tok = [&](int c, int j) { const int s = dir ? (SEQ - 1 - (32 * c + j)) : (32 * c + j); return b * SEQ + s; };
    v4u g_r8, g_k8, g_a8, g_w8, g_v8 = {0u, 0u, 0u, 0u};
    auto issue_chunk = [&](int c) {
        const size_t m = (size_t)tok(c, lj); const int col = h * 64 + 8 * lg;
        g_r8 = *(const v4u*)(RKV + m * 1536 + col); g_k8 = *(const v4u*)(RKV + m * 1536 + 512 + col); g_a8 = *(const v4u*)(ASIG + m * 512 + col); g_w8 = *(const v4u*)(DEC + m * 512 + col);
        if (lg < 4) g_v8 = *(const v4u*)(RKV + m * 1536 + 1024 + h * 64 + half * 32 + 8 * lg);
    };
    auto commit_chunk = [&](int bufi) {
        f32x4 r0, r1, k0, k1, a0, a1, w0, w1; unpack8(g_r8, r0, r1); unpack8(g_k8, k0, k1); unpack8(g_a8, a0, a1); unpack8(g_w8, w0, w1);
        float kf[8], ss = 0.f;
#pragma unroll
        for (int i = 0; i < 4; ++i) { kf[i] = k0[i] * kk8[i]; kf[4 + i] = k1[i] * kk8[4 + i]; }
#pragma unroll
        for (int i = 0; i < 8; ++i) ss += kf[i] * kf[i];
        ss = red8(ss);
        const float inv = 1.f / fmaxf(sqrtf(ss), 1e-12f);
        f32x4 na0, na1, bb0, bb1, kp0, kp1, d0, d1;
#pragma unroll
        for (int i = 0; i < 4; ++i) { const float q0 = kf[i] * inv, q1 = kf[4 + i] * inv; na0[i] = -q0; na1[i] = -q1; bb0[i] = q0 * a0[i]; bb1[i] = q1 * a1[i];
            kp0[i] = k0[i] * (1.f + (a0[i] - 1.f) * ka8[i]); kp1[i] = k1[i] * (1.f + (a1[i] - 1.f) * ka8[4 + i]); d0[i] = fexp(w0[i]); d1[i] = fexp(w1[i]); }
        LAS float* sp = (LAS float*)(lds + bufi * SC_BUF + lj * SC_STEP) + 8 * lg;
        *(LAS f32x4*)(sp) = r0; *(LAS f32x4*)(sp + 4) = r1; *(LAS f32x4*)(sp + 64) = d0; *(LAS f32x4*)(sp + 68) = d1; *(LAS f32x4*)(sp + 128) = kp0; *(LAS f32x4*)(sp + 132) = kp1;
        *(LAS f32x4*)(sp + 192) = na0; *(LAS f32x4*)(sp + 196) = na1; *(LAS f32x4*)(sp + 256) = bb0; *(LAS f32x4*)(sp + 260) = bb1;
        if (lg < 4) { f32x4 v0, v1; unpack8(g_v8, v0, v1); *(LAS f32x4*)(sp + 320) = v0; *(LAS f32x4*)(sp + 324) = v1; }
    };
    auto flush_chunk = [&](int c, int bufi) {
        if (lg < 4) { const LAS float* ob = (const LAS float*)(lds + SC_OB + bufi * 4096) + lj * 32 + 8 * lg; const f32x4 x0 = *(const LAS f32x4*)ob, x1 = *(const LAS f32x4*)(ob + 4);
            *(v4u*)(OUT + (size_t)tok(c, lj) * 512 + h * 64 + half * 32 + 8 * lg) = pack8(x0, x1); }
    };
    f32x2 S[4]; S[0] = S[1] = S[2] = S[3] = (f32x2){0.f, 0.f};
    const int rowl = wid * 8 + (lane >> 3), jj = lane & 7;
#define SC_BAR() do { asm volatile("s_waitcnt lgkmcnt(0)" ::: "memory"); __builtin_amdgcn_s_barrier(); asm volatile("" ::: "memory"); } while (0)
    __syncthreads();
    if (loader) { issue_chunk(0); commit_chunk(0); issue_chunk(1); }
    SC_BAR();
    for (int c = 0; c < 128; ++c) {
        if (loader) { if (c + 1 < 128) commit_chunk((c + 1) & 1); if (c + 2 < 128) issue_chunk(c + 2); if (c > 0) flush_chunk(c - 1, (c - 1) & 1); }
        else {
            const LAS float* base = (const LAS float*)(lds + (c & 1) * SC_BUF) + 8 * jj; LAS float* ob = (LAS float*)(lds + SC_OB + (c & 1) * 4096) + rowl;
#define SC_LOAD(X, j) do { const LAS float* p_ = base + (j) * (SC_STEP / 4); \
                X##r0 = *(const LAS f32x4*)p_; X##r1 = *(const LAS f32x4*)(p_ + 4); X##w0 = *(const LAS f32x4*)(p_ + 64); X##w1 = *(const LAS f32x4*)(p_ + 68); X##k0 = *(const LAS f32x4*)(p_ + 128); X##k1 = *(const LAS f32x4*)(p_ + 132); \
                X##a0 = *(const LAS f32x4*)(p_ + 192); X##a1 = *(const LAS f32x4*)(p_ + 196); X##b0 = *(const LAS f32x4*)(p_ + 256); X##b1 = *(const LAS f32x4*)(p_ + 260); X##v = p_[320 - 8 * jj + rowl]; } while (0)
#define SC_COMP(X, j) do { \
                f32x2 t_ = S[0] * (f32x2){X##a0[0], X##a0[1]} + S[1] * (f32x2){X##a0[2], X##a0[3]}; f32x2 t2_ = S[2] * (f32x2){X##a1[0], X##a1[1]} + S[3] * (f32x2){X##a1[2], X##a1[3]}; t_ = t_ + t2_; \
                const float sa_ = red8(t_.x + t_.y); const f32x2 sa2_ = {sa_, sa_}, v2_ = {X##v, X##v}; \
                S[0] = S[0] * (f32x2){X##w0[0], X##w0[1]} + (sa2_ * (f32x2){X##b0[0], X##b0[1]} + v2_ * (f32x2){X##k0[0], X##k0[1]}); \
                S[1] = S[1] * (f32x2){X##w0[2], X##w0[3]} + (sa2_ * (f32x2){X##b0[2], X##b0[3]} + v2_ * (f32x2){X##k0[2], X##k0[3]}); \
                S[2] = S[2] * (f32x2){X##w1[0], X##w1[1]} + (sa2_ * (f32x2){X##b1[0], X##b1[1]} + v2_ * (f32x2){X##k1[0], X##k1[1]}); \
                S[3] = S[3] * (f32x2){X##w1[2], X##w1[3]} + (sa2_ * (f32x2){X##b1[2], X##b1[3]} + v2_ * (f32x2){X##k1[2], X##k1[3]}); \
                f32x2 q_ = S[0] * (f32x2){X##r0[0], X##r0[1]} + S[1] * (f32x2){X##r0[2], X##r0[3]}; f32x2 q2_ = S[2] * (f32x2){X##r1[0], X##r1[1]} + S[3] * (f32x2){X##r1[2], X##r1[3]}; q_ = q_ + q2_; \
                const float o_ = red8(q_.x + q_.y); if (jj == 0) ob[(j) * 32] = o_; } while (0)
            f32x4 Ar0, Ar1, Aw0, Aw1, Ak0, Ak1, Aa0, Aa1, Ab0, Ab1, Br0, Br1, Bw0, Bw1, Bk0, Bk1, Ba0, Ba1, Bb0, Bb1; float Av, Bv;
            SC_LOAD(A, 0);
#pragma unroll 2
            for (int j = 0; j < 32; j += 2) {
                SC_LOAD(B, j + 1);
                __builtin_amdgcn_sched_barrier(0);
                SC_COMP(A, j);
                if (j + 2 < 32) SC_LOAD(A, j + 2);
                __builtin_amdgcn_sched_barrier(0);
                SC_COMP(B, j + 1);
            }
#undef SC_LOAD
#undef SC_COMP
        }
        SC_BAR();
    }
    if (loader) flush_chunk(127, 1);
    __syncthreads();
}

constexpr int FV_STRIDE = 144, FV_BYTES = 64 * FV_STRIDE;
constexpr int FS_STEP = 896;
constexpr int FS_ABUF = 0, FS_SBUF = 45056, FS_SBYTES = 16 * FS_STEP, FS_OBUF = FS_SBUF + 2 * FS_SBYTES, FS_OBYTES = 16 * 256 * 4;
typedef _Float16 h4 __attribute__((ext_vector_type(4)));
template <int HL> __device__ __forceinline__ float mixfma(unsigned h, float s, float c) { float d;
    if (HL) asm("v_fma_mix_f32 %0, %1, %2, %3 op_sel:[1,0,0] op_sel_hi:[1,0,0]" : "=v"(d) : "v"(h), "v"(s), "v"(c));
    else    asm("v_fma_mix_f32 %0, %1, %2, %3 op_sel:[0,0,0] op_sel_hi:[1,0,0]" : "=v"(d) : "v"(h), "v"(s), "v"(c));
    return d; }
template <int HL> __device__ __forceinline__ float mixmul(unsigned h, float s) { float d;
    if (HL) asm("v_fma_mix_f32 %0, %1, %2, 0 op_sel:[1,0,0] op_sel_hi:[1,0,0]" : "=v"(d) : "v"(h), "v"(s));
    else    asm("v_fma_mix_f32 %0, %1, %2, 0 op_sel:[0,0,0] op_sel_hi:[1,0,0]" : "=v"(d) : "v"(h), "v"(s));
    return d; }
__device__ __forceinline__ float red16(float x) { x += dppf<0xB1>(x); x += dppf<0x4E>(x); x += dppf<0x141>(x); x += dppf<0x140>(x); return x; }
template <int MODE  > __device__ __forceinline__ void p4_fused(Frame& F) {
    const int tid = F.tid, lane = F.lane, wid = F.wave, r32 = lane & 31, hi = lane >> 5;
    LAS unsigned char* lds = F.lds;
    const int item = F.bid, sb = item >> 5, sh = (item >> 2) & 7, dir = (item >> 1) & 1, half = item & 1;
    const bf16* RKV = (const bf16*)(F.ws + WS_RKV); const bf16* ASIG = (const bf16*)(F.ws + WS_ASIG);
    const bf16* DEC = (const bf16*)(F.ws + (dir ? WS_DECB : WS_DECF)); bf16* OUT = (bf16*)(F.ws + (dir ? WS_OB : WS_OF));
    const bool loader = wid < 4;
    const int lt = tid & 255, lj = lt >> 4, lg = lt & 15;
    const bool stager = !loader;
    float kk4[4], ka4[4];
    if (stager) {
#pragma unroll
        for (int i = 0; i < 4; ++i) { kk4[i] = F.in[19][sh * 64 + 4 * lg + i]; ka4[i] = F.in[20][sh * 64 + 4 * lg + i]; } }
    auto tok = [&](int c, int j) { const int s = dir ? (SEQ - 1 - (16 * c + j)) : (16 * c + j); return sb * SEQ + s; };
    v2u g_r, g_k, g_a, g_w, g_v = {0u, 0u};
    auto issue_chunk = [&](int c) {
        const size_t m = (size_t)tok(c, lj); const int col = sh * 64 + 4 * lg;
        g_r = *(const v2u*)(RKV + m * 1536 + col); g_k = *(const v2u*)(RKV + m * 1536 + 512 + col); g_a = *(const v2u*)(ASIG + m * 512 + col); g_w = *(const v2u*)(DEC + m * 512 + col);
        if (lg < 8) g_v = *(const v2u*)(RKV + m * 1536 + 1024 + sh * 64 + half * 32 + 4 * lg);
    };
    auto commit_chunk = [&](int bufi) {
        const f32x4 r = {bflo(g_r.x), bfhi(g_r.x), bflo(g_r.y), bfhi(g_r.y)}, k = {bflo(g_k.x), bfhi(g_k.x), bflo(g_k.y), bfhi(g_k.y)},
                    a = {bflo(g_a.x), bfhi(g_a.x), bflo(g_a.y), bfhi(g_a.y)}, w = {bflo(g_w.x), bfhi(g_w.x), bflo(g_w.y), bfhi(g_w.y)};
        float kf[4], ss = 0.f;
#pragma unroll
        for (int i = 0; i < 4; ++i) { kf[i] = k[i] * kk4[i]; ss += kf[i] * kf[i]; }
        ss = red16(ss);
        const float inv = 1.f / fmaxf(sqrtf(ss), 1e-12f);
        f32x4 na, bb, kp, d;
#pragma unroll
        for (int i = 0; i < 4; ++i) { const float q = kf[i] * inv; na[i] = -q; bb[i] = q * a[i]; kp[i] = k[i] * (1.f + (a[i] - 1.f) * ka4[i]); d[i] = fexp(w[i]); }
        LAS unsigned char* sp = lds + FS_SBUF + bufi * FS_SBYTES + lj * FS_STEP;
        *(LAS h4*)(sp + 8 * lg) = (h4){(_Float16)r[0], (_Float16)r[1], (_Float16)r[2], (_Float16)r[3]};
        *(LAS h4*)(sp + 128 + 8 * lg) = (h4){(_Float16)kp[0], (_Float16)kp[1], (_Float16)kp[2], (_Float16)kp[3]};
        *(LAS h4*)(sp + 256 + 8 * lg) = (h4){(_Float16)na[0], (_Float16)na[1], (_Float16)na[2], (_Float16)na[3]};
        *(LAS h4*)(sp + 384 + 8 * lg) = (h4){(_Float16)bb[0], (_Float16)bb[1], (_Float16)bb[2], (_Float16)bb[3]};
        *(LAS f32x4*)(sp + 512 + 16 * lg) = d;
        if (lg < 8) *(LAS f32x4*)(sp + 768 + 16 * lg) = (f32x4){bflo(g_v.x), bfhi(g_v.x), bflo(g_v.y), bfhi(g_v.y)};
    };
    auto flush_chunk = [&](int c, int bufi) {
        const LAS float* ob = (const LAS float*)(lds + FS_OBUF + bufi * FS_OBYTES) + lj * 256 + 16 * lg;
        const f32x4 x0 = *(const LAS f32x4*)ob, x1 = *(const LAS f32x4*)(ob + 4), x2 = *(const LAS f32x4*)(ob + 8), x3 = *(const LAS f32x4*)(ob + 12);
        const float ra = ((x0[0] + x0[1]) + (x0[2] + x0[3])) + ((x1[0] + x1[1]) + (x1[2] + x1[3])), rb = ((x2[0] + x2[1]) + (x2[2] + x2[3])) + ((x3[0] + x3[1]) + (x3[2] + x3[3]));
        *(unsigned*)(OUT + (size_t)tok(c, lj) * 512 + sh * 64 + half * 32 + 2 * lg) = pk2(ra, rb);
    };
    float Sx[8];
#pragma unroll
    for (int i = 0; i < 8; ++i) Sx[i] = 0.f;
    const int rowl = (wid & 3) * 8 + (lane >> 3), jj = lane & 7;
    const int at = tid & 255;
    const int qb = F.bid & 15, bh0 = F.bid >> 4;
    auto kptr = [&](int ss_) { const int bh = bh0 + 16 * (ss_ >> 6); return (const v4u*)((const bf16*)(F.ws + WS_K) + (size_t)bh * SEQ * 96) + (size_t)(ss_ & 63) * 768; };
    auto vptr = [&](int ss_, int c) { const int bh = bh0 + 16 * (ss_ >> 6); return (const v4u*)((const bf16*)(F.ws + WS_VT) + (size_t)bh * 64 * SEQ + (size_t)(c >> 3) * SEQ + (c & 7) * 8 + (ss_ & 63) * 64); };
    auto klds = [&](int c) { return (c / 12) * AK_STRIDE + (c % 12) * 16; };
    auto vlds = [&](int c) { return AV_OFF + (c >> 3) * FV_STRIDE + ((c & 7) >> 1) * 32 + (c & 1) * 8; };
    v4u sk0, sk1, sk2, sv0, sv1;
    __syncthreads();
    if (loader) {
        if (MODE & 2) {
        const v4u* kg = kptr(0); sk0 = kg[at]; sk1 = kg[at + 256]; sk2 = kg[at + 512]; sv0 = *vptr(0, at); sv1 = *vptr(0, at + 256);
        *(LAS v4u*)(lds + klds(at)) = sk0; *(LAS v4u*)(lds + klds(at + 256)) = sk1; *(LAS v4u*)(lds + klds(at + 512)) = sk2;
        *(LAS v2u*)(lds + vlds(at)) = (v2u){sv0.x, sv0.y}; *(LAS v2u*)(lds + vlds(at) + 16) = (v2u){sv0.z, sv0.w};
        *(LAS v2u*)(lds + vlds(at + 256)) = (v2u){sv1.x, sv1.y}; *(LAS v2u*)(lds + vlds(at + 256) + 16) = (v2u){sv1.z, sv1.w}; }
    }
    if (stager && (MODE & 1)) { issue_chunk(0); commit_chunk(0); issue_chunk(1); }
    SC_BAR();
    if (loader) {
        __builtin_amdgcn_s_setprio(3);
        for (int ss = 0; ss < 256; ++ss) {
            const int cur = ss & 1, nxt = cur ^ 1;
            if ((MODE & 2) && ss + 1 < 256) { const v4u* kgn = kptr(ss + 1); sk0 = kgn[at]; sk1 = kgn[at + 256]; sk2 = kgn[at + 512]; sv0 = *vptr(ss + 1, at); sv1 = *vptr(ss + 1, at + 256); }
            const LAS unsigned char* base = lds + FS_SBUF + cur * FS_SBYTES + 16 * jj; LAS float* ob = (LAS float*)(lds + FS_OBUF + cur * FS_OBYTES) + (tid & 255);
#define SC_LOAD(X, j) do { const LAS unsigned char* p_ = base + (j) * FS_STEP; \
                X##r = *(const LAS v4u*)p_; X##k = *(const LAS v4u*)(p_ + 128); X##a = *(const LAS v4u*)(p_ + 256); X##b = *(const LAS v4u*)(p_ + 384); \
                X##w0 = *(const LAS f32x4*)(p_ + 512 + 16 * jj); X##w1 = *(const LAS f32x4*)(p_ + 528 + 16 * jj); X##v = *(const LAS float*)(p_ + 768 - 16 * jj + 4 * rowl); } while (0)
#define SC_EL(X, i, d, hl, wv) do { float u_ = mixmul<hl>(X##k[d], X##v); u_ = mixfma<hl>(X##b[d], sa_, u_); Sx[i] = fmaf(Sx[i], wv, u_); } while (0)
#define SC_COMP(X, j) do { \
                float t0_ = mixmul<0>(X##a[0], Sx[0]), t1_ = mixmul<1>(X##a[0], Sx[1]); t0_ = mixfma<0>(X##a[1], Sx[2], t0_); t1_ = mixfma<1>(X##a[1], Sx[3], t1_); \
                t0_ = mixfma<0>(X##a[2], Sx[4], t0_); t1_ = mixfma<1>(X##a[2], Sx[5], t1_); t0_ = mixfma<0>(X##a[3], Sx[6], t0_); t1_ = mixfma<1>(X##a[3], Sx[7], t1_); \
                const float sa_ = red8(t0_ + t1_); \
                SC_EL(X, 0, 0, 0, X##w0[0]); SC_EL(X, 1, 0, 1, X##w0[1]); SC_EL(X, 2, 1, 0, X##w0[2]); SC_EL(X, 3, 1, 1, X##w0[3]); \
                SC_EL(X, 4, 2, 0, X##w1[0]); SC_EL(X, 5, 2, 1, X##w1[1]); SC_EL(X, 6, 3, 0, X##w1[2]); SC_EL(X, 7, 3, 1, X##w1[3]); \
                float q0_ = mixmul<0>(X##r[0], Sx[0]), q1_ = mixmul<1>(X##r[0], Sx[1]); q0_ = mixfma<0>(X##r[1], Sx[2], q0_); q1_ = mixfma<1>(X##r[1], Sx[3], q1_); \
                q0_ = mixfma<0>(X##r[2], Sx[4], q0_); q1_ = mixfma<1>(X##r[2], Sx[5], q1_); q0_ = mixfma<0>(X##r[3], Sx[6], q0_); q1_ = mixfma<1>(X##r[3], Sx[7], q1_); \
                ob[(j) * 256] = q0_ + q1_; } while (0)
            v4u Ar, Ak, Aa, Ab, Br, Bk, Ba, Bb; f32x4 Aw0, Aw1, Bw0, Bw1; float Av, Bv;
            if (MODE & 1) {
            SC_LOAD(A, 0);
#pragma unroll
            for (int j = 0; j < 16; j += 2) {
                SC_LOAD(B, j + 1);
                __builtin_amdgcn_sched_barrier(0);
                SC_COMP(A, j);
                if (j + 2 < 16) SC_LOAD(A, j + 2);
                __builtin_amdgcn_sched_barrier(0);
                SC_COMP(B, j + 1);
            }
            }
#undef SC_LOAD
#undef SC_EL
#undef SC_COMP
            if ((MODE & 2) && ss + 1 < 256) { LAS unsigned char* kn = lds + nxt * AK_BYTES; LAS unsigned char* vn = lds + nxt * FV_BYTES;
                *(LAS v4u*)(kn + klds(at)) = sk0; *(LAS v4u*)(kn + klds(at + 256)) = sk1; *(LAS v4u*)(kn + klds(at + 512)) = sk2;
                *(LAS v2u*)(vn + vlds(at)) = (v2u){sv0.x, sv0.y}; *(LAS v2u*)(vn + vlds(at) + 16) = (v2u){sv0.z, sv0.w};
                *(LAS v2u*)(vn + vlds(at + 256)) = (v2u){sv1.x, sv1.y}; *(LAS v2u*)(vn + vlds(at + 256) + 16) = (v2u){sv1.z, sv1.w}; }
            SC_BAR();
        }
        __builtin_amdgcn_s_setprio(0);
    } else {
        bf16x8 qf[2][6]; float mrun[2], lrun[2]; f32x16 o0[2], o1[2];
        const int aw = wid - 4;
        for (int ss = 0; ss < 256; ++ss) {
            const int t = ss & 63, bh = bh0 + 16 * (ss >> 6), cur = ss & 1, nxt = cur ^ 1;
            if ((MODE & 1) && ss + 1 < 256) commit_chunk(nxt);
            if ((MODE & 1) && ss + 2 < 256) issue_chunk(ss + 2);
            if ((MODE & 1) && ss > 0) flush_chunk(ss - 1, nxt);
            if (MODE & 2) {
            if (t == 0) {
#pragma unroll
                for (int qq = 0; qq < 2; ++qq) { const bf16* Qp = (const bf16*)(F.ws + WS_Q) + ((size_t)bh * SEQ + qb * 256 + aw * 64 + qq * 32 + r32) * 96;
#pragma unroll
                    for (int d0 = 0; d0 < 6; ++d0) qf[qq][d0] = *(const bf16x8*)(Qp + 16 * d0 + 8 * hi);
                    mrun[qq] = -1e30f; lrun[qq] = 0.f; o0[qq] = (f32x16){}; o1[qq] = (f32x16){}; } }
            const LAS unsigned char* kb_ = lds + cur * AK_BYTES; const LAS unsigned char* vb_ = lds + AV_OFF + cur * FV_BYTES;
#pragma unroll
            for (int qq = 0; qq < 2; ++qq) {
                f32x16 p0, p1;
#pragma unroll
                for (int r = 0; r < 16; ++r) { p0[r] = -8.f; p1[r] = -8.f; }
#pragma unroll
                for (int d0 = 0; d0 < 6; ++d0) {
                    const bf16x8 a0 = *(const LAS bf16x8*)(kb_ + r32 * AK_STRIDE + 32 * d0 + 16 * hi), a1 = *(const LAS bf16x8*)(kb_ + (32 + r32) * AK_STRIDE + 32 * d0 + 16 * hi);
                    p0 = MFMA32(a0, qf[qq][d0], p0); p1 = MFMA32(a1, qf[qq][d0], p1); }
                float ls = 0.f;
#pragma unroll
                for (int r = 0; r < 16; ++r) { p0[r] = __builtin_amdgcn_exp2f(p0[r]); p1[r] = __builtin_amdgcn_exp2f(p1[r]); ls += p0[r] + p1[r]; }
                lrun[qq] += ls;
                v4u pb[4];
                pb[0] = (v4u){pk2(p0[0], p0[1]), pk2(p0[2], p0[3]), pk2(p0[4], p0[5]), pk2(p0[6], p0[7])};
                pb[1] = (v4u){pk2(p0[8], p0[9]), pk2(p0[10], p0[11]), pk2(p0[12], p0[13]), pk2(p0[14], p0[15])};
                pb[2] = (v4u){pk2(p1[0], p1[1]), pk2(p1[2], p1[3]), pk2(p1[4], p1[5]), pk2(p1[6], p1[7])};
                pb[3] = (v4u){pk2(p1[8], p1[9]), pk2(p1[10], p1[11]), pk2(p1[12], p1[13]), pk2(p1[14], p1[15])};
#pragma unroll
                for (int sl = 0; sl < 4; ++sl) {
                    const LAS unsigned char* va = vb_ + r32 * FV_STRIDE + 32 * sl + 16 * hi;
                    const bf16x8 vx = *(const LAS bf16x8*)va, vy = *(const LAS bf16x8*)(va + 32 * FV_STRIDE);
                    const bf16x8 pbf = __builtin_bit_cast(bf16x8, pb[sl]);
                    o0[qq] = MFMA32(vx, pbf, o0[qq]);
                    o1[qq] = MFMA32(vy, pbf, o1[qq]); }
                if (t == 63) {
                    const float lt_ = lrun[qq] + __shfl_xor(lrun[qq], 32);
                    const float inv = 1.f / lt_;
                    bf16* op = (bf16*)(F.ws + WS_OA) + ((size_t)(bh >> 3) * SEQ + qb * 256 + aw * 64 + qq * 32 + r32) * 512 + (bh & 7) * 64;
#pragma unroll
                    for (int g4 = 0; g4 < 4; ++g4) {
                        *(v2u*)(op + 8 * g4 + 4 * hi) = (v2u){pk2(o0[qq][4 * g4] * inv, o0[qq][4 * g4 + 1] * inv), pk2(o0[qq][4 * g4 + 2] * inv, o0[qq][4 * g4 + 3] * inv)};
                        *(v2u*)(op + 32 + 8 * g4 + 4 * hi) = (v2u){pk2(o1[qq][4 * g4] * inv, o1[qq][4 * g4 + 1] * inv), pk2(o1[qq][4 * g4 + 2] * inv, o1[qq][4 * g4 + 3] * inv)}; } }
            }
            }
            SC_BAR();
        }
        if (MODE & 1) flush_chunk(255, 1);
    }
    __syncthreads();
}

template <int MODE> __device__ __forceinline__ void p4_fused2(Frame& F) {
    const int tid = F.tid, lane = F.lane, wid = F.wave, r32 = lane & 31, hi = lane >> 5;
    LAS unsigned char* lds = F.lds;
    const int item = F.bid, sb = item >> 5, sh = (item >> 2) & 7, dir = (item >> 1) & 1, half = item & 1;
    const bf16* RKV = (const bf16*)(F.ws + WS_RKV); const bf16* ASIG = (const bf16*)(F.ws + WS_ASIG);
    const bf16* DEC = (const bf16*)(F.ws + (dir ? WS_DECB : WS_DECF)); bf16* OUT = (bf16*)(F.ws + (dir ? WS_OB : WS_OF));
    const bool isScan = wid < 2, isHelp = (wid == 2) || (wid == 3);
    const int ht = tid & 127, lj = ht >> 3, lg = ht & 7;
    const int qb = F.bid & 15, bh0 = F.bid >> 4;
    auto tok = [&](int c, int j) { const int s = dir ? (SEQ - 1 - (16 * c + j)) : (16 * c + j); return sb * SEQ + s; };
    auto kptr = [&](int ss_) { const int bh = bh0 + 16 * (ss_ >> 6); return (const v4u*)((const bf16*)(F.ws + WS_K) + (size_t)bh * SEQ * 96) + (size_t)(ss_ & 63) * 768; };
    auto vptr = [&](int ss_, int c) { const int bh = bh0 + 16 * (ss_ >> 6); return (const v4u*)((const bf16*)(F.ws + WS_VT) + (size_t)bh * 64 * SEQ + (size_t)(c >> 3) * SEQ + (c & 7) * 8 + (ss_ & 63) * 64); };
    auto klds = [&](int c) { return (c / 12) * AK_STRIDE + (c % 12) * 16; };
    auto vlds = [&](int c) { return AV_OFF + (c >> 3) * AV_STRIDE + (c & 7) * 16; };
    __syncthreads();
    if (isHelp) {
        float kk8[8], ka8[8];
#pragma unroll
        for (int i = 0; i < 8; ++i) { kk8[i] = F.in[19][sh * 64 + 8 * lg + i]; ka8[i] = F.in[20][sh * 64 + 8 * lg + i]; }
        v4u g_r8, g_k8, g_a8, g_w8, g_v8 = {0u, 0u, 0u, 0u};
        v4u sk[6], sv[4];
        auto issue_chunk = [&](int c) {
            const size_t m = (size_t)tok(c, lj); const int col = sh * 64 + 8 * lg;
            g_r8 = *(const v4u*)(RKV + m * 1536 + col); g_k8 = *(const v4u*)(RKV + m * 1536 + 512 + col); g_a8 = *(const v4u*)(ASIG + m * 512 + col); g_w8 = *(const v4u*)(DEC + m * 512 + col);
            if (lg < 4) g_v8 = *(const v4u*)(RKV + m * 1536 + 1024 + sh * 64 + half * 32 + 8 * lg);
        };
        auto commit_chunk = [&](int bufi) {
            f32x4 r0, r1, k0, k1, a0, a1, w0, w1; unpack8(g_r8, r0, r1); unpack8(g_k8, k0, k1); unpack8(g_a8, a0, a1); unpack8(g_w8, w0, w1);
            float kf[8], ss = 0.f;
#pragma unroll
            for (int i = 0; i < 4; ++i) { kf[i] = k0[i] * kk8[i]; kf[4 + i] = k1[i] * kk8[4 + i]; }
#pragma unroll
            for (int i = 0; i < 8; ++i) ss += kf[i] * kf[i];
            ss = red8(ss);
            const float inv = 1.f / fmaxf(sqrtf(ss), 1e-12f);
            f32x4 na0, na1, bb0, bb1, kp0, kp1, d0, d1;
#pragma unroll
            for (int i = 0; i < 4; ++i) { const float q0 = kf[i] * inv, q1 = kf[4 + i] * inv; na0[i] = -q0; na1[i] = -q1; bb0[i] = q0 * a0[i]; bb1[i] = q1 * a1[i];
                kp0[i] = k0[i] * (1.f + (a0[i] - 1.f) * ka8[i]); kp1[i] = k1[i] * (1.f + (a1[i] - 1.f) * ka8[4 + i]); d0[i] = fexp(w0[i]); d1[i] = fexp(w1[i]); }
            LAS float* sp = (LAS float*)(lds + FS_SBUF + bufi * FS_SBYTES + lj * SC_STEP) + 8 * lg;
            *(LAS f32x4*)(sp) = r0; *(LAS f32x4*)(sp + 4) = r1; *(LAS f32x4*)(sp + 64) = d0; *(LAS f32x4*)(sp + 68) = d1; *(LAS f32x4*)(sp + 128) = kp0; *(LAS f32x4*)(sp + 132) = kp1;
            *(LAS f32x4*)(sp + 192) = na0; *(LAS f32x4*)(sp + 196) = na1; *(LAS f32x4*)(sp + 256) = bb0; *(LAS f32x4*)(sp + 260) = bb1;
            if (lg < 4) { f32x4 v0, v1; unpack8(g_v8, v0, v1); *(LAS f32x4*)(sp + 320) = v0; *(LAS f32x4*)(sp + 324) = v1; }
        };
        auto flush_chunk = [&](int c, int bufi) {
            const LAS float* ob = (const LAS float*)(lds + FS_OBUF + bufi * FS_OBYTES) + lj * 256 + 32 * lg;
            float rs[4];
#pragma unroll
            for (int q = 0; q < 4; ++q) { const f32x4 x0 = *(const LAS f32x4*)(ob + 8 * q), x1 = *(const LAS f32x4*)(ob + 8 * q + 4); rs[q] = ((x0[0] + x0[1]) + (x0[2] + x0[3])) + ((x1[0] + x1[1]) + (x1[2] + x1[3])); }
            *(v2u*)(OUT + (size_t)tok(c, lj) * 512 + sh * 64 + half * 32 + 4 * lg) = (v2u){pk2(rs[0], rs[1]), pk2(rs[2], rs[3])};
        };
        auto kv_issue = [&](int ss_) { const v4u* kg = kptr(ss_);
#pragma unroll
            for (int i = 0; i < 6; ++i) sk[i] = kg[ht + 128 * i];
#pragma unroll
            for (int i = 0; i < 4; ++i) sv[i] = *vptr(ss_, ht + 128 * i); };
        auto kv_commit = [&](int bufi) { LAS unsigned char* kn = lds + bufi * AK_BYTES; LAS unsigned char* vn = lds + bufi * AV_BYTES;
#pragma unroll
            for (int i = 0; i < 6; ++i) *(LAS v4u*)(kn + klds(ht + 128 * i)) = sk[i];
#pragma unroll
            for (int i = 0; i < 4; ++i) { *(LAS v2u*)(vn + vlds(ht + 128 * i)) = (v2u){sv[i].x, sv[i].y}; *(LAS v2u*)(vn + vlds(ht + 128 * i) + 8) = (v2u){sv[i].z, sv[i].w}; } };
        if (MODE & 2) { kv_issue(0); kv_commit(0); }
        if (MODE & 1) { issue_chunk(0); commit_chunk(0); issue_chunk(1); }
        SC_BAR();
        for (int ss = 0; ss < 256; ++ss) {
            const int nxt = (ss & 1) ^ 1;
            if ((MODE & 2) && ss + 1 < 256) kv_issue(ss + 1);
            if ((MODE & 1) && ss + 1 < 256) commit_chunk(nxt);
            if ((MODE & 1) && ss + 2 < 256) issue_chunk(ss + 2);
            if ((MODE & 1) && ss > 0) flush_chunk(ss - 1, nxt);
            if ((MODE & 2) && ss + 1 < 256) kv_commit(nxt);
            SC_BAR();
        }
        if (MODE & 1) flush_chunk(255, 1);
    } else if (isScan) {
        __builtin_amdgcn_s_setprio(3);
        f32x2 SA[4], SB[4];
#pragma unroll
        for (int i = 0; i < 4; ++i) { SA[i] = (f32x2){0.f, 0.f}; SB[i] = (f32x2){0.f, 0.f}; }
        const int jj = lane & 7, rowA = wid * 16 + (lane >> 3), rowB = rowA + 8;
        SC_BAR();
        for (int ss = 0; ss < 256; ++ss) {
            const int cur = ss & 1;
            if (MODE & 1) {
            const LAS float* base = (const LAS float*)(lds + FS_SBUF + cur * FS_SBYTES) + 8 * jj; LAS float* ob = (LAS float*)(lds + FS_OBUF + cur * FS_OBYTES) + wid * 128 + lane;
#define SC_LOAD(X, j) do { const LAS float* p_ = base + (j) * (SC_STEP / 4); \
                X##r0 = *(const LAS f32x4*)p_; X##r1 = *(const LAS f32x4*)(p_ + 4); X##w0 = *(const LAS f32x4*)(p_ + 64); X##w1 = *(const LAS f32x4*)(p_ + 68); X##k0 = *(const LAS f32x4*)(p_ + 128); X##k1 = *(const LAS f32x4*)(p_ + 132); \
                X##a0 = *(const LAS f32x4*)(p_ + 192); X##a1 = *(const LAS f32x4*)(p_ + 196); X##b0 = *(const LAS f32x4*)(p_ + 256); X##b1 = *(const LAS f32x4*)(p_ + 260); \
                X##va = p_[320 - 8 * jj + rowA]; X##vb = p_[320 - 8 * jj + rowB]; } while (0)
#define SC_ROW(S, X, vv, oidx) do { \
                f32x2 t_ = S[0] * (f32x2){X##a0[0], X##a0[1]} + S[1] * (f32x2){X##a0[2], X##a0[3]}; f32x2 t2_ = S[2] * (f32x2){X##a1[0], X##a1[1]} + S[3] * (f32x2){X##a1[2], X##a1[3]}; t_ = t_ + t2_; \
                const float sa_ = red8(t_.x + t_.y); const f32x2 sa2_ = {sa_, sa_}, v2_ = {vv, vv}; \
                S[0] = S[0] * (f32x2){X##w0[0], X##w0[1]} + (sa2_ * (f32x2){X##b0[0], X##b0[1]} + v2_ * (f32x2){X##k0[0], X##k0[1]}); \
                S[1] = S[1] * (f32x2){X##w0[2], X##w0[3]} + (sa2_ * (f32x2){X##b0[2], X##b0[3]} + v2_ * (f32x2){X##k0[2], X##k0[3]}); \
                S[2] = S[2] * (f32x2){X##w1[0], X##w1[1]} + (sa2_ * (f32x2){X##b1[0], X##b1[1]} + v2_ * (f32x2){X##k1[0], X##k1[1]}); \
                S[3] = S[3] * (f32x2){X##w1[2], X##w1[3]} + (sa2_ * (f32x2){X##b1[2], X##b1[3]} + v2_ * (f32x2){X##k1[2], X##k1[3]}); \
                f32x2 q_ = S[0] * (f32x2){X##r0[0], X##r0[1]} + S[1] * (f32x2){X##r0[2], X##r0[3]}; f32x2 q2_ = S[2] * (f32x2){X##r1[0], X##r1[1]} + S[3] * (f32x2){X##r1[2], X##r1[3]}; q_ = q_ + q2_; \
                ob[(oidx)] = q_.x + q_.y; } while (0)
#define SC_COMP(X, j) do { SC_ROW(SA, X, X##va, (j) * 256); SC_ROW(SB, X, X##vb, (j) * 256 + 64); } while (0)
            f32x4 Ar0, Ar1, Aw0, Aw1, Ak0, Ak1, Aa0, Aa1, Ab0, Ab1, Br0, Br1, Bw0, Bw1, Bk0, Bk1, Ba0, Ba1, Bb0, Bb1; float Ava, Avb, Bva, Bvb;
            SC_LOAD(A, 0);
#pragma unroll
            for (int j = 0; j < 16; j += 2) {
                SC_LOAD(B, j + 1);
                __builtin_amdgcn_sched_barrier(0);
                SC_COMP(A, j);
                if (j + 2 < 16) SC_LOAD(A, j + 2);
                __builtin_amdgcn_sched_barrier(0);
                SC_COMP(B, j + 1);
            }
#undef SC_LOAD
#undef SC_ROW
#undef SC_COMP
            }
            SC_BAR();
        }
        __builtin_amdgcn_s_setprio(0);
    } else {
        SC_BAR();
        bf16x8 qf[2][6]; float mrun[2], lrun[2]; f32x16 o0[2], o1[2];
        const int aw = wid - 4;
        for (int ss = 0; ss < 256; ++ss) {
            const int t = ss & 63, bh = bh0 + 16 * (ss >> 6), cur = ss & 1;
            if (MODE & 2) {
            if (t == 0) {
#pragma unroll
                for (int qq = 0; qq < 2; ++qq) { const bf16* Qp = (const bf16*)(F.ws + WS_Q) + ((size_t)bh * SEQ + qb * 256 + aw * 64 + qq * 32 + r32) * 96;
#pragma unroll
                    for (int d0 = 0; d0 < 6; ++d0) qf[qq][d0] = *(const bf16x8*)(Qp + 16 * d0 + 8 * hi);
                    mrun[qq] = -1e30f; lrun[qq] = 0.f; o0[qq] = (f32x16){}; o1[qq] = (f32x16){}; } }
            const LAS unsigned char* kb_ = lds + cur * AK_BYTES; const LAS unsigned char* vb_ = lds + AV_OFF + cur * AV_BYTES;
#pragma unroll
            for (int qq = 0; qq < 2; ++qq) {
                f32x16 p0, p1;
#pragma unroll
                for (int r = 0; r < 16; ++r) { p0[r] = -8.f; p1[r] = -8.f; }
#pragma unroll
                for (int d0 = 0; d0 < 6; ++d0) {
                    const bf16x8 a0 = *(const LAS bf16x8*)(kb_ + r32 * AK_STRIDE + 32 * d0 + 16 * hi), a1 = *(const LAS bf16x8*)(kb_ + (32 + r32) * AK_STRIDE + 32 * d0 + 16 * hi);
                    p0 = MFMA32(a0, qf[qq][d0], p0); p1 = MFMA32(a1, qf[qq][d0], p1); }
                float ls = 0.f;
#pragma unroll
                for (int r = 0; r < 16; ++r) { p0[r] = __builtin_amdgcn_exp2f(p0[r]); p1[r] = __builtin_amdgcn_exp2f(p1[r]); ls += p0[r] + p1[r]; }
                lrun[qq] += ls;
                v4u pb[4];
                pb[0] = (v4u){pk2(p0[0], p0[1]), pk2(p0[2], p0[3]), pk2(p0[4], p0[5]), pk2(p0[6], p0[7])};
                pb[1] = (v4u){pk2(p0[8], p0[9]), pk2(p0[10], p0[11]), pk2(p0[12], p0[13]), pk2(p0[14], p0[15])};
                pb[2] = (v4u){pk2(p1[0], p1[1]), pk2(p1[2], p1[3]), pk2(p1[4], p1[5]), pk2(p1[6], p1[7])};
                pb[3] = (v4u){pk2(p1[8], p1[9]), pk2(p1[10], p1[11]), pk2(p1[12], p1[13]), pk2(p1[14], p1[15])};
#pragma unroll
                for (int sl = 0; sl < 4; ++sl) {
                    const LAS unsigned char* va = vb_ + r32 * AV_STRIDE + 2 * (16 * sl + 4 * hi);
                    const v2u x0 = *(const LAS v2u*)va, x1 = *(const LAS v2u*)(va + 16), y0 = *(const LAS v2u*)(va + 32 * AV_STRIDE), y1 = *(const LAS v2u*)(va + 32 * AV_STRIDE + 16);
                    const bf16x8 pbf = __builtin_bit_cast(bf16x8, pb[sl]);
                    o0[qq] = MFMA32(__builtin_bit_cast(bf16x8, ((v4u){x0.x, x0.y, x1.x, x1.y})), pbf, o0[qq]);
                    o1[qq] = MFMA32(__builtin_bit_cast(bf16x8, ((v4u){y0.x, y0.y, y1.x, y1.y})), pbf, o1[qq]); }
                if (t == 63) {
                    const float lt_ = lrun[qq] + __shfl_xor(lrun[qq], 32);
                    const float inv = 1.f / lt_;
                    bf16* op = (bf16*)(F.ws + WS_OA) + ((size_t)(bh >> 3) * SEQ + qb * 256 + aw * 64 + qq * 32 + r32) * 512 + (bh & 7) * 64;
#pragma unroll
                    for (int g4 = 0; g4 < 4; ++g4) {
                        *(v2u*)(op + 8 * g4 + 4 * hi) = (v2u){pk2(o0[qq][4 * g4] * inv, o0[qq][4 * g4 + 1] * inv), pk2(o0[qq][4 * g4 + 2] * inv, o0[qq][4 * g4 + 3] * inv)};
                        *(v2u*)(op + 32 + 8 * g4 + 4 * hi) = (v2u){pk2(o1[qq][4 * g4] * inv, o1[qq][4 * g4 + 1] * inv), pk2(o1[qq][4 * g4 + 2] * inv, o1[qq][4 * g4 + 3] * inv)}; } }
            }
            }
            SC_BAR();
        }
    }
    __syncthreads();
}

#define XB_TMO      128
#define XB_XCNT(j)  (256  + 64 * (j))
#define XB_XSUB(j)  (1280 + 64 * (j))
#define XB_XGEN(j)  (2304 + 64 * (j))
#define XB_TOP      3328
#define XB_TOPGEN   3392
#define XCD_BAR_WORDS 3456
#define XB_SPIN_CAP (1u << 18)

__device__ __forceinline__ unsigned xb_ld(unsigned* p)              { return __hip_atomic_load(p, __ATOMIC_RELAXED, __HIP_MEMORY_SCOPE_AGENT); }
__device__ __forceinline__ unsigned xb_add(unsigned* p, unsigned v) { return __hip_atomic_fetch_add(p, v, __ATOMIC_RELAXED, __HIP_MEMORY_SCOPE_AGENT); }
__device__ __forceinline__ unsigned xb_xcc_id() { return (unsigned)__builtin_amdgcn_s_getreg((3 << 11) | 20) & 0xFu; }
#define XB_SPIN(cond, bar) do { unsigned _sp = 0; while (cond) { __builtin_amdgcn_s_sleep(1); \
    if ((++_sp & 255u) == 0u) { if (xb_ld(&(bar)[XB_TMO])) break; if (_sp > XB_SPIN_CAP) { atomicAdd(&(bar)[XB_TMO], 1u); break; } } } } while (0)

struct XcdBarrier {
    unsigned* bar; unsigned x;
    volatile LAS unsigned* st;
};

__device__ __forceinline__ XcdBarrier xcd_barrier_post(unsigned* bar, volatile LAS unsigned* st) {
    XcdBarrier b; b.bar = bar; b.x = xb_xcc_id(); b.st = st;
    if (threadIdx.x == 0) (void)xb_add(&bar[XB_XCNT(b.x)], 1u);
    return b;
}
__device__ __forceinline__ void xcd_barrier_complete(unsigned* bar, unsigned x, unsigned& nloc, unsigned& nx) {
    const unsigned G = gridDim.x * gridDim.y * gridDim.z;
    unsigned sum, cnt, mine, sp = 0u;
    for (;;) {
        sum = 0u; cnt = 0u; mine = 0u;
#pragma unroll
        for (unsigned j = 0; j < 16; ++j) { const unsigned c = xb_ld(&bar[XB_XCNT(j)]); sum += c; cnt += (c > 0u) ? 1u : 0u; mine = (j == x) ? c : mine; }
        if (sum == G) break;
        __builtin_amdgcn_s_sleep(1);
        if ((++sp & 255u) == 0u) { if (xb_ld(&bar[XB_TMO])) break; if (sp > XB_SPIN_CAP) { atomicAdd(&bar[XB_TMO], 1u); break; } }
    }
    nloc = mine > 0u ? mine : 1u; nx = cnt > 0u ? cnt : 1u;
}

__device__ __forceinline__ void xcd_barrier(const XcdBarrier& b) {
    asm volatile("s_waitcnt vmcnt(0)" ::: "memory");
    __syncthreads();
    if (threadIdx.x == 0) {
        unsigned* bar = b.bar;
        __builtin_amdgcn_s_waitcnt(0);
        unsigned nloc = b.st[0], nx = b.st[1];
        if (nloc == 0u) { xcd_barrier_complete(bar, b.x, nloc, nx); b.st[0] = nloc; b.st[1] = nx; }
        const unsigned old = xb_add(&bar[XB_XSUB(b.x)], 1u);
        const unsigned gen = old / nloc;
        if (old + 1u == (gen + 1u) * nloc) {
            __builtin_amdgcn_fence(__ATOMIC_RELEASE, "agent");
            asm volatile("s_waitcnt vmcnt(0)" ::: "memory");
            const unsigned og = xb_add(&bar[XB_TOP], 1u);
            const unsigned tg = og / nx;
            if (og + 1u == (tg + 1u) * nx) xb_add(&bar[XB_TOPGEN], 1u);
            else XB_SPIN(xb_ld(&bar[XB_TOPGEN]) == tg, bar);
            __builtin_amdgcn_fence(__ATOMIC_ACQUIRE, "agent");
            xb_add(&bar[XB_XGEN(b.x)], 1u);
            asm volatile("s_waitcnt vmcnt(0)" ::: "memory");
        } else {
            XB_SPIN(xb_ld(&bar[XB_XGEN(b.x)]) == gen, bar);
            __builtin_amdgcn_fence(__ATOMIC_ACQUIRE, "agent");
            asm volatile("s_waitcnt vmcnt(0)" ::: "memory");
        }
    }
    __syncthreads();
}

constexpr int N_PHASES = 13;
__global__ void __launch_bounds__(512, 2) fwd_kernel(Args args) {
    extern __shared__ __attribute__((aligned(16))) unsigned char lds_raw[];
    cg::grid_group grid = cg::this_grid();
    Frame F;
    F.lds = (LAS unsigned char*)lds_raw;
    F.tid = threadIdx.x; F.lane = F.tid & 63; F.wave = __builtin_amdgcn_readfirstlane(F.tid >> 6); F.G = gridDim.x; F.bid = blockIdx.x;
#pragma unroll
    for (int i = 0; i < 32; ++i) F.in[i] = args.in[i];
    F.out = args.out; F.ws = args.ws;
    unsigned char* ws = args.ws;
    const int lo = args.ph_lo, hi = args.ph_hi;
#ifndef SKIPMASK
#define SKIPMASK 0
#endif
#define IN(k) (lo <= (k) && (k) < hi && !((SKIPMASK >> (k)) & 1))
    volatile LAS unsigned* xst = (volatile LAS unsigned*)(F.lds + 131072 + 64);
    if (F.tid == 0) { xst[0] = 0u; xst[1] = 0u; }
    __syncthreads();
    if (args.ph_hi < 0) grid.sync();
    const XcdBarrier xbar = xcd_barrier_post((unsigned*)ws, xst);
#define SEAM(k) do { if (IN(k) && IN((k) + 1)) { xcd_barrier(xbar); } } while (0)
#ifndef REPMASK
#define REPMASK 0
#endif
#define REP(k) for (int rep_ = 0; rep_ < 1 + ((REPMASK >> (k)) & 1); ++rep_)
    bf16* PG = (bf16*)F.out;
    if (IN(0)) REP(0) { p0_prologue(F); } SEAM(0);
    if (IN(1)) { run_gemm(F, (const bf16*)(ws + WS_XN), 1024, (const bf16*)(ws + WS_WIN), 1024, 4608, 1024, FnIn{PG, (bf16*)(ws + WS_PR), (bf16*)(ws + WS_PM), F.in[4]});
#ifdef DUP1
        run_gemm(F, (const bf16*)(ws + WS_XN), 1024, (const bf16*)(ws + WS_WIN), 1024, 4608, 1024, FnIn{PG, (bf16*)(ws + WS_PR), (bf16*)(ws + WS_PM), F.in[4]});
#endif
    } SEAM(1);
    if (IN(2)) REP(2) { if (!((SKIPMASK >> 13) & 1)) p2_shift(F); } SEAM(2);
    if (IN(3)) {
        if (!((SKIPMASK >> 14) & 1)) for (int it = F.bid; it < 256; it += F.G) mla_item(F, it);
        run_gemm(F, (const bf16*)(ws + WS_LI), 256, (const bf16*)(ws + WS_WL1), 128, 1024, 128, FnLora1{(bf16*)(ws + WS_ASIG), (bf16*)(ws + WS_DECF), F.in[16], F.in[14]});
        run_gemm(F, (const bf16*)(ws + WS_LI) + 128, 256, (const bf16*)(ws + WS_WL2), 128, 512, 128, FnLora2{(bf16*)(ws + WS_DECB), F.in[14] + 512});

#ifdef DUP3
#if DUP3 & 1
        if (!((SKIPMASK >> 14) & 1)) for (int it = F.bid; it < 256; it += F.G) mla_item(F, it);
#endif
#if DUP3 & 2
        run_gemm(F, (const bf16*)(ws + WS_LI), 256, (const bf16*)(ws + WS_WL1), 128, 1024, 128, FnLora1{(bf16*)(ws + WS_ASIG), (bf16*)(ws + WS_DECF), F.in[16], F.in[14]});
        run_gemm(F, (const bf16*)(ws + WS_LI) + 128, 256, (const bf16*)(ws + WS_WL2), 128, 512, 128, FnLora2{(bf16*)(ws + WS_DECB), F.in[14] + 512});


#endif
#endif
    } SEAM(3);
    if (IN(4)) {
#ifndef REP_SCAN
#define REP_SCAN 1
#endif
#ifndef REP_ATTN
#define REP_ATTN 1
#endif
#ifndef P4FORM
#define P4FORM 1
#endif
        if (F.G == 256) { if (P4FORM == 2) p4_fused2<3>(F); else p4_fused<3>(F);
#ifdef DUP4
            if (P4FORM == 2) p4_fused2<DUP4>(F); else p4_fused<DUP4>(F);
#endif
        }
        else {
        for (int rep = 0; rep < REP_SCAN; ++rep) for (int it = F.bid; it < 256; it += F.G) scan_item(F, it);
        for (int rep = 0; rep < REP_ATTN; ++rep) for (int u = F.bid; u < 1024; u += F.G) attn_unit(F, u >> 4, u & 15);
        }
    } SEAM(4);
    if (IN(5)) { p5_gn(F); } SEAM(5);
    if (IN(6)) {
        run_gemm(F, (const bf16*)(ws + WS_SG), 256, (const bf16*)(ws + WS_WGF), 128, 512, 128, FnMulAcc<0>{(bf16*)(ws + WS_OBC), 512, (const bf16*)(ws + WS_OF), 512, 0});
        run_gemm(F, (const bf16*)(ws + WS_SG) + 128, 256, (const bf16*)(ws + WS_WGB), 128, 512, 128, FnMulAcc<1>{(bf16*)(ws + WS_OBC), 512, (const bf16*)(ws + WS_OB), 512, 0});

#ifdef DUP67

        run_gemm(F, (const bf16*)(ws + WS_SG), 256, (const bf16*)(ws + WS_WGF), 128, 512, 128, FnMulAcc<0>{(bf16*)(ws + WS_OBC), 512, (const bf16*)(ws + WS_OF), 512, 0});
        run_gemm(F, (const bf16*)(ws + WS_SG) + 128, 256, (const bf16*)(ws + WS_WGB), 128, 512, 128, FnMulAcc<1>{(bf16*)(ws + WS_OBC), 512, (const bf16*)(ws + WS_OB), 512, 0});

#endif
    } SEAM(6);
    if (IN(7)) {
        run_gemm(F, (const bf16*)(ws + WS_OA), 512, (const bf16*)(ws + WS_WO), 1024, 1024, 512, FnMulAcc<0>{(bf16*)(ws + WS_M), 1024, PG, 2048, 0});
        run_gemm(F, (const bf16*)(ws + WS_OBC), 512, (const bf16*)(ws + WS_WO) + 512, 1024, 1024, 512, FnMulAcc<1>{(bf16*)(ws + WS_M), 1024, PG, 2048, 1024});

#ifdef DUP67

        run_gemm(F, (const bf16*)(ws + WS_OA), 512, (const bf16*)(ws + WS_WO), 1024, 1024, 512, FnMulAcc<0>{(bf16*)(ws + WS_M), 1024, PG, 2048, 0});
        run_gemm(F, (const bf16*)(ws + WS_OBC), 512, (const bf16*)(ws + WS_WO) + 512, 1024, 1024, 512, FnMulAcc<1>{(bf16*)(ws + WS_M), 1024, PG, 2048, 1024});

#endif
    } SEAM(7);
    if (IN(8)) { run_gemm(F, (const bf16*)(ws + WS_M), 1024, (const bf16*)(ws + WS_WM), 1024, 1024, 1024, FnResidNorm{F.in[0], F.out, (bf16*)(ws + WS_XN), (float*)(ws + WS_RSQ)}); } SEAM(8);
    if (IN(10)) { run_gemm(F, (const bf16*)(ws + WS_XN), 1024, (const bf16*)(ws + WS_WGU), 1024, 2816, 1024, FnStoreScaled{(bf16*)(ws + WS_GU), 2816, (const float*)(ws + WS_RSQ)});
#ifdef DUP10
        run_gemm(F, (const bf16*)(ws + WS_XN), 1024, (const bf16*)(ws + WS_WGU), 1024, 2816, 1024, FnStoreScaled{(bf16*)(ws + WS_GU), 2816, (const float*)(ws + WS_RSQ)});
#endif
    } SEAM(10);
    if (IN(11)) { run_gemm(F, (const bf16*)(ws + WS_XN), 1024, (const bf16*)(ws + WS_WGU) + (size_t)2816 * 1024, 1024, 2816, 1024, FnConvAct{(const bf16*)(ws + WS_GU), (bf16*)(ws + WS_ACT), F.in[29], F.in[30], (const float*)(ws + WS_RSQ)}); } SEAM(11);
    if (IN(12)) { run_gemm(F, (const bf16*)(ws + WS_ACT), 2816, (const bf16*)(ws + WS_WD), 2816, 1024, 2816, FnResidBf{(const bf16*)(ws + WS_XN), F.out}); }
#ifdef XSYNC
    for (int i = 0; i < XSYNC; ++i) xcd_barrier(xbar);
#endif
#undef IN
#undef SEAM
}

#ifndef MK_PER_PHASE
#define MK_PER_PHASE 0
#endif
extern "C" void kernel_launch(void* const* d_in, const int* in_sizes, int n_in, void* d_out, int out_size, void* d_ws, size_t ws_size, hipStream_t stream) {
    static int grid = 0;
    if (grid == 0) {
        if (n_in != 32 || out_size != NTOK * DM || ws_size < WS_END) { fprintf(stderr, "kernel_launch: unexpected problem (n_in %d out %d ws %zu)\n", n_in, out_size, ws_size); grid = -1; return; }
        int dev = 0, cus = 0, per_cu = 0;
        hipGetDevice(&dev); hipDeviceGetAttribute(&cus, hipDeviceAttributeMultiprocessorCount, dev);
        hipFuncSetAttribute((const void*)fwd_kernel, hipFuncAttributeMaxDynamicSharedMemorySize, LDS_BYTES);
        if (hipOccupancyMaxActiveBlocksPerMultiprocessor(&per_cu, (const void*)fwd_kernel, 512, LDS_BYTES) != hipSuccess || per_cu < 1) per_cu = 1;
        (void)hipGetLastError();
        grid = cus * per_cu;
    }
    if (grid < 0) return;
    Args a{};
    for (int i = 0; i < 32; ++i) a.in[i] = (const float*)d_in[i];
    a.out = (float*)d_out; a.ws = (unsigned char*)d_ws;
    if (hipMemsetAsync(d_ws, 0, 16384, stream) != hipSuccess) { fprintf(stderr, "kernel_launch: memset of the barrier word failed\n"); return; }
    void* params[] = {&a};
#if MK_PER_PHASE
    for (int p = 0; p < N_PHASES; ++p) { a.ph_lo = p; a.ph_hi = p + 1;
        hipError_t e = hipLaunchCooperativeKernel((void*)fwd_kernel, dim3(grid), dim3(512), params, LDS_BYTES, stream);
        if (e != hipSuccess) { fprintf(stderr, "launch %d failed: %s\n", p, hipGetErrorString(e)); break; } }
#else
    a.ph_lo = 0; a.ph_hi = N_PHASES;
    hipError_t e = hipLaunchCooperativeKernel((void*)fwd_kernel, dim3(grid), dim3(512), params, LDS_BYTES, stream);
    if (e != hipSuccess) fprintf(stderr, "cooperative launch failed: %s (grid %d)\n", hipGetErrorString(e), grid);
#endif
}
```

```cpp
#include <hip/hip_runtime.h>
#include <hip/hip_cooperative_groups.h>
#include <cstdio>
#include <cstdint>
namespace cg = cooperative_groups;
namespace pg8 {
#define PG8_LAS __attribute__((address_space(3)))
typedef unsigned short bf16_t;
typedef short bf16x8 __attribute__((ext_vector_type(8)));
typedef float f32x4 __attribute__((ext_vector_type(4)));
typedef unsigned u32x4 __attribute__((ext_vector_type(4)));
constexpr int BM = 256, BK = 64, HALF = 128, HTB = HALF * BK * 2  , STAGE_BYTES = 8 * HTB, NXCD = 8, WGM = 8;

__host__ __device__ __forceinline__ int lds_byte(int r, int c) { const int st = (r >> 4) * 2 + (c >> 5), rr = r & 15, cc = c & 31, ob = rr * 64 + cc * 2; return st * 1024 + (ob ^ (((ob >> 9) & 1) << 5)); }
__host__ __device__ __forceinline__ void stage_rc(int b, int& R, int& C) { const int st = b / 1024, sb = b % 1024, swz = sb ^ (((sb >> 9) & 1) << 5); R = (st >> 1) * 16 + swz / 64; C = (st & 1) * 32 + (swz % 64) / 2; }
__host__ __device__ __forceinline__ int perm32(int rho) { const int n = rho >> 4, i = rho & 15; return 8 * (i >> 2) + 4 * n + (i & 3); }

struct Unit { int pm, pn; };
struct Gemm { const bf16_t* A; const bf16_t* Bt; int M, N, K, lda, ldb; };

struct StaticOrder {
    int nM, nN, nwg, G, c;
    __host__ __device__ void init(int M, int N, int G_, int c_) { nM = M / BM; nN = N / BM; nwg = nM * nN; G = G_; c = c_; }
    __host__ __device__ bool next(int i, Unit& u) const {
        const long L = (long)i * G + c; if (L >= nwg) return false;
        int wgid = (int)L; { const int q = nwg / NXCD, r = nwg % NXCD, xcd = wgid % NXCD, off = wgid / NXCD; wgid = (xcd < r ? xcd * (q + 1) : r * (q + 1) + (xcd - r) * q) + off; }
        const int nig = WGM * nN, gid = wgid / nig, fm = gid * WGM, gsz = (nM - fm) < WGM ? (nM - fm) : WGM;
        u.pm = fm + ((wgid % nig) % gsz); u.pn = (wgid % nig) / gsz; return true;
    }
    __device__ __forceinline__ void a_ready(const Unit&) const {}
    __device__ __forceinline__ void done(const Unit&) const {}
};

__device__ __forceinline__ unsigned cvt_pk_bf16(float lo, float hi) { unsigned r; asm volatile("v_cvt_pk_bf16_f32 %0, %1, %2" : "=v"(r) : "v"(lo), "v"(hi)); return r; }
template <class Epi, class Sched, bool ALIGN_EPI = false, bool SP2 = false>
__device__ __forceinline__ void gemm_phase(PG8_LAS unsigned char* lds, const Gemm g, const Sched& S, const Epi& E) {
    const int tid = threadIdx.x, wid = __builtin_amdgcn_readfirstlane(tid >> 6), lane = tid & 63, wr = wid >> 2, wc = wid & 3, fr = lane & 15, fq = lane >> 4;
    const int K = g.K, nt = K / BK;
    unsigned voffA[2], voffB[2];
#pragma unroll
    for (int i = 0; i < 2; ++i) { int R, C; stage_rc(tid * 16 + i * 8192, R, C); const int Rb = Epi::PERM ? ((R & ~31) + perm32(R & 31)) : R;
        voffA[i] = (unsigned)(R * g.lda + C) * 2u; voffB[i] = (unsigned)(Rb * g.ldb + C) * 2u; }
    const size_t kstep = (size_t)(BK * 2);
    const size_t hstepA = (size_t)HALF * g.lda * 2, hstepB = (size_t)HALF * g.ldb * 2;
    const size_t tstepA = 2 * hstepA, tstepB = 2 * hstepB;
    const unsigned ldsw = (unsigned)wid * 1024u;
    const int aoff = lds_byte(wr * 64 + fr, fq * 8), boff = lds_byte(wc * 32 + fr, fq * 8);
#define PG8_SA(b, h) (((b) * 2 + (h)) * HTB)
#define PG8_SB(b, h) ((4 + (b) * 2 + (h)) * HTB)
#define PG8_STAGE(bufoff, gbase, voff) do { _Pragma("unroll") for (int _i = 0; _i < 2; ++_i) \
        __builtin_amdgcn_global_load_lds((const unsigned*)((const char*)(gbase) + (voff)[_i]), (PG8_LAS unsigned*)(lds + (bufoff) + ldsw + _i * 8192), 16, 0, 0); } while (0)
#define PG8_LDA(dst, b, h) do { _Pragma("unroll") for (int m = 0; m < 4; ++m) _Pragma("unroll") for (int k = 0; k < 2; ++k) dst[m][k] = *(const PG8_LAS bf16x8*)(lds + PG8_SA(b, h) + aoff + m * 2048 + k * 1024); } while (0)
#define PG8_LDB(dst, b, h) do { _Pragma("unroll") for (int n = 0; n < 2; ++n) _Pragma("unroll") for (int k = 0; k < 2; ++k) dst[n][k] = *(const PG8_LAS bf16x8*)(lds + PG8_SB(b, h) + boff + n * 2048 + k * 1024); } while (0)
#define PG8_MMA(ai, bj, At, Bt) do { __builtin_amdgcn_s_setprio(1); _Pragma("unroll") for (int m = 0; m < 4; ++m) _Pragma("unroll") for (int n = 0; n < 2; ++n) _Pragma("unroll") for (int k = 0; k < 2; ++k) \
        acc[ai][bj][m][n] = __builtin_amdgcn_mfma_f32_16x16x32_bf16(Bt[n][k], At[m][k], acc[ai][bj][m][n], 0, 0, 0); __builtin_amdgcn_s_setprio(0); } while (0)
#define PG8_WAIT_V(n) asm volatile("s_waitcnt vmcnt(" #n ")" ::: "memory")
#define PG8_WAIT_L(n) asm volatile("s_waitcnt lgkmcnt(" #n ")" ::: "memory")
#define PG8_BAR __builtin_amdgcn_s_barrier()
#define PG8_SCHED __builtin_amdgcn_sched_barrier(0)
    Unit cur, nxt; int ui = 0;
    if (!S.next(0, cur)) return;
    f32x4 acc[2][2][4][2];
#pragma unroll
    for (int a = 0; a < 2; ++a)
#pragma unroll
        for (int b = 0; b < 2; ++b)
#pragma unroll
            for (int m = 0; m < 4; ++m)
#pragma unroll
                for (int n = 0; n < 2; ++n) acc[a][b][m][n] = (f32x4){0.f, 0.f, 0.f, 0.f};
    bf16x8 At[4][2], B0[2][2], B1[2][2];
    const char* cA = (const char*)g.A + (size_t)cur.pm * tstepA; const char* cB = (const char*)g.Bt + (size_t)cur.pn * tstepB;
    S.a_ready(cur);
    if constexpr (SP2) {
        PG8_STAGE(PG8_SB(0, 0), cB, voffB); PG8_STAGE(PG8_SB(0, 1), cB + hstepB, voffB); PG8_STAGE(PG8_SA(0, 0), cA, voffA); PG8_STAGE(PG8_SA(0, 1), cA + hstepA, voffA);
        if (wr == 1) PG8_BAR;
        PG8_WAIT_V(2); PG8_BAR;
        PG8_STAGE(PG8_SB(1, 0), cB + kstep, voffB); PG8_STAGE(PG8_SA(1, 0), cA + kstep, voffA); PG8_STAGE(PG8_SB(1, 1), cB + hstepB + kstep, voffB);
        PG8_WAIT_V(6); PG8_BAR;
    } else {
        PG8_STAGE(PG8_SB(0, 0), cB, voffB); PG8_STAGE(PG8_SA(0, 0), cA, voffA); PG8_STAGE(PG8_SB(0, 1), cB + hstepB, voffB); PG8_STAGE(PG8_SA(0, 1), cA + hstepA, voffA);
        if (wr == 1) PG8_BAR;
        PG8_WAIT_V(4); PG8_BAR;
        PG8_STAGE(PG8_SB(1, 0), cB + kstep, voffB); PG8_STAGE(PG8_SA(1, 0), cA + kstep, voffA); PG8_STAGE(PG8_SB(1, 1), cB + hstepB + kstep, voffB);
        PG8_WAIT_V(6); PG8_BAR;
    }
    for (;;) {
        const bool has_next = S.next(ui + 1, nxt);
        const char* nA = has_next ? (const char*)g.A + (size_t)nxt.pm * tstepA : cA; const char* nB = has_next ? (const char*)g.Bt + (size_t)nxt.pn * tstepB : cB;
        for (int t = 0; t < nt; t += 2) {
            const bool last = (t == nt - 2);
            const char* a1 = cA + (size_t)(t + 1) * kstep;
            const char* a2 = last ? nA : cA + (size_t)(t + 2) * kstep; const char* b2 = last ? nB : cB + (size_t)(t + 2) * kstep;
            const char* a3 = a2 + kstep; const char* b3 = b2 + kstep;
            if (last && has_next) S.a_ready(nxt);
            if constexpr (SP2) {
            PG8_LDB(B0, 0, 0); PG8_LDB(B1, 0, 1); PG8_SCHED; PG8_LDA(At, 0, 0); PG8_STAGE(PG8_SA(1, 1), a1 + hstepA, voffA);
            PG8_WAIT_V(8); PG8_WAIT_L(0); PG8_BAR; PG8_MMA(0, 0, At, B0); PG8_MMA(0, 1, At, B1); PG8_BAR; PG8_SCHED;
            PG8_LDA(At, 0, 1); PG8_STAGE(PG8_SB(0, 0), b2, voffB); PG8_STAGE(PG8_SB(0, 1), b2 + hstepB, voffB); PG8_STAGE(PG8_SA(0, 0), a2, voffA);
            PG8_WAIT_V(8); PG8_WAIT_L(0); PG8_BAR; PG8_MMA(1, 0, At, B0); PG8_MMA(1, 1, At, B1); PG8_BAR; PG8_SCHED;
            PG8_LDB(B0, 1, 0); PG8_LDB(B1, 1, 1); PG8_SCHED; PG8_LDA(At, 1, 0); PG8_STAGE(PG8_SA(0, 1), a2 + hstepA, voffA);
            PG8_WAIT_V(8); PG8_WAIT_L(0); PG8_BAR; PG8_MMA(0, 0, At, B0); PG8_MMA(0, 1, At, B1); PG8_BAR; PG8_SCHED;
            PG8_LDA(At, 1, 1); PG8_STAGE(PG8_SB(1, 0), b3, voffB); PG8_STAGE(PG8_SB(1, 1), b3 + hstepB, voffB); PG8_STAGE(PG8_SA(1, 0), a3, voffA);
            PG8_WAIT_V(8); PG8_WAIT_L(0); PG8_BAR; PG8_MMA(1, 0, At, B0); PG8_MMA(1, 1, At, B1); PG8_BAR; PG8_SCHED;
            } else {
            PG8_LDB(B0, 0, 0); PG8_SCHED; PG8_LDA(At, 0, 0); PG8_STAGE(PG8_SA(1, 1), a1 + hstepA, voffA);
            PG8_WAIT_L(8); PG8_BAR; PG8_WAIT_L(0); PG8_MMA(0, 0, At, B0); PG8_BAR; PG8_SCHED;
            PG8_LDB(B1, 0, 1); PG8_STAGE(PG8_SB(0, 0), b2, voffB);
            PG8_BAR; PG8_WAIT_L(0); PG8_MMA(0, 1, At, B1); PG8_BAR;
            PG8_LDA(At, 0, 1); PG8_STAGE(PG8_SA(0, 0), a2, voffA);
            PG8_BAR; PG8_WAIT_L(0); PG8_MMA(1, 0, At, B0); PG8_BAR; PG8_SCHED;
            PG8_STAGE(PG8_SB(0, 1), b2 + hstepB, voffB);
            PG8_WAIT_V(6); PG8_BAR; PG8_MMA(1, 1, At, B1); PG8_BAR;
            PG8_LDB(B0, 1, 0); PG8_SCHED; PG8_LDA(At, 1, 0); PG8_STAGE(PG8_SA(0, 1), a2 + hstepA, voffA);
            PG8_WAIT_L(8); PG8_BAR; PG8_WAIT_L(0); PG8_MMA(0, 0, At, B0); PG8_BAR; PG8_SCHED;
            PG8_LDB(B1, 1, 1); PG8_STAGE(PG8_SB(1, 0), b3, voffB);
            PG8_BAR; PG8_WAIT_L(0); PG8_MMA(0, 1, At, B1); PG8_BAR;
            PG8_LDA(At, 1, 1); PG8_STAGE(PG8_SA(1, 0), a3, voffA);
            PG8_BAR; PG8_WAIT_L(0); PG8_MMA(1, 0, At, B0); PG8_BAR; PG8_SCHED;
            PG8_STAGE(PG8_SB(1, 1), b3 + hstepB, voffB);
            PG8_WAIT_V(6); PG8_BAR; PG8_MMA(1, 1, At, B1); PG8_BAR;
            }
        }
        if constexpr (ALIGN_EPI) { if (wr == 0) PG8_BAR; }
        if constexpr (!Epi::AFTER_DRAIN) { E(acc, cur, wr, wc, fr, fq); S.done(cur); }
        if (!has_next) break;
#pragma unroll
        for (int a = 0; a < 2; ++a)
#pragma unroll
            for (int b = 0; b < 2; ++b)
#pragma unroll
                for (int m = 0; m < 4; ++m)
#pragma unroll
                    for (int n = 0; n < 2; ++n) acc[a][b][m][n] = (f32x4){0.f, 0.f, 0.f, 0.f};
        cur = nxt; cA = nA; cB = nB; ++ui;
        if constexpr (ALIGN_EPI) { if (wr == 1) PG8_BAR; }
    }
    PG8_WAIT_V(0);
    if constexpr (!ALIGN_EPI) { if (wr == 0) PG8_BAR; }
    PG8_BAR;
    if constexpr (Epi::AFTER_DRAIN) { E.fused(acc, cur, wr, wc, fr, fq, lds, wid, lane); S.done(cur); }
#undef PG8_SA
#undef PG8_SB
#undef PG8_STAGE
#undef PG8_LDA
#undef PG8_LDB
#undef PG8_MMA
#undef PG8_WAIT_V
#undef PG8_WAIT_L
#undef PG8_BAR
#undef PG8_SCHED
}
}

#define GAS __attribute__((address_space(1)))
#define LAS __attribute__((address_space(3)))
typedef unsigned short bf16;
typedef unsigned v4u __attribute__((ext_vector_type(4)));
typedef unsigned v2u __attribute__((ext_vector_type(2)));
typedef float f32x4 __attribute__((ext_vector_type(4)));
typedef float f32x2 __attribute__((ext_vector_type(2)));
typedef float f32x16 __attribute__((ext_vector_type(16)));
typedef short bf16x8 __attribute__((ext_vector_type(8)));

constexpr int NTOK = 32768, SEQ = 4096, DM = 1024;
constexpr size_t MiB = 1u << 20;
constexpr size_t WS_WIN = 1 * MiB, WS_WUQ = 10 * MiB, WS_WUKV = 10 * MiB + 512 * 1024, WS_WL1 = 10 * MiB + 768 * 1024, WS_WL2 = 11 * MiB, WS_WGF = 11 * MiB + 128 * 1024,
                 WS_WGB = 11 * MiB + 256 * 1024, WS_WO = 12 * MiB, WS_WM = 14 * MiB, WS_WGU = 16 * MiB, WS_WD = 27 * MiB;
constexpr size_t WS_XN = 33 * MiB, WS_PR = 97 * MiB, WS_PM = 225 * MiB, WS_RKV = 257 * MiB, WS_LI = 353 * MiB, WS_SG = 369 * MiB, WS_VT = 385 * MiB, WS_OF = 417 * MiB, WS_OB = 449 * MiB;
constexpr size_t WS_ASIG = 33 * MiB, WS_DECF = 65 * MiB, WS_DECB = 97 * MiB, WS_Q = 129 * MiB, WS_K = 177 * MiB, WS_OA = 225 * MiB, WS_OBC = 65 * MiB, WS_M = 97 * MiB, WS_GU = 97 * MiB, WS_ACT = 273 * MiB;
constexpr size_t WS_END = 481 * MiB, WS_RSQ = 65536;
constexpr int LDS_BYTES = 135168;
constexpr float LOG2E = 1.4426950408889634f;
constexpr float QSCALE = 0.10206207261596575f * 1.4426950408889634f;

struct Args { const float* in[32]; float* out; unsigned char* ws; int ph_lo, ph_hi; };

typedef __bf16 bf16x2_t __attribute__((ext_vector_type(2)));
__device__ __forceinline__ unsigned pk2(float lo, float hi) { unsigned r; asm volatile("v_cvt_pk_bf16_f32 %0, %1, %2" : "=v"(r) : "v"(lo), "v"(hi)); return r; }
__device__ __forceinline__ unsigned pk2s(float lo, float hi) { const f32x2 v = {lo, hi}; return __builtin_bit_cast(unsigned, __builtin_convertvector(v, bf16x2_t)); }
__device__ __forceinline__ float bflo(unsigned u) { return __uint_as_float(u << 16); }
__device__ __forceinline__ float bfhi(unsigned u) { return __uint_as_float(u & 0xffff0000u); }
__device__ __forceinline__ float bf1(bf16 b) { return __uint_as_float((unsigned)b << 16); }
__device__ __forceinline__ float fexp(float x) { return __builtin_amdgcn_exp2f(x * LOG2E); }
__device__ __forceinline__ float sigm(float x) { return __builtin_amdgcn_rcpf(1.f + fexp(-x)); }
__device__ __forceinline__ float ftanh(float x) { return 1.f - 2.f * __builtin_amdgcn_rcpf(1.f + fexp(2.f * x)); }
__device__ __forceinline__ float wave_sum(float v) {
#pragma unroll
    for (int o = 1; o < 64; o <<= 1) v += __shfl_xor(v, o);
    return v;
}
template <int CTRL> __device__ __forceinline__ float dppf(float x) { return __int_as_float(__builtin_amdgcn_update_dpp(0, __float_as_int(x), CTRL, 0xf, 0xf, true)); }
__device__ __forceinline__ float red8(float x) { x += dppf<0xB1>(x); x += dppf<0x4E>(x); x += dppf<0x141>(x); return x; }
__device__ __forceinline__ int crow(int r, int hi) { return (r & 3) + 8 * (r >> 2) + 4 * hi; }

struct Frame {
    LAS unsigned char* lds;
    int tid, lane, wave, G, bid;
    const float* in[32]; float* out; unsigned char* ws;
};

__device__ __forceinline__ void tr_item(const float* W, int ldn, int nblk, bf16* WT, int ldk, LAS float* scr, int item, int lane, const float* ksc = nullptr) {
    const int kb = item / nblk, nb = item % nblk, k0 = 64 * kb, n0 = 32 * nb;
#pragma unroll 8
    for (int i = 0; i < 32; ++i) { const int kk = 2 * i + (lane >> 5); float w_ = W[(size_t)(k0 + kk) * ldn + n0 + (lane & 31)]; if (ksc) w_ *= ksc[k0 + kk]; scr[kk * 33 + (lane & 31)] = w_; }
    asm volatile("s_waitcnt lgkmcnt(0)" ::: "memory");
    const int c = lane & 7;
#pragma unroll
    for (int j = 0; j < 4; ++j) { const int n = (lane >> 3) + 8 * j; const LAS float* s = scr + (8 * c) * 33 + n;
        v4u o; o.x = pk2(s[0 * 33], s[1 * 33]); o.y = pk2(s[2 * 33], s[3 * 33]); o.z = pk2(s[4 * 33], s[5 * 33]); o.w = pk2(s[6 * 33], s[7 * 33]);
        *(v4u*)(WT + (size_t)(n0 + n) * ldk + k0 + 8 * c) = o; }
    asm volatile("s_waitcnt lgkmcnt(0)" ::: "memory");
}
__device__ __forceinline__ void rms_row(const float* xrow, const float* g, bf16* orow, int lane) {
    const f32x4* xr = (const f32x4*)xrow + lane; const f32x4* gr = (const f32x4*)g + lane;
    f32x4 v[4]; float s = 0.f;
#pragma unroll
    for (int j = 0; j < 4; ++j) { v[j] = xr[64 * j]; s += (v[j].x * v[j].x + v[j].y * v[j].y) + (v[j].z * v[j].z + v[j].w * v[j].w); }
    const float rstd = 1.f / sqrtf(wave_sum(s) * (1.f / 1024.f) + 1e-6f);
    v2u* o8 = (v2u*)orow + lane;
#pragma unroll
    for (int j = 0; j < 4; ++j) { const f32x4 gg = gr[64 * j]; v2u o; o.x = pk2(v[j].x * rstd * gg.x, v[j].y * rstd * gg.y); o.y = pk2(v[j].z * rstd * gg.z, v[j].w * rstd * gg.w); o8[64 * j] = o; }
}
__device__ __forceinline__ void zero_fill(Frame& F, bf16* p, int rows, int cols, int ld) {
    const int cpr = cols / 8, n = rows * cpr;
    for (int i = F.bid * 512 + F.tid; i < n; i += F.G * 512) { const int r = i / cpr, c = i % cpr; *(v4u*)(p + (size_t)r * ld + 8 * c) = (v4u){0u, 0u, 0u, 0u}; }
}
__device__ __forceinline__ void p0_prologue(Frame& F) {
    LAS float* scr = (LAS float*)(F.lds + F.wave * 16384);
    const int gw = F.bid * 8 + F.wave, NGW = F.G * 8;
    unsigned char* ws = F.ws;
    bf16* WIN = (bf16*)(ws + WS_WIN);
    constexpr int J0 = 16 * 13, J1 = J0 + 16 * 62, J2 = J1 + 16 * 64, J3 = J2 + 4 * 24, J4 = J3 + 2 * 32, J5 = J4 + 16, J6 = J5 + 16, J7 = J6 + 16, J8 = J7 + 32, J9 = J8 + 32,
                  J10 = J9 + 512, J11 = J10 + 512, J12 = J11 + 1408, J13 = J12 + 1408, J14 = J13 + 1408;
    for (int it = gw; it < J14; it += NGW) {
        if (it < J0) tr_item(F.in[3], 4448, 13, WIN + (size_t)4096 * 1024, 1024, scr, it, F.lane);
        else if (it < J1) tr_item(F.in[3] + 416, 4448, 62, WIN + (size_t)2048 * 1024, 1024, scr, it - J0, F.lane);
        else if (it < J2) tr_item(F.in[3] + 2400, 4448, 64, WIN, 1024, scr, it - J1, F.lane);
        else if (it < J3) tr_item(F.in[7], 768, 24, (bf16*)(ws + WS_WUQ), 256, scr, it - J2, F.lane);
        else if (it < J4) tr_item(F.in[8], 1024, 32, (bf16*)(ws + WS_WUKV), 128, scr, it - J3, F.lane);
        else if (it < J5) tr_item(F.in[17], 512, 16, (bf16*)(ws + WS_WL1), 128, scr, it - J4, F.lane);
        else if (it < J6) tr_item(F.in[15], 512, 16, (bf16*)(ws + WS_WL1) + 512 * 128 + 64, 128, scr, it - J5, F.lane);
        else if (it < J7) tr_item(F.in[15] + 64 * 512, 512, 16, (bf16*)(ws + WS_WL2), 128, scr, it - J6, F.lane);
        else if (it < J8) tr_item(F.in[18], 512, 16, (bf16*)(ws + WS_WGF), 128, scr, it - J7, F.lane);
        else if (it < J9) tr_item(F.in[18] + 128 * 512, 512, 16, (bf16*)(ws + WS_WGB), 128, scr, it - J8, F.lane);
        else if (it < J10) tr_item(F.in[24], 1024, 32, (bf16*)(ws + WS_WO), 1024, scr, it - J9, F.lane);
        else if (it < J11) tr_item(F.in[25], 1024, 32, (bf16*)(ws + WS_WM), 1024, scr, it - J10, F.lane);
        else if (it < J12) tr_item(F.in[27], 2816, 88, (bf16*)(ws + WS_WGU), 1024, scr, it - J11, F.lane, F.in[26]);
        else if (it < J13) tr_item(F.in[28], 2816, 88, (bf16*)(ws + WS_WGU) + (size_t)2816 * 1024, 1024, scr, it - J12, F.lane, F.in[26]);
        else tr_item(F.in[31], 1024, 32, (bf16*)(ws + WS_WD), 2816, scr, it - J13, F.lane);
    }
    zero_fill(F, WIN + (size_t)4032 * 1024, 64, 1024, 1024);
    zero_fill(F, WIN + (size_t)4512 * 1024, 96, 1024, 1024);
    zero_fill(F, (bf16*)(ws + WS_WL1) + 64, 512, 64, 128);
    zero_fill(F, (bf16*)(ws + WS_WL1) + 512 * 128, 512, 64, 128);
    zero_fill(F, (bf16*)(ws + WS_WL2) + 64, 512, 64, 128);
    for (int i = F.bid * 512 + F.tid; i < NTOK; i += F.G * 512) ((float*)(ws + WS_RSQ))[i] = 0.f;
    for (int m = gw; m < NTOK; m += NGW) rms_row(F.in[0] + (size_t)m * DM, F.in[2], (bf16*)(ws + WS_XN) + (size_t)m * DM, F.lane);
}

template <class Fn> struct Epi8 {
    static constexpr bool PERM = true, AFTER_DRAIN = false; Fn f;
    __device__ __forceinline__ void operator()(const pg8::f32x4 (&acc)[2][2][4][2], const pg8::Unit& u, int wr, int wc, int fr, int fq) const {
#pragma unroll
        for (int ai = 0; ai < 2; ++ai)
#pragma unroll
            for (int m = 0; m < 4; ++m)
#pragma unroll
                for (int bj = 0; bj < 2; ++bj) f(u.pm * 256 + ai * 128 + wr * 64 + m * 16 + fr, u.pn * 256 + bj * 128 + wc * 32 + 8 * fq, acc[ai][bj][m][0], acc[ai][bj][m][1]);
    }
};
__device__ __forceinline__ v4u pack8(f32x4 a, f32x4 b) { v4u w; w.x = pk2(a[0], a[1]); w.y = pk2(a[2], a[3]); w.z = pk2(b[0], b[1]); w.w = pk2(b[2], b[3]); return w; }
__device__ __forceinline__ v4u pack8s(f32x4 a, f32x4 b) { v4u w; w.x = pk2s(a[0], a[1]); w.y = pk2s(a[2], a[3]); w.z = pk2s(b[0], b[1]); w.w = pk2s(b[2], b[3]); return w; }
__device__ __forceinline__ void unpack8(v4u w, f32x4& a, f32x4& b) { a = (f32x4){bflo(w.x), bfhi(w.x), bflo(w.y), bfhi(w.y)}; b = (f32x4){bflo(w.z), bfhi(w.z), bflo(w.w), bfhi(w.w)}; }

struct FnIn {
    bf16* PG; bf16* PR; bf16* PM; const float* bg;
    __device__ __forceinline__ void operator()(int row, int col, f32x4 a, f32x4 b) const {
        if (col < 2048) { const f32x4 b0 = *(const f32x4*)(bg + col), b1 = *(const f32x4*)(bg + col + 4);
#pragma unroll
            for (int i = 0; i < 4; ++i) { a[i] = sigm(a[i] + b0[i]); b[i] = sigm(b[i] + b1[i]); }
            *(v4u*)(PG + (size_t)row * 2048 + col) = pack8(a, b); }
        else if (col < 4096) *(v4u*)(PR + (size_t)row * 2048 + (col - 2048)) = pack8(a, b);
        else *(v4u*)(PM + (size_t)row * 512 + (col - 4096)) = pack8(a, b);
    }
};
__device__ __forceinline__ float logdecay(float z) {
    const float x = -z, sp = fmaxf(x, 0.f) + __builtin_amdgcn_logf(1.f + fexp(-fabsf(x))) * 0.6931471805599453f;
    return -fexp(-sp - 0.5f);
}
struct FnLora1 {
    bf16* ASIG; bf16* DEC; const float* a0; const float* w0;
    __device__ __forceinline__ void operator()(int row, int col, f32x4 a, f32x4 b) const {
        if (col < 512) { const f32x4 b0 = *(const f32x4*)(a0 + col), b1 = *(const f32x4*)(a0 + col + 4);
#pragma unroll
            for (int i = 0; i < 4; ++i) { a[i] = sigm(a[i] + b0[i]); b[i] = sigm(b[i] + b1[i]); }
            *(v4u*)(ASIG + (size_t)row * 512 + col) = pack8(a, b); }
        else { const int c = col - 512; const f32x4 b0 = *(const f32x4*)(w0 + c), b1 = *(const f32x4*)(w0 + c + 4);
#pragma unroll
            for (int i = 0; i < 4; ++i) { a[i] = logdecay(a[i] + b0[i]); b[i] = logdecay(b[i] + b1[i]); }
            *(v4u*)(DEC + (size_t)row * 512 + c) = pack8(a, b); }
    }
};
struct FnLora2 {
    bf16* DEC; const float* w0;
    __device__ __forceinline__ void operator()(int row, int col, f32x4 a, f32x4 b) const {
        const f32x4 b0 = *(const f32x4*)(w0 + col), b1 = *(const f32x4*)(w0 + col + 4);
#pragma unroll
        for (int i = 0; i < 4; ++i) { a[i] = logdecay(a[i] + b0[i]); b[i] = logdecay(b[i] + b1[i]); }
        *(v4u*)(DEC + (size_t)row * 512 + col) = pack8(a, b);
    }
};
template <int ACC> struct FnMulAcc {
    bf16* O; int ldo; const bf16* S; int lds_; int soff;
    __device__ __forceinline__ void operator()(int row, int col, f32x4 a, f32x4 b) const {
        f32x4 s0, s1; unpack8(*(const v4u*)(S + (size_t)row * lds_ + soff + col), s0, s1);
        a = a * s0; b = b * s1;
        if (ACC) { f32x4 o0, o1; unpack8(*(const v4u*)(O + (size_t)row * ldo + col), o0, o1); a = a + o0; b = b + o1; }
        *(v4u*)(O + (size_t)row * ldo + col) = pack8(a, b);
    }
};
struct FnResid {
    const float* base; float* out;
    __device__ __forceinline__ void operator()(int row, int col, f32x4 a, f32x4 b) const {
        const size_t o = (size_t)row * 1024 + col; const f32x4 x0 = *(const f32x4*)(base + o), x1 = *(const f32x4*)(base + o + 4);
        *(f32x4*)(out + o) = x0 + a; *(f32x4*)(out + o + 4) = x1 + b;
    }
};
struct FnStore {
    bf16* O; int ldo;
    __device__ __forceinline__ void operator()(int row, int col, f32x4 a, f32x4 b) const { *(v4u*)(O + (size_t)row * ldo + col) = pack8(a, b); }
};
struct FnResidNorm {
    const float* base; float* out; bf16* XB; float* rsq;
    __device__ __forceinline__ void operator()(int row, int col, f32x4 a, f32x4 b) const {
        const size_t o = (size_t)row * 1024 + col; const f32x4 x0 = *(const f32x4*)(base + o) + a, x1 = *(const f32x4*)(base + o + 4) + b;
        *(v4u*)(XB + o) = pack8(x0, x1);
        float ss = (x0[0] * x0[0] + x0[1] * x0[1]) + (x0[2] * x0[2] + x0[3] * x0[3]) + (x1[0] * x1[0] + x1[1] * x1[1]) + (x1[2] * x1[2] + x1[3] * x1[3]);
        ss += __shfl_xor(ss, 16); ss += __shfl_xor(ss, 32);
        if (((col >> 3) & 3) == 0) atomicAdd(rsq + row, ss);
    }
};
struct FnResidBf {
    const bf16* XB; float* out;
    __device__ __forceinline__ void operator()(int row, int col, f32x4 a, f32x4 b) const {
        const size_t o = (size_t)row * 1024 + col; f32x4 x0, x1; unpack8(*(const v4u*)(XB + o), x0, x1);
        *(f32x4*)(out + o) = x0 + a; *(f32x4*)(out + o + 4) = x1 + b;
    }
};
struct FnStoreScaled {
    bf16* O; int ldo; const float* rsq;
    __device__ __forceinline__ void operator()(int row, int col, f32x4 a, f32x4 b) const { const float rs = 1.f / sqrtf(rsq[row] * (1.f / 1024.f) + 1e-6f); *(v4u*)(O + (size_t)row * ldo + col) = pack8(a * rs, b * rs); }
};
struct FnConvAct {
    const bf16* G; bf16* ACT; const float* cw; const float* cb; const float* rsq;
    __device__ __forceinline__ void operator()(int row, int col, f32x4 a, f32x4 b) const {
        { const float rs = 1.f / sqrtf(rsq[row] * (1.f / 1024.f) + 1e-6f); a = a * rs; b = b * rs; }
        const int s = row & (SEQ - 1); const bf16* g = G + (size_t)row * 2816 + col;
        f32x4 c0, c1, p0 = {0.f, 0.f, 0.f, 0.f}, p1 = p0, n0 = p0, n1 = p0;
        unpack8(*(const v4u*)g, c0, c1);
        if (s > 0) unpack8(*(const v4u*)(g - 2816), p0, p1);
        if (s < SEQ - 1) unpack8(*(const v4u*)(g + 2816), n0, n1);
        const f32x4 wa0 = *(const f32x4*)(cw + col), wa1 = *(const f32x4*)(cw + col + 4), wb0 = *(const f32x4*)(cw + 2816 + col), wb1 = *(const f32x4*)(cw + 2816 + col + 4),
                    wc0 = *(const f32x4*)(cw + 5632 + col), wc1 = *(const f32x4*)(cw + 5632 + col + 4), bb0 = *(const f32x4*)(cb + col), bb1 = *(const f32x4*)(cb + col + 4);
        f32x4 g0 = p0 * wa0 + c0 * wb0 + n0 * wc0 + bb0, g1 = p1 * wa1 + c1 * wb1 + n1 * wc1 + bb1;
#pragma unroll
        for (int i = 0; i < 4; ++i) { g0[i] = g0[i] * sigm(g0[i]) * a[i]; g1[i] = g1[i] * sigm(g1[i]) * b[i]; }
        *(v4u*)(ACT + (size_t)row * 2816 + col) = pack8(g0, g1);
    }
};
template <class Fn> __device__ __forceinline__ void run_gemm(Frame& F, const bf16* A, int lda, const bf16* Bt, int ldb, int N, int K, const Fn& fn) {
    asm volatile("" : "+s"(K));
    pg8::Gemm g{A, Bt, NTOK, N, K, lda, ldb}; pg8::StaticOrder S; S.init(NTOK, N, F.G, F.bid);
    Epi8<Fn> E{fn};
    pg8::gemm_phase<Epi8<Fn>, pg8::StaticOrder, true, true>(F.lds, g, S, E);
}

__device__ __forceinline__ void p2_shift(Frame& F) {
    const bf16* PR = (const bf16*)(F.ws + WS_PR); bf16* RKV = (bf16*)(F.ws + WS_RKV); bf16* LI = (bf16*)(F.ws + WS_LI); bf16* SG = (bf16*)(F.ws + WS_SG);
    const float* mu = F.in[13];
    for (int idx = F.bid * 512 + F.tid; idx < NTOK * 256; idx += F.G * 512) {
        const int m = idx >> 8, ch = idx & 255, s = m & (SEQ - 1), c = ch * 8;
        if (ch >= 248) { *(v4u*)(LI + (size_t)m * 256 + 192 + (ch - 248) * 8) = (v4u){0u, 0u, 0u, 0u}; continue; }
        const bf16* p = PR + (size_t)m * 2048 + c;
        f32x4 c0, c1, p0 = {0.f, 0.f, 0.f, 0.f}, p1 = p0, n0 = p0, n1 = p0;
        unpack8(*(const v4u*)p, c0, c1);
        if (s > 0) unpack8(*(const v4u*)(p - 2048), p0, p1);
        if (s < SEQ - 1) unpack8(*(const v4u*)(p + 2048), n0, n1);
        const f32x4 mp0 = *(const f32x4*)(mu + c), mp1 = *(const f32x4*)(mu + c + 4), mn0 = *(const f32x4*)(mu + 1984 + c), mn1 = *(const f32x4*)(mu + 1984 + c + 4);
        f32x4 u0 = c0 + mp0 * (p0 - c0) + mn0 * (n0 - c0), u1 = c1 + mp1 * (p1 - c1) + mn1 * (n1 - c1);
        if (c < 1536) *(v4u*)(RKV + (size_t)m * 1536 + c) = pack8(u0, u1);
        else if (c < 1600) *(v4u*)(LI + (size_t)m * 256 + (c - 1536)) = pack8(u0, u1);
        else if (c < 1728) {
#pragma unroll
            for (int i = 0; i < 4; ++i) { u0[i] = ftanh(u0[i]); u1[i] = ftanh(u1[i]); }
            *(v4u*)(LI + (size_t)m * 256 + 64 + (c - 1600)) = pack8(u0, u1); }
        else {
#pragma unroll
            for (int i = 0; i < 4; ++i) { u0[i] = sigm(u0[i]); u1[i] = sigm(u1[i]); }
            *(v4u*)(SG + (size_t)m * 256 + (c - 1728)) = pack8(u0, u1); }
    }
}

__device__ __forceinline__ void p5_gn(Frame& F) {
    const bf16* RKV = (const bf16*)(F.ws + WS_RKV); const bf16* ASIG = (const bf16*)(F.ws + WS_ASIG); bf16* OF = (bf16*)(F.ws + WS_OF); bf16* OB = (bf16*)(F.ws + WS_OB);
    const float *k_a = F.in[20], *r_k = F.in[21], *lng = F.in[22], *lnb = F.in[23];
    for (int idx = F.bid * 512 + F.tid; idx < NTOK * 64; idx += F.G * 512) {
        const int m = idx >> 6, c = (idx & 63) * 8;
        float r[8], k[8], v[8], a[8], of[8], ob[8];
        { f32x4 x0, x1; unpack8(*(const v4u*)(RKV + (size_t)m * 1536 + c), x0, x1); for (int i = 0; i < 4; ++i) { r[i] = x0[i]; r[4 + i] = x1[i]; }
          unpack8(*(const v4u*)(RKV + (size_t)m * 1536 + 512 + c), x0, x1); for (int i = 0; i < 4; ++i) { k[i] = x0[i]; k[4 + i] = x1[i]; }
          unpack8(*(const v4u*)(RKV + (size_t)m * 1536 + 1024 + c), x0, x1); for (int i = 0; i < 4; ++i) { v[i] = x0[i]; v[4 + i] = x1[i]; }
          unpack8(*(const v4u*)(ASIG + (size_t)m * 512 + c), x0, x1); for (int i = 0; i < 4; ++i) { a[i] = x0[i]; a[4 + i] = x1[i]; }
          unpack8(*(const v4u*)(OF + (size_t)m * 512 + c), x0, x1); for (int i = 0; i < 4; ++i) { of[i] = x0[i]; of[4 + i] = x1[i]; }
          unpack8(*(const v4u*)(OB + (size_t)m * 512 + c), x0, x1); for (int i = 0; i < 4; ++i) { ob[i] = x0[i]; ob[4 + i] = x1[i]; } }
        float bs = 0.f, sf = 0.f, sb = 0.f;
#pragma unroll
        for (int i = 0; i < 8; ++i) { const float kp = k[i] * (1.f + (a[i] - 1.f) * k_a[c + i]); bs += r[i] * kp * r_k[c + i]; sf += of[i]; sb += ob[i]; }
        bs = red8(bs); const float muf = red8(sf) * (1.f / 64.f), mub = red8(sb) * (1.f / 64.f);
        float qf = 0.f, qb = 0.f;
#pragma unroll
        for (int i = 0; i < 8; ++i) { of[i] -= muf; ob[i] -= mub; qf += of[i] * of[i]; qb += ob[i] * ob[i]; }
        const float rf = 1.f / sqrtf(red8(qf) * (1.f / 64.f) + 64e-5f), rb = 1.f / sqrtf(red8(qb) * (1.f / 64.f) + 64e-5f);
        f32x4 o0, o1, o2, o3;
#pragma unroll
        for (int i = 0; i < 4; ++i) {
            o0[i] = of[i] * rf * lng[c + i] + lnb[c + i] + bs * v[i];             o1[i] = of[4 + i] * rf * lng[c + 4 + i] + lnb[c + 4 + i] + bs * v[4 + i];
            o2[i] = ob[i] * rb * lng[c + i] + lnb[c + i] + bs * v[i];             o3[i] = ob[4 + i] * rb * lng[c + 4 + i] + lnb[c + 4 + i] + bs * v[4 + i]; }
        *(v4u*)(OF + (size_t)m * 512 + c) = pack8(o0, o1); *(v4u*)(OB + (size_t)m * 512 + c) = pack8(o2, o3);
    }
}

__device__ __forceinline__ void p11_conv(Frame& F) {
    bf16* GU = (bf16*)(F.ws + WS_GU); const float* cw = F.in[29]; const float* cb = F.in[30];
    for (int idx = F.bid * 512 + F.tid; idx < NTOK * 352; idx += F.G * 512) {
        const int m = idx / 352, c = (idx - m * 352) * 8, s = m & (SEQ - 1);
        bf16* g = GU + (size_t)m * 5632 + c;
        f32x4 c0, c1, p0 = {0.f, 0.f, 0.f, 0.f}, p1 = p0, n0 = p0, n1 = p0, u0, u1;
        unpack8(*(const v4u*)g, c0, c1); unpack8(*(const v4u*)(g + 2816), u0, u1);
        if (s > 0) unpack8(*(const v4u*)(g - 5632), p0, p1);
        if (s < SEQ - 1) unpack8(*(const v4u*)(g + 5632), n0, n1);
        const f32x4 wa0 = *(const f32x4*)(cw + c), wa1 = *(const f32x4*)(cw + c + 4), wb0 = *(const f32x4*)(cw + 2816 + c), wb1 = *(const f32x4*)(cw + 2816 + c + 4),
                    wc0 = *(const f32x4*)(cw + 5632 + c), wc1 = *(const f32x4*)(cw + 5632 + c + 4), bb0 = *(const f32x4*)(cb + c), bb1 = *(const f32x4*)(cb + c + 4);
        f32x4 g0 = p0 * wa0 + c0 * wb0 + n0 * wc0 + bb0, g1 = p1 * wa1 + c1 * wb1 + n1 * wc1 + bb1;
#pragma unroll
        for (int i = 0; i < 4; ++i) { g0[i] = g0[i] * sigm(g0[i]) * u0[i]; g1[i] = g1[i] * sigm(g1[i]) * u1[i]; }
        *(v4u*)(g + 2816) = pack8(g0, g1);
    }
}

#define MFMA32(a, b, c) __builtin_amdgcn_mfma_f32_32x32x16_bf16((a), (b), (c), 0, 0, 0)
__device__ __forceinline__ float ssq8(v4u w) { float a0 = bflo(w.x), a1 = bfhi(w.x), a2 = bflo(w.y), a3 = bfhi(w.y), a4 = bflo(w.z), a5 = bfhi(w.z), a6 = bflo(w.w), a7 = bfhi(w.w);
    return (a0 * a0 + a1 * a1) + (a2 * a2 + a3 * a3) + (a4 * a4 + a5 * a5) + (a6 * a6 + a7 * a7); }
__device__ __forceinline__ v4u scale8(v4u w, float rs, const float* g) { const f32x4 g0 = *(const f32x4*)g, g1 = *(const f32x4*)(g + 4); v4u o;
    o.x = pk2(bflo(w.x) * rs * g0[0], bfhi(w.x) * rs * g0[1]); o.y = pk2(bflo(w.y) * rs * g0[2], bfhi(w.y) * rs * g0[3]);
    o.z = pk2(bflo(w.z) * rs * g1[0], bfhi(w.z) * rs * g1[1]); o.w = pk2(bflo(w.w) * rs * g1[2], bfhi(w.w) * rs * g1[3]); return o; }
__device__ __forceinline__ float rope_inv_freq(int e, int hi) {
    constexpr float T[16] = {1.000000000e+00f, 5.623413324e-01f, 3.162277639e-01f, 1.778279394e-01f, 1.000000015e-01f, 5.623413250e-02f, 3.162277490e-02f, 1.778279431e-02f,
                             9.999999776e-03f, 5.623413250e-03f, 3.162277630e-03f, 1.778279431e-03f, 1.000000047e-03f, 5.623413017e-04f, 3.162277571e-04f, 1.778279402e-04f};
    const int i0 = (e & 3) + 8 * (e >> 2); return hi ? T[i0 + 4] : T[i0]; }
__device__ __forceinline__ void mla_item(Frame& F, int item) {
    const int tile = item >> 1, hg = item & 1, lane = F.lane, r32 = lane & 31, hi = lane >> 5;
    const int m = tile * 256 + F.wave * 32 + r32, b = m >> 12, s = m & (SEQ - 1);
    const bf16* PM = (const bf16*)(F.ws + WS_PM) + (size_t)m * 512;
    bf16* Qo = (bf16*)(F.ws + WS_Q); bf16* Ko = (bf16*)(F.ws + WS_K); bf16* VTo = (bf16*)(F.ws + WS_VT);
    v4u cq[16], ckv[8];
    float sq = 0.f, skv = 0.f;
#pragma unroll
    for (int i = 0; i < 16; ++i) { cq[i] = *(const v4u*)(PM + 16 * i + 8 * hi); sq += ssq8(cq[i]); }
#pragma unroll
    for (int i = 0; i < 8; ++i) { ckv[i] = *(const v4u*)(PM + 256 + 16 * i + 8 * hi); skv += ssq8(ckv[i]); }
    sq += __shfl_xor(sq, 32); skv += __shfl_xor(skv, 32);
    const float rq = 1.f / sqrtf(sq * (1.f / 256.f) + 1e-6f), rkv = 1.f / sqrtf(skv * (1.f / 128.f) + 1e-6f);
#pragma unroll
    for (int i = 0; i < 16; ++i) cq[i] = scale8(cq[i], rq, F.in[5] + 16 * i + 8 * hi);
#pragma unroll
    for (int i = 0; i < 8; ++i) ckv[i] = scale8(ckv[i], rkv, F.in[6] + 16 * i + 8 * hi);
    float cs[8], sn[8];
    { const float pos = (float)((const int*)F.in[1])[m];
#pragma unroll
      for (int e = 0; e < 8; ++e) { const float inv = rope_inv_freq(e, hi); const float ang = pos * inv;
          const float kq = rintf(ang * 0.15915494309189535f); float rr = fmaf(-kq, 6.28125f, ang); rr = fmaf(-kq, 1.9353071795864769e-3f, rr);
          rr *= 0.15915494309189535f; sn[e] = __builtin_amdgcn_sinf(rr); cs[e] = __builtin_amdgcn_cosf(rr); } }
    { float t1[8], t2[8];
      const v2u a0 = *(const v2u*)(PM + 384 + 4 * hi), a1 = *(const v2u*)(PM + 384 + 8 + 4 * hi), b0 = *(const v2u*)(PM + 384 + 16 + 4 * hi), b1 = *(const v2u*)(PM + 384 + 24 + 4 * hi);
      t1[0] = bflo(a0.x); t1[1] = bfhi(a0.x); t1[2] = bflo(a0.y); t1[3] = bfhi(a0.y); t1[4] = bflo(a1.x); t1[5] = bfhi(a1.x); t1[6] = bflo(a1.y); t1[7] = bfhi(a1.y);
      t2[0] = bflo(b0.x); t2[1] = bfhi(b0.x); t2[2] = bflo(b0.y); t2[3] = bfhi(b0.y); t2[4] = bflo(b1.x); t2[5] = bfhi(b1.x); t2[6] = bflo(b1.y); t2[7] = bfhi(b1.y);
      float ss = 0.f;
#pragma unroll
      for (int e = 0; e < 8; ++e) ss += t1[e] * t1[e] + t2[e] * t2[e];
      ss += __shfl_xor(ss, 32);
      const float rs = 1.f / sqrtf(ss * (1.f / 32.f) + 1e-6f);
      float o1[8], o2[8];
#pragma unroll
      for (int e = 0; e < 8; ++e) { const int i = crow(e, hi); const float x1 = t1[e] * rs * F.in[12][i], x2 = t2[e] * rs * F.in[12][i + 16]; o1[e] = x1 * cs[e] - x2 * sn[e]; o2[e] = x2 * cs[e] + x1 * sn[e]; }
#pragma unroll
      for (int hh = 0; hh < 4; ++hh) { bf16* kp = Ko + ((size_t)(b * 8 + hg * 4 + hh) * SEQ + s) * 96 + 64;
          *(v2u*)(kp + 4 * hi) = (v2u){pk2s(o1[0], o1[1]), pk2s(o1[2], o1[3])}; *(v2u*)(kp + 8 + 4 * hi) = (v2u){pk2s(o1[4], o1[5]), pk2s(o1[6], o1[7])};
          *(v2u*)(kp + 16 + 4 * hi) = (v2u){pk2s(o2[0], o2[1]), pk2s(o2[2], o2[3])}; *(v2u*)(kp + 24 + 4 * hi) = (v2u){pk2s(o2[4], o2[5]), pk2s(o2[6], o2[7])}; } }
    const bf16* WUQ = (const bf16*)(F.ws + WS_WUQ); const bf16* WUKV = (const bf16*)(F.ws + WS_WUKV);
    LAS unsigned char* lq = F.lds; LAS unsigned char* lkv = F.lds + 96 * 528;
    for (int hh = 0; hh < 4; ++hh) {
        const int h = hg * 4 + hh;
        __syncthreads();
        { const v4u* src = (const v4u*)(WUQ + (size_t)h * 96 * 256);
#pragma unroll
          for (int j = 0; j < 6; ++j) { const int i = j * 512 + F.tid; *(LAS v4u*)(lq + (i >> 5) * 528 + (i & 31) * 16) = src[i]; }
          const v4u* src2 = (const v4u*)(WUKV + (size_t)h * 128 * 128);
#pragma unroll
          for (int j = 0; j < 4; ++j) { const int i = j * 512 + F.tid; *(LAS v4u*)(lkv + (i >> 4) * 272 + (i & 15) * 16) = src2[i]; } }
        __syncthreads();
        const size_t rowq = ((size_t)(b * 8 + h) * SEQ + s) * 96;
        f32x16 qa[3];
#pragma unroll
        for (int j = 0; j < 3; ++j) { qa[j] = (f32x16){};
#pragma unroll
            for (int i = 0; i < 16; ++i) { const bf16x8 a = *(const LAS bf16x8*)(lq + (32 * j + r32) * 528 + 32 * i + 16 * hi); qa[j] = MFMA32(a, __builtin_bit_cast(bf16x8, cq[i]), qa[j]); } }
        { float ss = 0.f;
#pragma unroll
          for (int r = 0; r < 16; ++r) ss += qa[0][r] * qa[0][r] + qa[1][r] * qa[1][r];
          ss += __shfl_xor(ss, 32);
          const float rs = QSCALE / sqrtf(ss * (1.f / 64.f) + 1e-6f);
#pragma unroll
          for (int j = 0; j < 2; ++j)
#pragma unroll
              for (int g4 = 0; g4 < 4; ++g4) { const int col = 32 * j + 8 * g4 + 4 * hi; const f32x4 gg = *(const f32x4*)(F.in[9] + col);
                  *(v2u*)(Qo + rowq + col) = (v2u){pk2s(qa[j][4 * g4] * rs * gg[0], qa[j][4 * g4 + 1] * rs * gg[1]), pk2s(qa[j][4 * g4 + 2] * rs * gg[2], qa[j][4 * g4 + 3] * rs * gg[3])}; }
          float s2 = 0.f;
#pragma unroll
          for (int r = 0; r < 16; ++r) s2 += qa[2][r] * qa[2][r];
          s2 += __shfl_xor(s2, 32);
          const float r2 = 1.f / sqrtf(s2 * (1.f / 32.f) + 1e-6f);
          float o1[8], o2[8];
#pragma unroll
          for (int e = 0; e < 8; ++e) { const int i = crow(e, hi); const float x1 = qa[2][e] * r2 * F.in[10][i], x2 = qa[2][e + 8] * r2 * F.in[10][i + 16];
              o1[e] = (x1 * cs[e] - x2 * sn[e]) * QSCALE; o2[e] = (x2 * cs[e] + x1 * sn[e]) * QSCALE; }
          bf16* qp = Qo + rowq + 64;
          *(v2u*)(qp + 4 * hi) = (v2u){pk2s(o1[0], o1[1]), pk2s(o1[2], o1[3])}; *(v2u*)(qp + 8 + 4 * hi) = (v2u){pk2s(o1[4], o1[5]), pk2s(o1[6], o1[7])};
          *(v2u*)(qp + 16 + 4 * hi) = (v2u){pk2s(o2[0], o2[1]), pk2s(o2[2], o2[3])}; *(v2u*)(qp + 24 + 4 * hi) = (v2u){pk2s(o2[4], o2[5]), pk2s(o2[6], o2[7])}; }
        f32x16 ka[2];
#pragma unroll
        for (int j = 0; j < 2; ++j) { ka[j] = (f32x16){};
#pragma unroll
            for (int i = 0; i < 8; ++i) { const bf16x8 a = *(const LAS bf16x8*)(lkv + (32 * j + r32) * 272 + 32 * i + 16 * hi); ka[j] = MFMA32(a, __builtin_bit_cast(bf16x8, ckv[i]), ka[j]); } }
        { float ss = 0.f;
#pragma unroll
          for (int r = 0; r < 16; ++r) ss += ka[0][r] * ka[0][r] + ka[1][r] * ka[1][r];
          ss += __shfl_xor(ss, 32);
          const float rs = 1.f / sqrtf(ss * (1.f / 64.f) + 1e-6f);
#pragma unroll
          for (int j = 0; j < 2; ++j)
#pragma unroll
              for (int g4 = 0; g4 < 4; ++g4) { const int col = 32 * j + 8 * g4 + 4 * hi; const f32x4 gg = *(const f32x4*)(F.in[11] + col);
                  *(v2u*)(Ko + rowq + col) = (v2u){pk2s(ka[j][4 * g4] * rs * gg[0], ka[j][4 * g4 + 1] * rs * gg[1]), pk2s(ka[j][4 * g4 + 2] * rs * gg[2], ka[j][4 * g4 + 3] * rs * gg[3])}; } }
#pragma unroll
        for (int j = 0; j < 2; ++j) { f32x16 va = (f32x16){};
#pragma unroll
            for (int i = 0; i < 8; ++i) { const bf16x8 a = *(const LAS bf16x8*)(lkv + (64 + 32 * j + r32) * 272 + 32 * i + 16 * hi); va = MFMA32(a, __builtin_bit_cast(bf16x8, ckv[i]), va); }
#pragma unroll
            for (int r = 0; r < 16; r += 2) { const unsigned w = pk2s(va[r], va[r + 1]); const int d = 32 * j + crow(r, hi);
                VTo[((size_t)(b * 8 + h) * 64 + d) * SEQ + s] = (bf16)(w & 0xffffu); VTo[((size_t)(b * 8 + h) * 64 + d + 1) * SEQ + s] = (bf16)(w >> 16); } }
    }
    __syncthreads();
}

constexpr int AK_STRIDE = 208, AV_STRIDE = 136, AK_BYTES = 64 * AK_STRIDE, AV_BYTES = 64 * AV_STRIDE, AV_OFF = 2 * AK_BYTES;
__device__ __forceinline__ void attn_unit(Frame& F, int bh, int qb) {
    const int tid = F.tid, lane = F.lane, wid = F.wave, r32 = lane & 31, hi = lane >> 5;
    const bf16* Qp = (const bf16*)(F.ws + WS_Q) + ((size_t)bh * SEQ + qb * 256 + wid * 32 + r32) * 96;
    const bf16* Kb = (const bf16*)(F.ws + WS_K) + (size_t)bh * SEQ * 96; const bf16* Vb = (const bf16*)(F.ws + WS_VT) + (size_t)bh * 64 * SEQ;
    LAS unsigned char* lds = F.lds;
    bf16x8 qf[6];
#pragma unroll
    for (int d0 = 0; d0 < 6; ++d0) qf[d0] = *(const bf16x8*)(Qp + 16 * d0 + 8 * hi);
    const int kl0 = (tid / 12) * AK_STRIDE + (tid % 12) * 16, i1 = 512 + tid, kl1 = (i1 / 12) * AK_STRIDE + (i1 % 12) * 16;
    const int vd = tid >> 3, vc = tid & 7, vl = AV_OFF + vd * AV_STRIDE + vc * 16;
    const v4u* kg = (const v4u*)Kb; const bf16* vg = Vb + (size_t)vd * SEQ + vc * 8;
    v4u sk0, sk1 = {0u, 0u, 0u, 0u}, sv;
    sk0 = kg[tid]; if (tid < 256) sk1 = kg[512 + tid]; sv = *(const v4u*)vg;
    __syncthreads();
    *(LAS v4u*)(lds + kl0) = sk0; if (tid < 256) *(LAS v4u*)(lds + kl1) = sk1;
    *(LAS v2u*)(lds + vl) = (v2u){sv.x, sv.y}; *(LAS v2u*)(lds + vl + 8) = (v2u){sv.z, sv.w};
    __syncthreads();
    float mrun = -1e30f, lrun = 0.f;
    f32x16 o0 = (f32x16){}, o1 = (f32x16){};
    for (int t = 0; t < 64; ++t) {
        const int cur = t & 1, nxt = cur ^ 1;
        if (t + 1 < 64) { const v4u* kgn = kg + (size_t)(t + 1) * 768; sk0 = kgn[tid]; if (tid < 256) sk1 = kgn[512 + tid]; sv = *(const v4u*)(vg + (t + 1) * 64); }
        const LAS unsigned char* kb_ = lds + cur * AK_BYTES; const LAS unsigned char* vb_ = lds + AV_OFF + cur * AV_BYTES;
        f32x16 p0 = (f32x16){}, p1 = (f32x16){};
#pragma unroll
        for (int d0 = 0; d0 < 6; ++d0) {
            const bf16x8 a0 = *(const LAS bf16x8*)(kb_ + r32 * AK_STRIDE + 32 * d0 + 16 * hi), a1 = *(const LAS bf16x8*)(kb_ + (32 + r32) * AK_STRIDE + 32 * d0 + 16 * hi);
            p0 = MFMA32(a0, qf[d0], p0); p1 = MFMA32(a1, qf[d0], p1); }
        float mx = fmaxf(p0[0], p1[0]);
#pragma unroll
        for (int r = 1; r < 16; ++r) mx = fmaxf(mx, fmaxf(p0[r], p1[r]));
        mx = fmaxf(mx, __shfl_xor(mx, 32));
        const float mnew = fmaxf(mrun, mx), alpha = __builtin_amdgcn_exp2f(mrun - mnew);
        mrun = mnew;
        float ls = 0.f;
#pragma unroll
        for (int r = 0; r < 16; ++r) { p0[r] = __builtin_amdgcn_exp2f(p0[r] - mnew); p1[r] = __builtin_amdgcn_exp2f(p1[r] - mnew); ls += p0[r] + p1[r]; }
        lrun = lrun * alpha + ls;
#pragma unroll
        for (int r = 0; r < 16; ++r) { o0[r] *= alpha; o1[r] *= alpha; }
        v4u pb[4];
        pb[0] = (v4u){pk2(p0[0], p0[1]), pk2(p0[2], p0[3]), pk2(p0[4], p0[5]), pk2(p0[6], p0[7])};
        pb[1] = (v4u){pk2(p0[8], p0[9]), pk2(p0[10], p0[11]), pk2(p0[12], p0[13]), pk2(p0[14], p0[15])};
        pb[2] = (v4u){pk2(p1[0], p1[1]), pk2(p1[2], p1[3]), pk2(p1[4], p1[5]), pk2(p1[6], p1[7])};
        pb[3] = (v4u){pk2(p1[8], p1[9]), pk2(p1[10], p1[11]), pk2(p1[12], p1[13]), pk2(p1[14], p1[15])};
#pragma unroll
        for (int sl = 0; sl < 4; ++sl) {
            const LAS unsigned char* va = vb_ + r32 * AV_STRIDE + 2 * (16 * sl + 4 * hi);
            const v2u x0 = *(const LAS v2u*)va, x1 = *(const LAS v2u*)(va + 16), y0 = *(const LAS v2u*)(va + 32 * AV_STRIDE), y1 = *(const LAS v2u*)(va + 32 * AV_STRIDE + 16);
            const bf16x8 pbf = __builtin_bit_cast(bf16x8, pb[sl]);
            o0 = MFMA32(__builtin_bit_cast(bf16x8, ((v4u){x0.x, x0.y, x1.x, x1.y})), pbf, o0);
            o1 = MFMA32(__builtin_bit_cast(bf16x8, ((v4u){y0.x, y0.y, y1.x, y1.y})), pbf, o1); }
        if (t + 1 < 64) { LAS unsigned char* kn = lds + nxt * AK_BYTES; LAS unsigned char* vn = lds + nxt * AV_BYTES;
            *(LAS v4u*)(kn + kl0) = sk0; if (tid < 256) *(LAS v4u*)(kn + kl1) = sk1;
            *(LAS v2u*)(vn + vl) = (v2u){sv.x, sv.y}; *(LAS v2u*)(vn + vl + 8) = (v2u){sv.z, sv.w}; }
        __syncthreads();
    }
    lrun += __shfl_xor(lrun, 32);
    const float inv = 1.f / lrun;
    const int b = bh >> 3, h = bh & 7;
    bf16* op = (bf16*)(F.ws + WS_OA) + ((size_t)b * SEQ + qb * 256 + wid * 32 + r32) * 512 + h * 64;
#pragma unroll
    for (int g4 = 0; g4 < 4; ++g4) {
        *(v2u*)(op + 8 * g4 + 4 * hi) = (v2u){pk2(o0[4 * g4] * inv, o0[4 * g4 + 1] * inv), pk2(o0[4 * g4 + 2] * inv, o0[4 * g4 + 3] * inv)};
        *(v2u*)(op + 32 + 8 * g4 + 4 * hi) = (v2u){pk2(o1[4 * g4] * inv, o1[4 * g4 + 1] * inv), pk2(o1[4 * g4 + 2] * inv, o1[4 * g4 + 3] * inv)}; }
}

constexpr int SC_STEP = 1408, SC_BUF = 32 * SC_STEP, SC_OB = 2 * SC_BUF;
__device__ __forceinline__ float ffma_s(float a, float b, float c) { float d; asm("v_fma_f32 %0, %1, %2, %3" : "=v"(d) : "v"(a), "v"(b), "v"(c)); return d; }
__device__ __forceinline__ float fmul_s(float a, float b) { float d; asm("v_mul_f32_e32 %0, %1, %2" : "=v"(d) : "v"(a), "v"(b)); return d; }
__device__ __forceinline__ void scan_item(Frame& F, int item) {
    const int b = item >> 5, h = (item >> 2) & 7, dir = (item >> 1) & 1, half = item & 1;
    const int tid = F.tid, lane = F.lane, wid = F.wave;
    LAS unsigned char* lds = F.lds;
    const bf16* RKV = (const bf16*)(F.ws + WS_RKV); const bf16* ASIG = (const bf16*)(F.ws + WS_ASIG);
    const bf16* DEC = (const bf16*)(F.ws + (dir ? WS_DECB : WS_DECF)); bf16* OUT = (bf16*)(F.ws + (dir ? WS_OB : WS_OF));
    const bool loader = wid >= 4;
    const int lt = tid - 256, lj = lt >> 3, lg = lt & 7;
    float kk8[8], ka8[8];
    if (loader) {
#pragma unroll
        for (int i = 0; i < 8; ++i) { kk8[i] = F.in[19][h * 64 + 8 * lg + i]; ka8[i] = F.in[20][h * 64 + 8 * lg + i]; } }
    auto tok = [&](int c, int j) { const int s = dir ? (SEQ - 1 - (32 * c + j)) : (32 * c + j); return b * SEQ + s; };
    v4u g_r8, g_k8, g_a8, g_w8, g_v8 = {0u, 0u, 0u, 0u};
    auto issue_chunk = [&](int c) {
        const size_t m = (size_t)tok(c, lj); const int col = h * 64 + 8 * lg;
        g_r8 = *(const v4u*)(RKV + m * 1536 + col); g_k8 = *(const v4u*)(RKV + m * 1536 + 512 + col); g_a8 = *(const v4u*)(ASIG + m * 512 + col); g_w8 = *(const v4u*)(DEC + m * 512 + col);
        if (lg < 4) g_v8 = *(const v4u*)(RKV + m * 1536 + 1024 + h * 64 + half * 32 + 8 * lg);
    };
    auto commit_chunk = [&](int bufi) {
        f32x4 r0, r1, k0, k1, a0, a1, w0, w1; unpack8(g_r8, r0, r1); unpack8(g_k8, k0, k1); unpack8(g_a8, a0, a1); unpack8(g_w8, w0, w1);
        float kf[8], ss = 0.f;
#pragma unroll
        for (int i = 0; i < 4; ++i) { kf[i] = k0[i] * kk8[i]; kf[4 + i] = k1[i] * kk8[4 + i]; }
#pragma unroll
        for (int i = 0; i < 8; ++i) ss += kf[i] * kf[i];
        ss = red8(ss);
        const float inv = 1.f / fmaxf(sqrtf(ss), 1e-12f);
        f32x4 na0, na1, bb0, bb1, kp0, kp1, d0, d1;
#pragma unroll
        for (int i = 0; i < 4; ++i) { const float q0 = kf[i] * inv, q1 = kf[4 + i] * inv; na0[i] = -q0; na1[i] = -q1; bb0[i] = q0 * a0[i]; bb1[i] = q1 * a1[i];
            kp0[i] = k0[i] * (1.f + (a0[i] - 1.f) * ka8[i]); kp1[i] = k1[i] * (1.f + (a1[i] - 1.f) * ka8[4 + i]); d0[i] = fexp(w0[i]); d1[i] = fexp(w1[i]); }
        LAS float* sp = (LAS float*)(lds + bufi * SC_BUF + lj * SC_STEP) + 8 * lg;
        *(LAS f32x4*)(sp) = r0; *(LAS f32x4*)(sp + 4) = r1; *(LAS f32x4*)(sp + 64) = d0; *(LAS f32x4*)(sp + 68) = d1; *(LAS f32x4*)(sp + 128) = kp0; *(LAS f32x4*)(sp + 132) = kp1;
        *(LAS f32x4*)(sp + 192) = na0; *(LAS f32x4*)(sp + 196) = na1; *(LAS f32x4*)(sp + 256) = bb0; *(LAS f32x4*)(sp + 260) = bb1;
        if (lg < 4) { f32x4 v0, v1; unpack8(g_v8, v0, v1); *(LAS f32x4*)(sp + 320) = v0; *(LAS f32x4*)(sp + 324) = v1; }
    };
    auto flush_chunk = [&](int c, int bufi) {
        if (lg < 4) { const LAS float* ob = (const LAS float*)(lds + SC_OB + bufi * 4096) + lj * 32 + 8 * lg; const f32x4 x0 = *(const LAS f32x4*)ob, x1 = *(const LAS f32x4*)(ob + 4);
            *(v4u*)(OUT + (size_t)tok(c, lj) * 512 + h * 64 + half * 32 + 8 * lg) = pack8(x0, x1); }
    };
    f32x2 S[4]; S[0] = S[1] = S[2] = S[3] = (f32x2){0.f, 0.f};
    const int rowl = wid * 8 + (lane >> 3), jj = lane & 7;
#define SC_BAR() do { asm volatile("s_waitcnt lgkmcnt(0)" ::: "memory"); __builtin_amdgcn_s_barrier(); asm volatile("" ::: "memory"); } while (0)
    __syncthreads();
    if (loader) { issue_chunk(0); commit_chunk(0); issue_chunk(1); }
    SC_BAR();
    for (int c = 0; c < 128; ++c) {
        if (loader) { if (c + 1 < 128) commit_chunk((c + 1) & 1); if (c + 2 < 128) issue_chunk(c + 2); if (c > 0) flush_chunk(c - 1, (c - 1) & 1); }
        else {
            const LAS float* base = (const LAS float*)(lds + (c & 1) * SC_BUF) + 8 * jj; LAS float* ob = (LAS float*)(lds + SC_OB + (c & 1) * 4096) + rowl;
#define SC_LOAD(X, j) do { const LAS float* p_ = base + (j) * (SC_STEP / 4); \
                X##r0 = *(const LAS f32x4*)p_; X##r1 = *(const LAS f32x4*)(p_ + 4); X##w0 = *(const LAS f32x4*)(p_ + 64); X##w1 = *(const LAS f32x4*)(p_ + 68); X##k0 = *(const LAS f32x4*)(p_ + 128); X##k1 = *(const LAS f32x4*)(p_ + 132); \
                X##a0 = *(const LAS f32x4*)(p_ + 192); X##a1 = *(const LAS f32x4*)(p_ + 196); X##b0 = *(const LAS f32x4*)(p_ + 256); X##b1 = *(const LAS f32x4*)(p_ + 260); X##v = p_[320 - 8 * jj + rowl]; } while (0)
#define SC_COMP(X, j) do { \
                f32x2 t_ = S[0] * (f32x2){X##a0[0], X##a0[1]} + S[1] * (f32x2){X##a0[2], X##a0[3]}; f32x2 t2_ = S[2] * (f32x2){X##a1[0], X##a1[1]} + S[3] * (f32x2){X##a1[2], X##a1[3]}; t_ = t_ + t2_; \
                const float sa_ = red8(t_.x + t_.y); const f32x2 sa2_ = {sa_, sa_}, v2_ = {X##v, X##v}; \
                S[0] = S[0] * (f32x2){X##w0[0], X##w0[1]} + (sa2_ * (f32x2){X##b0[0], X##b0[1]} + v2_ * (f32x2){X##k0[0], X##k0[1]}); \
                S[1] = S[1] * (f32x2){X##w0[2], X##w0[3]} + (sa2_ * (f32x2){X##b0[2], X##b0[3]} + v2_ * (f32x2){X##k0[2], X##k0[3]}); \
                S[2] = S[2] * (f32x2){X##w1[0], X##w1[1]} + (sa2_ * (f32x2){X##b1[0], X##b1[1]} + v2_ * (f32x2){X##k1[0], X##k1[1]}); \
                S[3] = S[3] * (f32x2){X##w1[2], X##w1[3]} + (sa2_ * (f32x2){X##b1[2], X##b1[3]} + v2_ * (f32x2){X##k1[2], X##k1[3]}); \
                f32x2 q_ = S[0] * (f32x2){X##r0[0], X##r0[1]} + S[1] * (f32x2){X##r0[2], X##r0[3]}; f32x2 q2_ = S[2] * (f32x2){X##r1[0], X##r1[1]} + S[3] * (f32x2){X##r1[2], X##r1[3]}; q_ = q_ + q2_; \
                const float o_ = red8(q_.x + q_.y); if (jj == 0) ob[(j) * 32] = o_; } while (0)
            f32x4 Ar0, Ar1, Aw0, Aw1, Ak0, Ak1, Aa0, Aa1, Ab0, Ab1, Br0, Br1, Bw0, Bw1, Bk0, Bk1, Ba0, Ba1, Bb0, Bb1; float Av, Bv;
            SC_LOAD(A, 0);
#pragma unroll 2
            for (int j = 0; j < 32; j += 2) {
                SC_LOAD(B, j + 1);
                __builtin_amdgcn_sched_barrier(0);
                SC_COMP(A, j);
                if (j + 2 < 32) SC_LOAD(A, j + 2);
                __builtin_amdgcn_sched_barrier(0);
                SC_COMP(B, j + 1);
            }
#undef SC_LOAD
#undef SC_COMP
        }
        SC_BAR();
    }
    if (loader) flush_chunk(127, 1);
    __syncthreads();
}

constexpr int FV_STRIDE = 144, FV_BYTES = 64 * FV_STRIDE;
constexpr int FS_STEP = 896;
constexpr int FS_ABUF = 0, FS_SBUF = 45056, FS_SBYTES = 16 * FS_STEP, FS_OBUF = FS_SBUF + 2 * FS_SBYTES, FS_OBYTES = 16 * 256 * 4;
typedef _Float16 h4 __attribute__((ext_vector_type(4)));
template <int HL> __device__ __forceinline__ float mixfma(unsigned h, float s, float c) { float d;
    if (HL) asm("v_fma_mix_f32 %0, %1, %2, %3 op_sel:[1,0,0] op_sel_hi:[1,0,0]" : "=v"(d) : "v"(h), "v"(s), "v"(c));
    else    asm("v_fma_mix_f32 %0, %1, %2, %3 op_sel:[0,0,0] op_sel_hi:[1,0,0]" : "=v"(d) : "v"(h), "v"(s), "v"(c));
    return d; }
template <int HL> __device__ __forceinline__ float mixmul(unsigned h, float s) { float d;
    if (HL) asm("v_fma_mix_f32 %0, %1, %2, 0 op_sel:[1,0,0] op_sel_hi:[1,0,0]" : "=v"(d) : "v"(h), "v"(s));
    else    asm("v_fma_mix_f32 %0, %1, %2, 0 op_sel:[0,0,0] op_sel_hi:[1,0,0]" : "=v"(d) : "v"(h), "v"(s));
    return d; }
__device__ __forceinline__ float red16(float x) { x += dppf<0xB1>(x); x += dppf<0x4E>(x); x += dppf<0x141>(x); x += dppf<0x140>(x); return x; }
template <int MODE  > __device__ __forceinline__ void p4_fused(Frame& F) {
    const int tid = F.tid, lane = F.lane, wid = F.wave, r32 = lane & 31, hi = lane >> 5;
    LAS unsigned char* lds = F.lds;
    const int vb = ((F.bid & 7) << 5) | (F.bid >> 3);
    const int item = vb, sb = item >> 5, sh = (item >> 2) & 7, dir = (item >> 1) & 1, half = item & 1;
    const bf16* RKV = (const bf16*)(F.ws + WS_RKV); const bf16* ASIG = (const bf16*)(F.ws + WS_ASIG);
    const bf16* DEC = (const bf16*)(F.ws + (dir ? WS_DECB : WS_DECF)); bf16* OUT = (bf16*)(F.ws + (dir ? WS_OB : WS_OF));
    const bool loader = wid < 4;
    const int lt = tid & 255, lj = lt >> 4, lg = lt & 15;
    const bool stager = !loader;
    float kk4[4], ka4[4];
    if (stager) {
#pragma unroll
        for (int i = 0; i < 4; ++i) { kk4[i] = F.in[19][sh * 64 + 4 * lg + i]; ka4[i] = F.in[20][sh * 64 + 4 * lg + i]; } }
    auto tok = [&](int c, int j) { const int s = dir ? (SEQ - 1 - (16 * c + j)) : (16 * c + j); return sb * SEQ + s; };
    v2u g_r, g_k, g_a, g_w, g_v = {0u, 0u};
    auto issue_chunk = [&](int c) {
        const size_t m = (size_t)tok(c, lj); const int col = sh * 64 + 4 * lg;
        g_r = *(const v2u*)(RKV + m * 1536 + col); g_k = *(const v2u*)(RKV + m * 1536 + 512 + col); g_a = *(const v2u*)(ASIG + m * 512 + col); g_w = *(const v2u*)(DEC + m * 512 + col);
        if (lg < 8) g_v = *(const v2u*)(RKV + m * 1536 + 1024 + sh * 64 + half * 32 + 4 * lg);
    };
    auto commit_chunk = [&](int bufi) {
        const f32x4 r = {bflo(g_r.x), bfhi(g_r.x), bflo(g_r.y), bfhi(g_r.y)}, k = {bflo(g_k.x), bfhi(g_k.x), bflo(g_k.y), bfhi(g_k.y)},
                    a = {bflo(g_a.x), bfhi(g_a.x), bflo(g_a.y), bfhi(g_a.y)}, w = {bflo(g_w.x), bfhi(g_w.x), bflo(g_w.y), bfhi(g_w.y)};
        float kf[4], ss = 0.f;
#pragma unroll
        for (int i = 0; i < 4; ++i) { kf[i] = k[i] * kk4[i]; ss += kf[i] * kf[i]; }
        ss = red16(ss);
        const float inv = 1.f / fmaxf(sqrtf(ss), 1e-12f);
        f32x4 na, bb, kp, d;
#pragma unroll
        for (int i = 0; i < 4; ++i) { const float q = kf[i] * inv; na[i] = -q; bb[i] = q * a[i]; kp[i] = k[i] * (1.f + (a[i] - 1.f) * ka4[i]); d[i] = fexp(w[i]); }
        LAS unsigned char* sp = lds + FS_SBUF + bufi * FS_SBYTES + lj * FS_STEP;
        *(LAS h4*)(sp + 8 * lg) = (h4){(_Float16)r[0], (_Float16)r[1], (_Float16)r[2], (_Float16)r[3]};
        *(LAS h4*)(sp + 128 + 8 * lg) = (h4){(_Float16)kp[0], (_Float16)kp[1], (_Float16)kp[2], (_Float16)kp[3]};
        *(LAS h4*)(sp + 256 + 8 * lg) = (h4){(_Float16)na[0], (_Float16)na[1], (_Float16)na[2], (_Float16)na[3]};
        *(LAS h4*)(sp + 384 + 8 * lg) = (h4){(_Float16)bb[0], (_Float16)bb[1], (_Float16)bb[2], (_Float16)bb[3]};
        *(LAS f32x4*)(sp + 512 + 16 * lg) = d;
        if (lg < 8) *(LAS f32x4*)(sp + 768 + 16 * lg) = (f32x4){bflo(g_v.x), bfhi(g_v.x), bflo(g_v.y), bfhi(g_v.y)};
    };
    auto flush_chunk = [&](int c, int bufi) {
        const LAS float* ob = (const LAS float*)(lds + FS_OBUF + bufi * FS_OBYTES) + lj * 256 + 16 * lg;
        const f32x4 x0 = *(const LAS f32x4*)ob, x1 = *(const LAS f32x4*)(ob + 4), x2 = *(const LAS f32x4*)(ob + 8), x3 = *(const LAS f32x4*)(ob + 12);
        const float ra = ((x0[0] + x0[1]) + (x0[2] + x0[3])) + ((x1[0] + x1[1]) + (x1[2] + x1[3])), rb = ((x2[0] + x2[1]) + (x2[2] + x2[3])) + ((x3[0] + x3[1]) + (x3[2] + x3[3]));
        *(unsigned*)(OUT + (size_t)tok(c, lj) * 512 + sh * 64 + half * 32 + 2 * lg) = pk2(ra, rb);
    };
    float Sx[8];
#pragma unroll
    for (int i = 0; i < 8; ++i) Sx[i] = 0.f;
    const int rowl = (wid & 3) * 8 + (lane >> 3), jj = lane & 7;
    const int at = tid & 255;
    const int qb = vb & 15, bh0 = vb >> 4;
    auto kptr = [&](int ss_) { const int bh = bh0 + 16 * (ss_ >> 6); return (const v4u*)((const bf16*)(F.ws + WS_K) + (size_t)bh * SEQ * 96) + (size_t)(ss_ & 63) * 768; };
    auto vptr = [&](int ss_, int c) { const int bh = bh0 + 16 * (ss_ >> 6); return (const v4u*)((const bf16*)(F.ws + WS_VT) + (size_t)bh * 64 * SEQ + (size_t)(c >> 3) * SEQ + (c & 7) * 8 + (ss_ & 63) * 64); };
    auto klds = [&](int c) { return (c / 12) * AK_STRIDE + (c % 12) * 16; };
    auto vlds = [&](int c) { return AV_OFF + (c >> 3) * FV_STRIDE + ((c & 7) >> 1) * 32 + (c & 1) * 8; };
    v4u sk0, sk1, sk2, sv0, sv1;
    __syncthreads();
    if (loader) {
        if (MODE & 2) {
        const v4u* kg = kptr(0); sk0 = kg[at]; sk1 = kg[at + 256]; sk2 = kg[at + 512]; sv0 = *vptr(0, at); sv1 = *vptr(0, at + 256);
        *(LAS v4u*)(lds + klds(at)) = sk0; *(LAS v4u*)(lds + klds(at + 256)) = sk1; *(LAS v4u*)(lds + klds(at + 512)) = sk2;
        *(LAS v2u*)(lds + vlds(at)) = (v2u){sv0.x, sv0.y}; *(LAS v2u*)(lds + vlds(at) + 16) = (v2u){sv0.z, sv0.w};
        *(LAS v2u*)(lds + vlds(at + 256)) = (v2u){sv1.x, sv1.y}; *(LAS v2u*)(lds + vlds(at + 256) + 16) = (v2u){sv1.z, sv1.w}; }
    }
    if (stager && (MODE & 1)) { issue_chunk(0); commit_chunk(0); issue_chunk(1); }
    SC_BAR();
    if (loader) {
        __builtin_amdgcn_s_setprio(3);
        for (int ss = 0; ss < 256; ++ss) {
            const int cur = ss & 1, nxt = cur ^ 1;
            if ((MODE & 2) && ss + 1 < 256) { const v4u* kgn = kptr(ss + 1); sk0 = kgn[at]; sk1 = kgn[at + 256]; sk2 = kgn[at + 512]; sv0 = *vptr(ss + 1, at); sv1 = *vptr(ss + 1, at + 256); }
            const LAS unsigned char* base = lds + FS_SBUF + cur * FS_SBYTES + 16 * jj; LAS float* ob = (LAS float*)(lds + FS_OBUF + cur * FS_OBYTES) + (tid & 255);
#define SC_LOAD(X, j) do { const LAS unsigned char* p_ = base + (j) * FS_STEP; \
                X##r = *(const LAS v4u*)p_; X##k = *(const LAS v4u*)(p_ + 128); X##a = *(const LAS v4u*)(p_ + 256); X##b = *(const LAS v4u*)(p_ + 384); \
                X##w0 = *(const LAS f32x4*)(p_ + 512 + 16 * jj); X##w1 = *(const LAS f32x4*)(p_ + 528 + 16 * jj); X##v = *(const LAS float*)(p_ + 768 - 16 * jj + 4 * rowl); } while (0)
#define SC_EL(X, i, d, hl, wv) do { float u_ = mixmul<hl>(X##k[d], X##v); u_ = mixfma<hl>(X##b[d], sa_, u_); Sx[i] = fmaf(Sx[i], wv, u_); } while (0)
#define SC_COMP(X, j) do { \
                float t0_ = mixmul<0>(X##a[0], Sx[0]), t1_ = mixmul<1>(X##a[0], Sx[1]); t0_ = mixfma<0>(X##a[1], Sx[2], t0_); t1_ = mixfma<1>(X##a[1], Sx[3], t1_); \
                t0_ = mixfma<0>(X##a[2], Sx[4], t0_); t1_ = mixfma<1>(X##a[2], Sx[5], t1_); t0_ = mixfma<0>(X##a[3], Sx[6], t0_); t1_ = mixfma<1>(X##a[3], Sx[7], t1_); \
                const float sa_ = red8(t0_ + t1_); \
                SC_EL(X, 0, 0, 0, X##w0[0]); SC_EL(X, 1, 0, 1, X##w0[1]); SC_EL(X, 2, 1, 0, X##w0[2]); SC_EL(X, 3, 1, 1, X##w0[3]); \
                SC_EL(X, 4, 2, 0, X##w1[0]); SC_EL(X, 5, 2, 1, X##w1[1]); SC_EL(X, 6, 3, 0, X##w1[2]); SC_EL(X, 7, 3, 1, X##w1[3]); \
                float q0_ = mixmul<0>(X##r[0], Sx[0]), q1_ = mixmul<1>(X##r[0], Sx[1]); q0_ = mixfma<0>(X##r[1], Sx[2], q0_); q1_ = mixfma<1>(X##r[1], Sx[3], q1_); \
                q0_ = mixfma<0>(X##r[2], Sx[4], q0_); q1_ = mixfma<1>(X##r[2], Sx[5], q1_); q0_ = mixfma<0>(X##r[3], Sx[6], q0_); q1_ = mixfma<1>(X##r[3], Sx[7], q1_); \
                ob[(j) * 256] = q0_ + q1_; } while (0)
            v4u Ar, Ak, Aa, Ab, Br, Bk, Ba, Bb; f32x4 Aw0, Aw1, Bw0, Bw1; float Av, Bv;
            if (MODE & 1) {
            SC_LOAD(A, 0);
#pragma unroll
            for (int j = 0; j < 16; j += 2) {
                SC_LOAD(B, j + 1);
                __builtin_amdgcn_sched_barrier(0);
                SC_COMP(A, j);
                if (j + 2 < 16) SC_LOAD(A, j + 2);
                __builtin_amdgcn_sched_barrier(0);
                SC_COMP(B, j + 1);
            }
            }
#undef SC_LOAD
#undef SC_EL
#undef SC_COMP
            if ((MODE & 2) && ss + 1 < 256) { LAS unsigned char* kn = lds + nxt * AK_BYTES; LAS unsigned char* vn = lds + nxt * FV_BYTES;
                *(LAS v4u*)(kn + klds(at)) = sk0; *(LAS v4u*)(kn + klds(at + 256)) = sk1; *(LAS v4u*)(kn + klds(at + 512)) = sk2;
                *(LAS v2u*)(vn + vlds(at)) = (v2u){sv0.x, sv0.y}; *(LAS v2u*)(vn + vlds(at) + 16) = (v2u){sv0.z, sv0.w};
                *(LAS v2u*)(vn + vlds(at + 256)) = (v2u){sv1.x, sv1.y}; *(LAS v2u*)(vn + vlds(at + 256) + 16) = (v2u){sv1.z, sv1.w}; }
            SC_BAR();
        }
        __builtin_amdgcn_s_setprio(0);
    } else {
        bf16x8 qf[2][6]; float mrun[2], lrun[2]; f32x16 o0[2], o1[2];
        const int aw = wid - 4;
        for (int ss = 0; ss < 256; ++ss) {
            const int t = ss & 63, bh = bh0 + 16 * (ss >> 6), cur = ss & 1, nxt = cur ^ 1;
            if ((MODE & 1) && ss + 1 < 256) commit_chunk(nxt);
            if ((MODE & 1) && ss + 2 < 256) issue_chunk(ss + 2);
            if ((MODE & 1) && ss > 0) flush_chunk(ss - 1, nxt);
            if (MODE & 2) {
            if (t == 0) {
#pragma unroll
                for (int qq = 0; qq < 2; ++qq) { const bf16* Qp = (const bf16*)(F.ws + WS_Q) + ((size_t)bh * SEQ + qb * 256 + aw * 64 + qq * 32 + r32) * 96;
#pragma unroll
                    for (int d0 = 0; d0 < 6; ++d0) qf[qq][d0] = *(const bf16x8*)(Qp + 16 * d0 + 8 * hi);
                    mrun[qq] = -1e30f; lrun[qq] = 0.f; o0[qq] = (f32x16){}; o1[qq] = (f32x16){}; } }
            const LAS unsigned char* kb_ = lds + cur * AK_BYTES; const LAS unsigned char* vb_ = lds + AV_OFF + cur * FV_BYTES;
#pragma unroll
            for (int qq = 0; qq < 2; ++qq) {
                f32x16 p0, p1;
#pragma unroll
                for (int r = 0; r < 16; ++r) { p0[r] = -8.f; p1[r] = -8.f; }
#pragma unroll
                for (int d0 = 0; d0 < 6; ++d0) {
                    const bf16x8 a0 = *(const LAS bf16x8*)(kb_ + r32 * AK_STRIDE + 32 * d0 + 16 * hi), a1 = *(const LAS bf16x8*)(kb_ + (32 + r32) * AK_STRIDE + 32 * d0 + 16 * hi);
                    p0 = MFMA32(a0, qf[qq][d0], p0); p1 = MFMA32(a1, qf[qq][d0], p1); }
                float ls = 0.f;
#pragma unroll
                for (int r = 0; r < 16; ++r) { p0[r] = __builtin_amdgcn_exp2f(p0[r]); p1[r] = __builtin_amdgcn_exp2f(p1[r]); ls += p0[r] + p1[r]; }
                lrun[qq] += ls;
                v4u pb[4];
                pb[0] = (v4u){pk2(p0[0], p0[1]), pk2(p0[2], p0[3]), pk2(p0[4], p0[5]), pk2(p0[6], p0[7])};
                pb[1] = (v4u){pk2(p0[8], p0[9]), pk2(p0[10], p0[11]), pk2(p0[12], p0[13]), pk2(p0[14], p0[15])};
                pb[2] = (v4u){pk2(p1[0], p1[1]), pk2(p1[2], p1[3]), pk2(p1[4], p1[5]), pk2(p1[6], p1[7])};
                pb[3] = (v4u){pk2(p1[8], p1[9]), pk2(p1[10], p1[11]), pk2(p1[12], p1[13]), pk2(p1[14], p1[15])};
#pragma unroll
                for (int sl = 0; sl < 4; ++sl) {
                    const LAS unsigned char* va = vb_ + r32 * FV_STRIDE + 32 * sl + 16 * hi;
                    const bf16x8 vx = *(const LAS bf16x8*)va, vy = *(const LAS bf16x8*)(va + 32 * FV_STRIDE);
                    const bf16x8 pbf = __builtin_bit_cast(bf16x8, pb[sl]);
                    o0[qq] = MFMA32(vx, pbf, o0[qq]);
                    o1[qq] = MFMA32(vy, pbf, o1[qq]); }
                if (t == 63) {
                    const float lt_ = lrun[qq] + __shfl_xor(lrun[qq], 32);
                    const float inv = 1.f / lt_;
                    bf16* op = (bf16*)(F.ws + WS_OA) + ((size_t)(bh >> 3) * SEQ + qb * 256 + aw * 64 + qq * 32 + r32) * 512 + (bh & 7) * 64;
#pragma unroll
                    for (int g4 = 0; g4 < 4; ++g4) {
                        *(v2u*)(op + 8 * g4 + 4 * hi) = (v2u){pk2(o0[qq][4 * g4] * inv, o0[qq][4 * g4 + 1] * inv), pk2(o0[qq][4 * g4 + 2] * inv, o0[qq][4 * g4 + 3] * inv)};
                        *(v2u*)(op + 32 + 8 * g4 + 4 * hi) = (v2u){pk2(o1[qq][4 * g4] * inv, o1[qq][4 * g4 + 1] * inv), pk2(o1[qq][4 * g4 + 2] * inv, o1[qq][4 * g4 + 3] * inv)}; } }
            }
            }
            SC_BAR();
        }
        if (MODE & 1) flush_chunk(255, 1);
    }
    __syncthreads();
}

template <int MODE> __device__ __forceinline__ void p4_fused2(Frame& F) {
    const int tid = F.tid, lane = F.lane, wid = F.wave, r32 = lane & 31, hi = lane >> 5;
    LAS unsigned char* lds = F.lds;
    const int item = F.bid, sb = item >> 5, sh = (item >> 2) & 7, dir = (item >> 1) & 1, half = item & 1;
    const bf16* RKV = (const bf16*)(F.ws + WS_RKV); const bf16* ASIG = (const bf16*)(F.ws + WS_ASIG);
    const bf16* DEC = (const bf16*)(F.ws + (dir ? WS_DECB : WS_DECF)); bf16* OUT = (bf16*)(F.ws + (dir ? WS_OB : WS_OF));
    const bool isScan = wid < 2, isHelp = (wid == 2) || (wid == 3);
    const int ht = tid & 127, lj = ht >> 3, lg = ht & 7;
    const int qb = F.bid & 15, bh0 = F.bid >> 4;
    auto tok = [&](int c, int j) { const int s = dir ? (SEQ - 1 - (16 * c + j)) : (16 * c + j); return sb * SEQ + s; };
    auto kptr = [&](int ss_) { const int bh = bh0 + 16 * (ss_ >> 6); return (const v4u*)((const bf16*)(F.ws + WS_K) + (size_t)bh * SEQ * 96) + (size_t)(ss_ & 63) * 768; };
    auto vptr = [&](int ss_, int c) { const int bh = bh0 + 16 * (ss_ >> 6); return (const v4u*)((const bf16*)(F.ws + WS_VT) + (size_t)bh * 64 * SEQ + (size_t)(c >> 3) * SEQ + (c & 7) * 8 + (ss_ & 63) * 64); };
    auto klds = [&](int c) { return (c / 12) * AK_STRIDE + (c % 12) * 16; };
    auto vlds = [&](int c) { return AV_OFF + (c >> 3) * AV_STRIDE + (c & 7) * 16; };
    __syncthreads();
    if (isHelp) {
        float kk8[8], ka8[8];
#pragma unroll
        for (int i = 0; i < 8; ++i) { kk8[i] = F.in[19][sh * 64 + 8 * lg + i]; ka8[i] = F.in[20][sh * 64 + 8 * lg + i]; }
        v4u g_r8, g_k8, g_a8, g_w8, g_v8 = {0u, 0u, 0u, 0u};
        v4u sk[6], sv[4];
        auto issue_chunk = [&](int c) {
            const size_t m = (size_t)tok(c, lj); const int col = sh * 64 + 8 * lg;
            g_r8 = *(const v4u*)(RKV + m * 1536 + col); g_k8 = *(const v4u*)(RKV + m * 1536 + 512 + col); g_a8 = *(const v4u*)(ASIG + m * 512 + col); g_w8 = *(const v4u*)(DEC + m * 512 + col);
            if (lg < 4) g_v8 = *(const v4u*)(RKV + m * 1536 + 1024 + sh * 64 + half * 32 + 8 * lg);
        };
        auto commit_chunk = [&](int bufi) {
            f32x4 r0, r1, k0, k1, a0, a1, w0, w1; unpack8(g_r8, r0, r1); unpack8(g_k8, k0, k1); unpack8(g_a8, a0, a1); unpack8(g_w8, w0, w1);
            float kf[8], ss = 0.f;
#pragma unroll
            for (int i = 0; i < 4; ++i) { kf[i] = k0[i] * kk8[i]; kf[4 + i] = k1[i] * kk8[4 + i]; }
#pragma unroll
            for (int i = 0; i < 8; ++i) ss += kf[i] * kf[i];
            ss = red8(ss);
            const float inv = 1.f / fmaxf(sqrtf(ss), 1e-12f);
            f32x4 na0, na1, bb0, bb1, kp0, kp1, d0, d1;
#pragma unroll
            for (int i = 0; i < 4; ++i) { const float q0 = kf[i] * inv, q1 = kf[4 + i] * inv; na0[i] = -q0; na1[i] = -q1; bb0[i] = q0 * a0[i]; bb1[i] = q1 * a1[i];
                kp0[i] = k0[i] * (1.f + (a0[i] - 1.f) * ka8[i]); kp1[i] = k1[i] * (1.f + (a1[i] - 1.f) * ka8[4 + i]); d0[i] = fexp(w0[i]); d1[i] = fexp(w1[i]); }
            LAS float* sp = (LAS float*)(lds + FS_SBUF + bufi * FS_SBYTES + lj * SC_STEP) + 8 * lg;
            *(LAS f32x4*)(sp) = r0; *(LAS f32x4*)(sp + 4) = r1; *(LAS f32x4*)(sp + 64) = d0; *(LAS f32x4*)(sp + 68) = d1; *(LAS f32x4*)(sp + 128) = kp0; *(LAS f32x4*)(sp + 132) = kp1;
            *(LAS f32x4*)(sp + 192) = na0; *(LAS f32x4*)(sp + 196) = na1; *(LAS f32x4*)(sp + 256) = bb0; *(LAS f32x4*)(sp + 260) = bb1;
            if (lg < 4) { f32x4 v0, v1; unpack8(g_v8, v0, v1); *(LAS f32x4*)(sp + 320) = v0; *(LAS f32x4*)(sp + 324) = v1; }
        };
        auto flush_chunk = [&](int c, int bufi) {
            const LAS float* ob = (const LAS float*)(lds + FS_OBUF + bufi * FS_OBYTES) + lj * 256 + 32 * lg;
            float rs[4];
#pragma unroll
            for (int q = 0; q < 4; ++q) { const f32x4 x0 = *(const LAS f32x4*)(ob + 8 * q), x1 = *(const LAS f32x4*)(ob + 8 * q + 4); rs[q] = ((x0[0] + x0[1]) + (x0[2] + x0[3])) + ((x1[0] + x1[1]) + (x1[2] + x1[3])); }
            *(v2u*)(OUT + (size_t)tok(c, lj) * 512 + sh * 64 + half * 32 + 4 * lg) = (v2u){pk2(rs[0], rs[1]), pk2(rs[2], rs[3])};
        };
        auto kv_issue = [&](int ss_) { const v4u* kg = kptr(ss_);
#pragma unroll
            for (int i = 0; i < 6; ++i) sk[i] = kg[ht + 128 * i];
#pragma unroll
            for (int i = 0; i < 4; ++i) sv[i] = *vptr(ss_, ht + 128 * i); };
        auto kv_commit = [&](int bufi) { LAS unsigned char* kn = lds + bufi * AK_BYTES; LAS unsigned char* vn = lds + bufi * AV_BYTES;
#pragma unroll
            for (int i = 0; i < 6; ++i) *(LAS v4u*)(kn + klds(ht + 128 * i)) = sk[i];
#pragma unroll
            for (int i = 0; i < 4; ++i) { *(LAS v2u*)(vn + vlds(ht + 128 * i)) = (v2u){sv[i].x, sv[i].y}; *(LAS v2u*)(vn + vlds(ht + 128 * i) + 8) = (v2u){sv[i].z, sv[i].w}; } };
        if (MODE & 2) { kv_issue(0); kv_commit(0); }
        if (MODE & 1) { issue_chunk(0); commit_chunk(0); issue_chunk(1); }
        SC_BAR();
        for (int ss = 0; ss < 256; ++ss) {
            const int nxt = (ss & 1) ^ 1;
            if ((MODE & 2) && ss + 1 < 256) kv_issue(ss + 1);
            if ((MODE & 1) && ss + 1 < 256) commit_chunk(nxt);
            if ((MODE & 1) && ss + 2 < 256) issue_chunk(ss + 2);
            if ((MODE & 1) && ss > 0) flush_chunk(ss - 1, nxt);
            if ((MODE & 2) && ss + 1 < 256) kv_commit(nxt);
            SC_BAR();
        }
        if (MODE & 1) flush_chunk(255, 1);
    } else if (isScan) {
        __builtin_amdgcn_s_setprio(3);
        f32x2 SA[4], SB[4];
#pragma unroll
        for (int i = 0; i < 4; ++i) { SA[i] = (f32x2){0.f, 0.f}; SB[i] = (f32x2){0.f, 0.f}; }
        const int jj = lane & 7, rowA = wid * 16 + (lane >> 3), rowB = rowA + 8;
        SC_BAR();
        for (int ss = 0; ss < 256; ++ss) {
            const int cur = ss & 1;
            if (MODE & 1) {
            const LAS float* base = (const LAS float*)(lds + FS_SBUF + cur * FS_SBYTES) + 8 * jj; LAS float* ob = (LAS float*)(lds + FS_OBUF + cur * FS_OBYTES) + wid * 128 + lane;
#define SC_LOAD(X, j) do { const LAS float* p_ = base + (j) * (SC_STEP / 4); \
                X##r0 = *(const LAS f32x4*)p_; X##r1 = *(const LAS f32x4*)(p_ + 4); X##w0 = *(const LAS f32x4*)(p_ + 64); X##w1 = *(const LAS f32x4*)(p_ + 68); X##k0 = *(const LAS f32x4*)(p_ + 128); X##k1 = *(const LAS f32x4*)(p_ + 132); \
                X##a0 = *(const LAS f32x4*)(p_ + 192); X##a1 = *(const LAS f32x4*)(p_ + 196); X##b0 = *(const LAS f32x4*)(p_ + 256); X##b1 = *(const LAS f32x4*)(p_ + 260); \
                X##va = p_[320 - 8 * jj + rowA]; X##vb = p_[320 - 8 * jj + rowB]; } while (0)
#define SC_ROW(S, X, vv, oidx) do { \
                f32x2 t_ = S[0] * (f32x2){X##a0[0], X##a0[1]} + S[1] * (f32x2){X##a0[2], X##a0[3]}; f32x2 t2_ = S[2] * (f32x2){X##a1[0], X##a1[1]} + S[3] * (f32x2){X##a1[2], X##a1[3]}; t_ = t_ + t2_; \
                const float sa_ = red8(t_.x + t_.y); const f32x2 sa2_ = {sa_, sa_}, v2_ = {vv, vv}; \
                S[0] = S[0] * (f32x2){X##w0[0], X##w0[1]} + (sa2_ * (f32x2){X##b0[0], X##b0[1]} + v2_ * (f32x2){X##k0[0], X##k0[1]}); \
                S[1] = S[1] * (f32x2){X##w0[2], X##w0[3]} + (sa2_ * (f32x2){X##b0[2], X##b0[3]} + v2_ * (f32x2){X##k0[2], X##k0[3]}); \
                S[2] = S[2] * (f32x2){X##w1[0], X##w1[1]} + (sa2_ * (f32x2){X##b1[0], X##b1[1]} + v2_ * (f32x2){X##k1[0], X##k1[1]}); \
                S[3] = S[3] * (f32x2){X##w1[2], X##w1[3]} + (sa2_ * (f32x2){X##b1[2], X##b1[3]} + v2_ * (f32x2){X##k1[2], X##k1[3]}); \
                f32x2 q_ = S[0] * (f32x2){X##r0[0], X##r0[1]} + S[1] * (f32x2){X##r0[2], X##r0[3]}; f32x2 q2_ = S[2] * (f32x2){X##r1[0], X##r1[1]} + S[3] * (f32x2){X##r1[2], X##r1[3]}; q_ = q_ + q2_; \
                ob[(oidx)] = q_.x + q_.y; } while (0)
#define SC_COMP(X, j) do { SC_ROW(SA, X, X##va, (j) * 256); SC_ROW(SB, X, X##vb, (j) * 256 + 64); } while (0)
            f32x4 Ar0, Ar1, Aw0, Aw1, Ak0, Ak1, Aa0, Aa1, Ab0, Ab1, Br0, Br1, Bw0, Bw1, Bk0, Bk1, Ba0, Ba1, Bb0, Bb1; float Ava, Avb, Bva, Bvb;
            SC_LOAD(A, 0);
#pragma unroll
            for (int j = 0; j < 16; j += 2) {
                SC_LOAD(B, j + 1);
                __builtin_amdgcn_sched_barrier(0);
                SC_COMP(A, j);
                if (j + 2 < 16) SC_LOAD(A, j + 2);
                __builtin_amdgcn_sched_barrier(0);
                SC_COMP(B, j + 1);
            }
#undef SC_LOAD
#undef SC_ROW
#undef SC_COMP
            }
            SC_BAR();
        }
        __builtin_amdgcn_s_setprio(0);
    } else {
        SC_BAR();
        bf16x8 qf[2][6]; float mrun[2], lrun[2]; f32x16 o0[2], o1[2];
        const int aw = wid - 4;
        for (int ss = 0; ss < 256; ++ss) {
            const int t = ss & 63, bh = bh0 + 16 * (ss >> 6), cur = ss & 1;
            if (MODE & 2) {
            if (t == 0) {
#pragma unroll
                for (int qq = 0; qq < 2; ++qq) { const bf16* Qp = (const bf16*)(F.ws + WS_Q) + ((size_t)bh * SEQ + qb * 256 + aw * 64 + qq * 32 + r32) * 96;
#pragma unroll
                    for (int d0 = 0; d0 < 6; ++d0) qf[qq][d0] = *(const bf16x8*)(Qp + 16 * d0 + 8 * hi);
                    mrun[qq] = -1e30f; lrun[qq] = 0.f; o0[qq] = (f32x16){}; o1[qq] = (f32x16){}; } }
            const LAS unsigned char* kb_ = lds + cur * AK_BYTES; const LAS unsigned char* vb_ = lds + AV_OFF + cur * AV_BYTES;
#pragma unroll
            for (int qq = 0; qq < 2; ++qq) {
                f32x16 p0, p1;
#pragma unroll
                for (int r = 0; r < 16; ++r) { p0[r] = -8.f; p1[r] = -8.f; }
#pragma unroll
                for (int d0 = 0; d0 < 6; ++d0) {
                    const bf16x8 a0 = *(const LAS bf16x8*)(kb_ + r32 * AK_STRIDE + 32 * d0 + 16 * hi), a1 = *(const LAS bf16x8*)(kb_ + (32 + r32) * AK_STRIDE + 32 * d0 + 16 * hi);
                    p0 = MFMA32(a0, qf[qq][d0], p0); p1 = MFMA32(a1, qf[qq][d0], p1); }
                float ls = 0.f;
#pragma unroll
                for (int r = 0; r < 16; ++r) { p0[r] = __builtin_amdgcn_exp2f(p0[r]); p1[r] = __builtin_amdgcn_exp2f(p1[r]); ls += p0[r] + p1[r]; }
                lrun[qq] += ls;
                v4u pb[4];
                pb[0] = (v4u){pk2(p0[0], p0[1]), pk2(p0[2], p0[3]), pk2(p0[4], p0[5]), pk2(p0[6], p0[7])};
                pb[1] = (v4u){pk2(p0[8], p0[9]), pk2(p0[10], p0[11]), pk2(p0[12], p0[13]), pk2(p0[14], p0[15])};
                pb[2] = (v4u){pk2(p1[0], p1[1]), pk2(p1[2], p1[3]), pk2(p1[4], p1[5]), pk2(p1[6], p1[7])};
                pb[3] = (v4u){pk2(p1[8], p1[9]), pk2(p1[10], p1[11]), pk2(p1[12], p1[13]), pk2(p1[14], p1[15])};
#pragma unroll
                for (int sl = 0; sl < 4; ++sl) {
                    const LAS unsigned char* va = vb_ + r32 * AV_STRIDE + 2 * (16 * sl + 4 * hi);
                    const v2u x0 = *(const LAS v2u*)va, x1 = *(const LAS v2u*)(va + 16), y0 = *(const LAS v2u*)(va + 32 * AV_STRIDE), y1 = *(const LAS v2u*)(va + 32 * AV_STRIDE + 16);
                    const bf16x8 pbf = __builtin_bit_cast(bf16x8, pb[sl]);
                    o0[qq] = MFMA32(__builtin_bit_cast(bf16x8, ((v4u){x0.x, x0.y, x1.x, x1.y})), pbf, o0[qq]);
                    o1[qq] = MFMA32(__builtin_bit_cast(bf16x8, ((v4u){y0.x, y0.y, y1.x, y1.y})), pbf, o1[qq]); }
                if (t == 63) {
                    const float lt_ = lrun[qq] + __shfl_xor(lrun[qq], 32);
                    const float inv = 1.f / lt_;
                    bf16* op = (bf16*)(F.ws + WS_OA) + ((size_t)(bh >> 3) * SEQ + qb * 256 + aw * 64 + qq * 32 + r32) * 512 + (bh & 7) * 64;
#pragma unroll
                    for (int g4 = 0; g4 < 4; ++g4) {
                        *(v2u*)(op + 8 * g4 + 4 * hi) = (v2u){pk2(o0[qq][4 * g4] * inv, o0[qq][4 * g4 + 1] * inv), pk2(o0[qq][4 * g4 + 2] * inv, o0[qq][4 * g4 + 3] * inv)};
                        *(v2u*)(op + 32 + 8 * g4 + 4 * hi) = (v2u){pk2(o1[qq][4 * g4] * inv, o1[qq][4 * g4 + 1] * inv), pk2(o1[qq][4 * g4 + 2] * inv, o1[qq][4 * g4 + 3] * inv)}; } }
            }
            }
            SC_BAR();
        }
    }
    __syncthreads();
}

#define XB_TMO      128
#define XB_XCNT(j)  (256  + 64 * (j))
#define XB_XSUB(j)  (1280 + 64 * (j))
#define XB_XGEN(j)  (2304 + 64 * (j))
#define XB_TOP      3328
#define XB_TOPGEN   3392
#define XCD_BAR_WORDS 3456
#define XB_SPIN_CAP (1u << 18)

__device__ __forceinline__ unsigned xb_ld(unsigned* p)              { return __hip_atomic_load(p, __ATOMIC_RELAXED, __HIP_MEMORY_SCOPE_AGENT); }
__device__ __forceinline__ unsigned xb_add(unsigned* p, unsigned v) { return __hip_atomic_fetch_add(p, v, __ATOMIC_RELAXED, __HIP_MEMORY_SCOPE_AGENT); }
__device__ __forceinline__ unsigned xb_xcc_id() { return (unsigned)__builtin_amdgcn_s_getreg((3 << 11) | 20) & 0xFu; }
#define XB_SPIN(cond, bar) do { unsigned _sp = 0; while (cond) { __builtin_amdgcn_s_sleep(1); \
    if ((++_sp & 255u) == 0u) { if (xb_ld(&(bar)[XB_TMO])) break; if (_sp > XB_SPIN_CAP) { atomicAdd(&(bar)[XB_TMO], 1u); break; } } } } while (0)

struct XcdBarrier {
    unsigned* bar; unsigned x;
    volatile LAS unsigned* st;
};

__device__ __forceinline__ XcdBarrier xcd_barrier_post(unsigned* bar, volatile LAS unsigned* st) {
    XcdBarrier b; b.bar = bar; b.x = xb_xcc_id(); b.st = st;
    if (threadIdx.x == 0) (void)xb_add(&bar[XB_XCNT(b.x)], 1u);
    return b;
}
__device__ __forceinline__ void xcd_barrier_complete(unsigned* bar, unsigned x, unsigned& nloc, unsigned& nx) {
    const unsigned G = gridDim.x * gridDim.y * gridDim.z;
    unsigned sum, cnt, mine, sp = 0u;
    for (;;) {
        sum = 0u; cnt = 0u; mine = 0u;
#pragma unroll
        for (unsigned j = 0; j < 16; ++j) { const unsigned c = xb_ld(&bar[XB_XCNT(j)]); sum += c; cnt += (c > 0u) ? 1u : 0u; mine = (j == x) ? c : mine; }
        if (sum == G) break;
        __builtin_amdgcn_s_sleep(1);
        if ((++sp & 255u) == 0u) { if (xb_ld(&bar[XB_TMO])) break; if (sp > XB_SPIN_CAP) { atomicAdd(&bar[XB_TMO], 1u); break; } }
    }
    nloc = mine > 0u ? mine : 1u; nx = cnt > 0u ? cnt : 1u;
}

__device__ __forceinline__ void xcd_barrier(const XcdBarrier& b) {
    asm volatile("s_waitcnt vmcnt(0)" ::: "memory");
    __syncthreads();
    if (threadIdx.x == 0) {
        unsigned* bar = b.bar;
        __builtin_amdgcn_s_waitcnt(0);
        unsigned nloc = b.st[0], nx = b.st[1];
        if (nloc == 0u) { xcd_barrier_complete(bar, b.x, nloc, nx); b.st[0] = nloc; b.st[1] = nx; }
        const unsigned old = xb_add(&bar[XB_XSUB(b.x)], 1u);
        const unsigned gen = old / nloc;
        if (old + 1u == (gen + 1u) * nloc) {
            __builtin_amdgcn_fence(__ATOMIC_RELEASE, "agent");
            asm volatile("s_waitcnt vmcnt(0)" ::: "memory");
            const unsigned og = xb_add(&bar[XB_TOP], 1u);
            const unsigned tg = og / nx;
            if (og + 1u == (tg + 1u) * nx) xb_add(&bar[XB_TOPGEN], 1u);
            else XB_SPIN(xb_ld(&bar[XB_TOPGEN]) == tg, bar);
            __builtin_amdgcn_fence(__ATOMIC_ACQUIRE, "agent");
            xb_add(&bar[XB_XGEN(b.x)], 1u);
            asm volatile("s_waitcnt vmcnt(0)" ::: "memory");
        } else {
            XB_SPIN(xb_ld(&bar[XB_XGEN(b.x)]) == gen, bar);
            __builtin_amdgcn_fence(__ATOMIC_ACQUIRE, "agent");
            asm volatile("s_waitcnt vmcnt(0)" ::: "memory");
        }
    }
    __syncthreads();
}

constexpr int N_PHASES = 13;
__global__ void __launch_bounds__(512, 2) fwd_kernel(Args args) {
    extern __shared__ __attribute__((aligned(16))) unsigned char lds_raw[];
    cg::grid_group grid = cg::this_grid();
    Frame F;
    F.lds = (LAS unsigned char*)lds_raw;
    F.tid = threadIdx.x; F.lane = F.tid & 63; F.wave = __builtin_amdgcn_readfirstlane(F.tid >> 6); F.G = gridDim.x; F.bid = blockIdx.x;
#pragma unroll
    for (int i = 0; i < 32; ++i) F.in[i] = args.in[i];
    F.out = args.out; F.ws = args.ws;
    unsigned char* ws = args.ws;
    const int lo = args.ph_lo, hi = args.ph_hi;
#ifndef SKIPMASK
#define SKIPMASK 0
#endif
#define IN(k) (lo <= (k) && (k) < hi && !((SKIPMASK >> (k)) & 1))
    volatile LAS unsigned* xst = (volatile LAS unsigned*)(F.lds + 131072 + 64);
    if (F.tid == 0) { xst[0] = 0u; xst[1] = 0u; }
    __syncthreads();
    if (args.ph_hi < 0) grid.sync();
    const XcdBarrier xbar = xcd_barrier_post((unsigned*)ws, xst);
#define SEAM(k) do { if (IN(k) && IN((k) + 1)) { xcd_barrier(xbar); } } while (0)
#ifndef REPMASK
#define REPMASK 0
#endif
#define REP(k) for (int rep_ = 0; rep_ < 1 + ((REPMASK >> (k)) & 1); ++rep_)
    bf16* PG = (bf16*)F.out;
    if (IN(0)) REP(0) { p0_prologue(F); } SEAM(0);
    if (IN(1)) { run_gemm(F, (const bf16*)(ws + WS_XN), 1024, (const bf16*)(ws + WS_WIN), 1024, 4608, 1024, FnIn{PG, (bf16*)(ws + WS_PR), (bf16*)(ws + WS_PM), F.in[4]});
#ifdef DUP1
        run_gemm(F, (const bf16*)(ws + WS_XN), 1024, (const bf16*)(ws + WS_WIN), 1024, 4608, 1024, FnIn{PG, (bf16*)(ws + WS_PR), (bf16*)(ws + WS_PM), F.in[4]});
#endif
    } SEAM(1);
    if (IN(2)) REP(2) { if (!((SKIPMASK >> 13) & 1)) p2_shift(F); } SEAM(2);
    if (IN(3)) {
        if (!((SKIPMASK >> 14) & 1)) for (int it = (F.G == 256) ? (((F.bid & 7) << 5) | (F.bid >> 3)) : F.bid; it < 256; it += F.G) mla_item(F, it);
        run_gemm(F, (const bf16*)(ws + WS_LI), 256, (const bf16*)(ws + WS_WL1), 128, 1024, 128, FnLora1{(bf16*)(ws + WS_ASIG), (bf16*)(ws + WS_DECF), F.in[16], F.in[14]});
        run_gemm(F, (const bf16*)(ws + WS_LI) + 128, 256, (const bf16*)(ws + WS_WL2), 128, 512, 128, FnLora2{(bf16*)(ws + WS_DECB), F.in[14] + 512});

#ifdef DUP3
#if DUP3 & 1
        if (!((SKIPMASK >> 14) & 1)) for (int it = (F.G == 256) ? (((F.bid & 7) << 5) | (F.bid >> 3)) : F.bid; it < 256; it += F.G) mla_item(F, it);
#endif
#if DUP3 & 2
        run_gemm(F, (const bf16*)(ws + WS_LI), 256, (const bf16*)(ws + WS_WL1), 128, 1024, 128, FnLora1{(bf16*)(ws + WS_ASIG), (bf16*)(ws + WS_DECF), F.in[16], F.in[14]});
        run_gemm(F, (const bf16*)(ws + WS_LI) + 128, 256, (const bf16*)(ws + WS_WL2), 128, 512, 128, FnLora2{(bf16*)(ws + WS_DECB), F.in[14] + 512});


#endif
#endif
    } SEAM(3);
    if (IN(4)) {
#ifndef REP_SCAN
#define REP_SCAN 1
#endif
#ifndef REP_ATTN
#define REP_ATTN 1
#endif
#ifndef P4FORM
#define P4FORM 1
#endif
        if (F.G == 256) { if (P4FORM == 2) p4_fused2<3>(F); else p4_fused<3>(F);
#ifdef DUP4
            if (P4FORM == 2) p4_fused2<DUP4>(F); else p4_fused<DUP4>(F);
#endif
        }
        else {
        for (int rep = 0; rep < REP_SCAN; ++rep) for (int it = F.bid; it < 256; it += F.G) scan_item(F, it);
        for (int rep = 0; rep < REP_ATTN; ++rep) for (int u = F.bid; u < 1024; u += F.G) attn_unit(F, u >> 4, u & 15);
        }
    } SEAM(4);
    if (IN(5)) { p5_gn(F); } SEAM(5);
    if (IN(6)) {
        run_gemm(F, (const bf16*)(ws + WS_SG), 256, (const bf16*)(ws + WS_WGF), 128, 512, 128, FnMulAcc<0>{(bf16*)(ws + WS_OBC), 512, (const bf16*)(ws + WS_OF), 512, 0});
        run_gemm(F, (const bf16*)(ws + WS_SG) + 128, 256, (const bf16*)(ws + WS_WGB), 128, 512, 128, FnMulAcc<1>{(bf16*)(ws + WS_OBC), 512, (const bf16*)(ws + WS_OB), 512, 0});

#ifdef DUP67

        run_gemm(F, (const bf16*)(ws + WS_SG), 256, (const bf16*)(ws + WS_WGF), 128, 512, 128, FnMulAcc<0>{(bf16*)(ws + WS_OBC), 512, (const bf16*)(ws + WS_OF), 512, 0});
        run_gemm(F, (const bf16*)(ws + WS_SG) + 128, 256, (const bf16*)(ws + WS_WGB), 128, 512, 128, FnMulAcc<1>{(bf16*)(ws + WS_OBC), 512, (const bf16*)(ws + WS_OB), 512, 0});

#endif
    } SEAM(6);
    if (IN(7)) {
        run_gemm(F, (const bf16*)(ws + WS_OA), 512, (const bf16*)(ws + WS_WO), 1024, 1024, 512, FnMulAcc<0>{(bf16*)(ws + WS_M), 1024, PG, 2048, 0});
        run_gemm(F, (const bf16*)(ws + WS_OBC), 512, (const bf16*)(ws + WS_WO) + 512, 1024, 1024, 512, FnMulAcc<1>{(bf16*)(ws + WS_M), 1024, PG, 2048, 1024});

#ifdef DUP67

        run_gemm(F, (const bf16*)(ws + WS_OA), 512, (const bf16*)(ws + WS_WO), 1024, 1024, 512, FnMulAcc<0>{(bf16*)(ws + WS_M), 1024, PG, 2048, 0});
        run_gemm(F, (const bf16*)(ws + WS_OBC), 512, (const bf16*)(ws + WS_WO) + 512, 1024, 1024, 512, FnMulAcc<1>{(bf16*)(ws + WS_M), 1024, PG, 2048, 1024});

#endif
    } SEAM(7);
    if (IN(8)) { run_gemm(F, (const bf16*)(ws + WS_M), 1024, (const bf16*)(ws + WS_WM), 1024, 1024, 1024, FnResidNorm{F.in[0], F.out, (bf16*)(ws + WS_XN), (float*)(ws + WS_RSQ)}); } SEAM(8);
    if (IN(10)) { run_gemm(F, (const bf16*)(ws + WS_XN), 1024, (const bf16*)(ws + WS_WGU), 1024, 2816, 1024, FnStoreScaled{(bf16*)(ws + WS_GU), 2816, (const float*)(ws + WS_RSQ)});
#ifdef DUP10
        run_gemm(F, (const bf16*)(ws + WS_XN), 1024, (const bf16*)(ws + WS_WGU), 1024, 2816, 1024, FnStoreScaled{(bf16*)(ws + WS_GU), 2816, (const float*)(ws + WS_RSQ)});
#endif
    } SEAM(10);
    if (IN(11)) { run_gemm(F, (const bf16*)(ws + WS_XN), 1024, (const bf16*)(ws + WS_WGU) + (size_t)2816 * 1024, 1024, 2816, 1024, FnConvAct{(const bf16*)(ws + WS_GU), (bf16*)(ws + WS_ACT), F.in[29], F.in[30], (const float*)(ws + WS_RSQ)}); } SEAM(11);
    if (IN(12)) { run_gemm(F, (const bf16*)(ws + WS_ACT), 2816, (const bf16*)(ws + WS_WD), 2816, 1024, 2816, FnResidBf{(const bf16*)(ws + WS_XN), F.out}); }
#ifdef XSYNC
    for (int i = 0; i < XSYNC; ++i) xcd_barrier(xbar);
#endif
#undef IN
#undef SEAM
}

#ifndef MK_PER_PHASE
#define MK_PER_PHASE 0
#endif
extern "C" void kernel_launch(void* const* d_in, const int* in_sizes, int n_in, void* d_out, int out_size, void* d_ws, size_t ws_size, hipStream_t stream) {
    static int grid = 0;
    if (grid == 0) {
        if (n_in != 32 || out_size != NTOK * DM || ws_size < WS_END) { fprintf(stderr, "kernel_launch: unexpected problem (n_in %d out %d ws %zu)\n", n_in, out_size, ws_size); grid = -1; return; }
        int dev = 0, cus = 0, per_cu = 0;
        hipGetDevice(&dev); hipDeviceGetAttribute(&cus, hipDeviceAttributeMultiprocessorCount, dev);
        hipFuncSetAttribute((const void*)fwd_kernel, hipFuncAttributeMaxDynamicSharedMemorySize, LDS_BYTES);
        if (hipOccupancyMaxActiveBlocksPerMultiprocessor(&per_cu, (const void*)fwd_kernel, 512, LDS_BYTES) != hipSuccess || per_cu < 1) per_cu = 1;
        (void)hipGetLastError();
        grid = cus * per_cu;
    }
    if (grid < 0) return;
    Args a{};
    for (int i = 0; i < 32; ++i) a.in[i] = (const float*)d_in[i];
    a.out = (float*)d_out; a.ws = (unsigned char*)d_ws;
    if (hipMemsetAsync(d_ws, 0, 16384, stream) != hipSuccess) { fprintf(stderr, "kernel_launch: memset of the barrier word failed\n"); return; }
    void* params[] = {&a};
#if MK_PER_PHASE
    for (int p = 0; p < N_PHASES; ++p) { a.ph_lo = p; a.ph_hi = p + 1;
        hipError_t e = hipLaunchCooperativeKernel((void*)fwd_kernel, dim3(grid), dim3(512), params, LDS_BYTES, stream);
        if (e != hipSuccess) { fprintf(stderr, "launch %d failed: %s\n", p, hipGetErrorString(e)); break; } }
#else
    a.ph_lo = 0; a.ph_hi = N_PHASES;
    hipError_t e = hipLaunchCooperativeKernel((void*)fwd_kernel, dim3(grid), dim3(512), params, LDS_BYTES, stream);
    if (e != hipSuccess) fprintf(stderr, "cooperative launch failed: %s (grid %d)\n", hipGetErrorString(e), grid);
#endif
}
```

```cpp
#include <hip/hip_runtime.h>
#include <hip/hip_cooperative_groups.h>
#include <cstdio>
#include <cstdint>
namespace cg = cooperative_groups;
namespace pg8 {
#define PG8_LAS __attribute__((address_space(3)))
typedef unsigned short bf16_t;
typedef short bf16x8 __attribute__((ext_vector_type(8)));
typedef float f32x4 __attribute__((ext_vector_type(4)));
typedef unsigned u32x4 __attribute__((ext_vector_type(4)));
constexpr int BM = 256, BK = 64, HALF = 128, HTB = HALF * BK * 2  , STAGE_BYTES = 8 * HTB, NXCD = 8, WGM = 8;

__host__ __device__ __forceinline__ int lds_byte(int r, int c) { const int st = (r >> 4) * 2 + (c >> 5), rr = r & 15, cc = c & 31, ob = rr * 64 + cc * 2; return st * 1024 + (ob ^ (((ob >> 9) & 1) << 5)); }
__host__ __device__ __forceinline__ void stage_rc(int b, int& R, int& C) { const int st = b / 1024, sb = b % 1024, swz = sb ^ (((sb >> 9) & 1) << 5); R = (st >> 1) * 16 + swz / 64; C = (st & 1) * 32 + (swz % 64) / 2; }
__host__ __device__ __forceinline__ int perm32(int rho) { const int n = rho >> 4, i = rho & 15; return 8 * (i >> 2) + 4 * n + (i & 3); }

struct Unit { int pm, pn; };
struct Gemm { const bf16_t* A; const bf16_t* Bt; int M, N, K, lda, ldb; };

struct StaticOrder {
    int nM, nN, nwg, G, c;
    __host__ __device__ void init(int M, int N, int G_, int c_) { nM = M / BM; nN = N / BM; nwg = nM * nN; G = G_; c = c_; }
    __host__ __device__ bool next(int i, Unit& u) const {
        const long L = (long)i * G + c; if (L >= nwg) return false;
        int wgid = (int)L; { const int q = nwg / NXCD, r = nwg % NXCD, xcd = wgid % NXCD, off = wgid / NXCD; wgid = (xcd < r ? xcd * (q + 1) : r * (q + 1) + (xcd - r) * q) + off; }
        const int nig = WGM * nN, gid = wgid / nig, fm = gid * WGM, gsz = (nM - fm) < WGM ? (nM - fm) : WGM;
        u.pm = fm + ((wgid % nig) % gsz); u.pn = (wgid % nig) / gsz; return true;
    }
    __device__ __forceinline__ void a_ready(const Unit&) const {}
    __device__ __forceinline__ void done(const Unit&) const {}
};

__device__ __forceinline__ unsigned cvt_pk_bf16(float lo, float hi) { unsigned r; asm volatile("v_cvt_pk_bf16_f32 %0, %1, %2" : "=v"(r) : "v"(lo), "v"(hi)); return r; }
template <class Epi, class Sched, bool ALIGN_EPI = false, bool SP2 = false>
__device__ __forceinline__ void gemm_phase(PG8_LAS unsigned char* lds, const Gemm g, const Sched& S, const Epi& E) {
    const int tid = threadIdx.x, wid = __builtin_amdgcn_readfirstlane(tid >> 6), lane = tid & 63, wr = wid >> 2, wc = wid & 3, fr = lane & 15, fq = lane >> 4;
    const int K = g.K, nt = K / BK;
    unsigned voffA[2], voffB[2];
#pragma unroll
    for (int i = 0; i < 2; ++i) { int R, C; stage_rc(tid * 16 + i * 8192, R, C); const int Rb = Epi::PERM ? ((R & ~31) + perm32(R & 31)) : R;
        voffA[i] = (unsigned)(R * g.lda + C) * 2u; voffB[i] = (unsigned)(Rb * g.ldb + C) * 2u; }
    const size_t kstep = (size_t)(BK * 2);
    const size_t hstepA = (size_t)HALF * g.lda * 2, hstepB = (size_t)HALF * g.ldb * 2;
    const size_t tstepA = 2 * hstepA, tstepB = 2 * hstepB;
    const unsigned ldsw = (unsigned)wid * 1024u;
    const int aoff = lds_byte(wr * 64 + fr, fq * 8), boff = lds_byte(wc * 32 + fr, fq * 8);
#define PG8_SA(b, h) (((b) * 2 + (h)) * HTB)
#define PG8_SB(b, h) ((4 + (b) * 2 + (h)) * HTB)
#define PG8_STAGE(bufoff, gbase, voff) do { _Pragma("unroll") for (int _i = 0; _i < 2; ++_i) \
        __builtin_amdgcn_global_load_lds((const unsigned*)((const char*)(gbase) + (voff)[_i]), (PG8_LAS unsigned*)(lds + (bufoff) + ldsw + _i * 8192), 16, 0, 0); } while (0)
#define PG8_LDA(dst, b, h) do { _Pragma("unroll") for (int m = 0; m < 4; ++m) _Pragma("unroll") for (int k = 0; k < 2; ++k) dst[m][k] = *(const PG8_LAS bf16x8*)(lds + PG8_SA(b, h) + aoff + m * 2048 + k * 1024); } while (0)
#define PG8_LDB(dst, b, h) do { _Pragma("unroll") for (int n = 0; n < 2; ++n) _Pragma("unroll") for (int k = 0; k < 2; ++k) dst[n][k] = *(const PG8_LAS bf16x8*)(lds + PG8_SB(b, h) + boff + n * 2048 + k * 1024); } while (0)
#define PG8_MMA(ai, bj, At, Bt) do { __builtin_amdgcn_s_setprio(1); _Pragma("unroll") for (int m = 0; m < 4; ++m) _Pragma("unroll") for (int n = 0; n < 2; ++n) _Pragma("unroll") for (int k = 0; k < 2; ++k) \
        acc[ai][bj][m][n] = __builtin_amdgcn_mfma_f32_16x16x32_bf16(Bt[n][k], At[m][k], acc[ai][bj][m][n], 0, 0, 0); __builtin_amdgcn_s_setprio(0); } while (0)
#define PG8_WAIT_V(n) asm volatile("s_waitcnt vmcnt(" #n ")" ::: "memory")
#define PG8_WAIT_L(n) asm volatile("s_waitcnt lgkmcnt(" #n ")" ::: "memory")
#define PG8_BAR __builtin_amdgcn_s_barrier()
#define PG8_SCHED __builtin_amdgcn_sched_barrier(0)
    Unit cur, nxt; int ui = 0;
    if (!S.next(0, cur)) return;
    f32x4 acc[2][2][4][2];
#pragma unroll
    for (int a = 0; a < 2; ++a)
#pragma unroll
        for (int b = 0; b < 2; ++b)
#pragma unroll
            for (int m = 0; m < 4; ++m)
#pragma unroll
                for (int n = 0; n < 2; ++n) acc[a][b][m][n] = (f32x4){0.f, 0.f, 0.f, 0.f};
    bf16x8 At[4][2], B0[2][2], B1[2][2];
    const char* cA = (const char*)g.A + (size_t)cur.pm * tstepA; const char* cB = (const char*)g.Bt + (size_t)cur.pn * tstepB;
    S.a_ready(cur);
    if constexpr (SP2) {
        PG8_STAGE(PG8_SB(0, 0), cB, voffB); PG8_STAGE(PG8_SB(0, 1), cB + hstepB, voffB); PG8_STAGE(PG8_SA(0, 0), cA, voffA); PG8_STAGE(PG8_SA(0, 1), cA + hstepA, voffA);
        if (wr == 1) PG8_BAR;
        PG8_WAIT_V(2); PG8_BAR;
        PG8_STAGE(PG8_SB(1, 0), cB + kstep, voffB); PG8_STAGE(PG8_SA(1, 0), cA + kstep, voffA); PG8_STAGE(PG8_SB(1, 1), cB + hstepB + kstep, voffB);
        PG8_WAIT_V(6); PG8_BAR;
    } else {
        PG8_STAGE(PG8_SB(0, 0), cB, voffB); PG8_STAGE(PG8_SA(0, 0), cA, voffA); PG8_STAGE(PG8_SB(0, 1), cB + hstepB, voffB); PG8_STAGE(PG8_SA(0, 1), cA + hstepA, voffA);
        if (wr == 1) PG8_BAR;
        PG8_WAIT_V(4); PG8_BAR;
        PG8_STAGE(PG8_SB(1, 0), cB + kstep, voffB); PG8_STAGE(PG8_SA(1, 0), cA + kstep, voffA); PG8_STAGE(PG8_SB(1, 1), cB + hstepB + kstep, voffB);
        PG8_WAIT_V(6); PG8_BAR;
    }
    for (;;) {
        const bool has_next = S.next(ui + 1, nxt);
        const char* nA = has_next ? (const char*)g.A + (size_t)nxt.pm * tstepA : cA; const char* nB = has_next ? (const char*)g.Bt + (size_t)nxt.pn * tstepB : cB;
        for (int t = 0; t < nt; t += 2) {
            const bool last = (t == nt - 2);
            const char* a1 = cA + (size_t)(t + 1) * kstep;
            const char* a2 = last ? nA : cA + (size_t)(t + 2) * kstep; const char* b2 = last ? nB : cB + (size_t)(t + 2) * kstep;
            const char* a3 = a2 + kstep; const char* b3 = b2 + kstep;
            if (last && has_next) S.a_ready(nxt);
            if constexpr (SP2) {
            PG8_LDB(B0, 0, 0); PG8_LDB(B1, 0, 1); PG8_SCHED; PG8_LDA(At, 0, 0); PG8_STAGE(PG8_SA(1, 1), a1 + hstepA, voffA);
            PG8_WAIT_V(8); PG8_WAIT_L(0); PG8_BAR; PG8_MMA(0, 0, At, B0); PG8_MMA(0, 1, At, B1); PG8_BAR; PG8_SCHED;
            PG8_LDA(At, 0, 1); PG8_STAGE(PG8_SB(0, 0), b2, voffB); PG8_STAGE(PG8_SB(0, 1), b2 + hstepB, voffB); PG8_STAGE(PG8_SA(0, 0), a2, voffA);
            PG8_WAIT_V(8); PG8_WAIT_L(0); PG8_BAR; PG8_MMA(1, 0, At, B0); PG8_MMA(1, 1, At, B1); PG8_BAR; PG8_SCHED;
            PG8_LDB(B0, 1, 0); PG8_LDB(B1, 1, 1); PG8_SCHED; PG8_LDA(At, 1, 0); PG8_STAGE(PG8_SA(0, 1), a2 + hstepA, voffA);
            PG8_WAIT_V(8); PG8_WAIT_L(0); PG8_BAR; PG8_MMA(0, 0, At, B0); PG8_MMA(0, 1, At, B1); PG8_BAR; PG8_SCHED;
            PG8_LDA(At, 1, 1); PG8_STAGE(PG8_SB(1, 0), b3, voffB); PG8_STAGE(PG8_SB(1, 1), b3 + hstepB, voffB); PG8_STAGE(PG8_SA(1, 0), a3, voffA);
            PG8_WAIT_V(8); PG8_WAIT_L(0); PG8_BAR; PG8_MMA(1, 0, At, B0); PG8_MMA(1, 1, At, B1); PG8_BAR; PG8_SCHED;
            } else {
            PG8_LDB(B0, 0, 0); PG8_SCHED; PG8_LDA(At, 0, 0); PG8_STAGE(PG8_SA(1, 1), a1 + hstepA, voffA);
            PG8_WAIT_L(8); PG8_BAR; PG8_WAIT_L(0); PG8_MMA(0, 0, At, B0); PG8_BAR; PG8_SCHED;
            PG8_LDB(B1, 0, 1); PG8_STAGE(PG8_SB(0, 0), b2, voffB);
            PG8_BAR; PG8_WAIT_L(0); PG8_MMA(0, 1, At, B1); PG8_BAR;
            PG8_LDA(At, 0, 1); PG8_STAGE(PG8_SA(0, 0), a2, voffA);
            PG8_BAR; PG8_WAIT_L(0); PG8_MMA(1, 0, At, B0); PG8_BAR; PG8_SCHED;
            PG8_STAGE(PG8_SB(0, 1), b2 + hstepB, voffB);
            PG8_WAIT_V(6); PG8_BAR; PG8_MMA(1, 1, At, B1); PG8_BAR;
            PG8_LDB(B0, 1, 0); PG8_SCHED; PG8_LDA(At, 1, 0); PG8_STAGE(PG8_SA(0, 1), a2 + hstepA, voffA);
            PG8_WAIT_L(8); PG8_BAR; PG8_WAIT_L(0); PG8_MMA(0, 0, At, B0); PG8_BAR; PG8_SCHED;
            PG8_LDB(B1, 1, 1); PG8_STAGE(PG8_SB(1, 0), b3, voffB);
            PG8_BAR; PG8_WAIT_L(0); PG8_MMA(0, 1, At, B1); PG8_BAR;
            PG8_LDA(At, 1, 1); PG8_STAGE(PG8_SA(1, 0), a3, voffA);
            PG8_BAR; PG8_WAIT_L(0); PG8_MMA(1, 0, At, B0); PG8_BAR; PG8_SCHED;
            PG8_STAGE(PG8_SB(1, 1), b3 + hstepB, voffB);
            PG8_WAIT_V(6); PG8_BAR; PG8_MMA(1, 1, At, B1); PG8_BAR;
            }
        }
        if constexpr (ALIGN_EPI) { if (wr == 0) PG8_BAR; }
        if constexpr (!Epi::AFTER_DRAIN) { E(acc, cur, wr, wc, fr, fq); S.done(cur); }
        if (!has_next) break;
#pragma unroll
        for (int a = 0; a < 2; ++a)
#pragma unroll
            for (int b = 0; b < 2; ++b)
#pragma unroll
                for (int m = 0; m < 4; ++m)
#pragma unroll
                    for (int n = 0; n < 2; ++n) acc[a][b][m][n] = (f32x4){0.f, 0.f, 0.f, 0.f};
        cur = nxt; cA = nA; cB = nB; ++ui;
        if constexpr (ALIGN_EPI) { if (wr == 1) PG8_BAR; }
    }
    PG8_WAIT_V(0);
    if constexpr (!ALIGN_EPI) { if (wr == 0) PG8_BAR; }
    PG8_BAR;
    if constexpr (Epi::AFTER_DRAIN) { E.fused(acc, cur, wr, wc, fr, fq, lds, wid, lane); S.done(cur); }
#undef PG8_SA
#undef PG8_SB
#undef PG8_STAGE
#undef PG8_LDA
#undef PG8_LDB
#undef PG8_MMA
#undef PG8_WAIT_V
#undef PG8_WAIT_L
#undef PG8_BAR
#undef PG8_SCHED
}
}

#define GAS __attribute__((address_space(1)))
#define LAS __attribute__((address_space(3)))
typedef unsigned short bf16;
typedef unsigned v4u __attribute__((ext_vector_type(4)));
typedef unsigned v2u __attribute__((ext_vector_type(2)));
typedef float f32x4 __attribute__((ext_vector_type(4)));
typedef float f32x2 __attribute__((ext_vector_type(2)));
typedef float f32x16 __attribute__((ext_vector_type(16)));
typedef short bf16x8 __attribute__((ext_vector_type(8)));

constexpr int NTOK = 32768, SEQ = 4096, DM = 1024;
constexpr size_t MiB = 1u << 20;
constexpr size_t WS_WIN = 1 * MiB, WS_WUQ = 10 * MiB, WS_WUKV = 10 * MiB + 512 * 1024, WS_WL1 = 10 * MiB + 768 * 1024, WS_WL2 = 11 * MiB, WS_WGF = 11 * MiB + 128 * 1024,
                 WS_WGB = 11 * MiB + 256 * 1024, WS_WO = 12 * MiB, WS_WM = 14 * MiB, WS_WGU = 16 * MiB, WS_WD = 27 * MiB;
constexpr size_t WS_XN = 33 * MiB, WS_PR = 97 * MiB, WS_PM = 225 * MiB, WS_RKV = 257 * MiB, WS_LI = 353 * MiB, WS_SG = 369 * MiB, WS_VT = 385 * MiB, WS_OF = 417 * MiB, WS_OB = 449 * MiB;
constexpr size_t WS_ASIG = 33 * MiB, WS_DECF = 65 * MiB, WS_DECB = 97 * MiB, WS_Q = 129 * MiB, WS_K = 177 * MiB, WS_OA = 225 * MiB, WS_OBC = 65 * MiB, WS_M = 97 * MiB, WS_GU = 97 * MiB, WS_ACT = 273 * MiB;
constexpr size_t WS_END = 481 * MiB, WS_RSQ = 65536;
constexpr int LDS_BYTES = 135168;
constexpr float LOG2E = 1.4426950408889634f;
constexpr float QSCALE = 0.10206207261596575f * 1.4426950408889634f;

struct Args { const float* in[32]; float* out; unsigned char* ws; int ph_lo, ph_hi; };

typedef __bf16 bf16x2_t __attribute__((ext_vector_type(2)));
__device__ __forceinline__ unsigned pk2(float lo, float hi) { unsigned r; asm volatile("v_cvt_pk_bf16_f32 %0, %1, %2" : "=v"(r) : "v"(lo), "v"(hi)); return r; }
__device__ __forceinline__ unsigned pk2s(float lo, float hi) { const f32x2 v = {lo, hi}; return __builtin_bit_cast(unsigned, __builtin_convertvector(v, bf16x2_t)); }
__device__ __forceinline__ float bflo(unsigned u) { return __uint_as_float(u << 16); }
__device__ __forceinline__ float bfhi(unsigned u) { return __uint_as_float(u & 0xffff0000u); }
__device__ __forceinline__ float bf1(bf16 b) { return __uint_as_float((unsigned)b << 16); }
__device__ __forceinline__ float fexp(float x) { return __builtin_amdgcn_exp2f(x * LOG2E); }
__device__ __forceinline__ float sigm(float x) { return __builtin_amdgcn_rcpf(1.f + fexp(-x)); }
__device__ __forceinline__ float ftanh(float x) { return 1.f - 2.f * __builtin_amdgcn_rcpf(1.f + fexp(2.f * x)); }
__device__ __forceinline__ float wave_sum(float v) {
#pragma unroll
    for (int o = 1; o < 64; o <<= 1) v += __shfl_xor(v, o);
    return v;
}
template <int CTRL> __device__ __forceinline__ float dppf(float x) { return __int_as_float(__builtin_amdgcn_update_dpp(0, __float_as_int(x), CTRL, 0xf, 0xf, true)); }
__device__ __forceinline__ float red8(float x) { x += dppf<0xB1>(x); x += dppf<0x4E>(x); x += dppf<0x141>(x); return x; }
__device__ __forceinline__ int crow(int r, int hi) { return (r & 3) + 8 * (r >> 2) + 4 * hi; }

struct Frame {
    LAS unsigned char* lds;
    int tid, lane, wave, G, bid;
    const float* in[32]; float* out; unsigned char* ws;
};

__device__ __forceinline__ void tr_item(const float* W, int ldn, int nblk, bf16* WT, int ldk, LAS float* scr, int item, int lane, const float* ksc = nullptr) {
    const int kb = item / nblk, nb = item % nblk, k0 = 64 * kb, n0 = 32 * nb;
#pragma unroll 8
    for (int i = 0; i < 32; ++i) { const int kk = 2 * i + (lane >> 5); float w_ = __builtin_nontemporal_load(&W[(size_t)(k0 + kk) * ldn + n0 + (lane & 31)]); if (ksc) w_ *= ksc[k0 + kk]; scr[kk * 33 + (lane & 31)] = w_; }
    asm volatile("s_waitcnt lgkmcnt(0)" ::: "memory");
    const int c = lane & 7;
#pragma unroll
    for (int j = 0; j < 4; ++j) { const int n = (lane >> 3) + 8 * j; const LAS float* s = scr + (8 * c) * 33 + n;
        v4u o; o.x = pk2(s[0 * 33], s[1 * 33]); o.y = pk2(s[2 * 33], s[3 * 33]); o.z = pk2(s[4 * 33], s[5 * 33]); o.w = pk2(s[6 * 33], s[7 * 33]);
        *(v4u*)(WT + (size_t)(n0 + n) * ldk + k0 + 8 * c) = o; }
    asm volatile("s_waitcnt lgkmcnt(0)" ::: "memory");
}
__device__ __forceinline__ void rms_row(const float* xrow, const float* g, bf16* orow, int lane) {
    const f32x4* xr = (const f32x4*)xrow + lane; const f32x4* gr = (const f32x4*)g + lane;
    f32x4 v[4]; float s = 0.f;
#pragma unroll
    for (int j = 0; j < 4; ++j) { v[j] = __builtin_nontemporal_load(&xr[64 * j]); s += (v[j].x * v[j].x + v[j].y * v[j].y) + (v[j].z * v[j].z + v[j].w * v[j].w); }
    const float rstd = 1.f / sqrtf(wave_sum(s) * (1.f / 1024.f) + 1e-6f);
    v2u* o8 = (v2u*)orow + lane;
#pragma unroll
    for (int j = 0; j < 4; ++j) { const f32x4 gg = gr[64 * j]; v2u o; o.x = pk2(v[j].x * rstd * gg.x, v[j].y * rstd * gg.y); o.y = pk2(v[j].z * rstd * gg.z, v[j].w * rstd * gg.w); o8[64 * j] = o; }
}
__device__ __forceinline__ void zero_fill(Frame& F, bf16* p, int rows, int cols, int ld) {
    const int cpr = cols / 8, n = rows * cpr;
    for (int i = F.bid * 512 + F.tid; i < n; i += F.G * 512) { const int r = i / cpr, c = i % cpr; *(v4u*)(p + (size_t)r * ld + 8 * c) = (v4u){0u, 0u, 0u, 0u}; }
}
__device__ __forceinline__ void p0_prologue(Frame& F) {
    LAS float* scr = (LAS float*)(F.lds + F.wave * 16384);
    const int gw = F.bid * 8 + F.wave, NGW = F.G * 8;
    unsigned char* ws = F.ws;
    bf16* WIN = (bf16*)(ws + WS_WIN);
    constexpr int J0 = 16 * 13, J1 = J0 + 16 * 62, J2 = J1 + 16 * 64, J3 = J2 + 4 * 24, J4 = J3 + 2 * 32, J5 = J4 + 16, J6 = J5 + 16, J7 = J6 + 16, J8 = J7 + 32, J9 = J8 + 32,
                  J10 = J9 + 512, J11 = J10 + 512, J12 = J11 + 1408, J13 = J12 + 1408, J14 = J13 + 1408;
    for (int it = gw; it < J14; it += NGW) {
        if (it < J0) tr_item(F.in[3], 4448, 13, WIN + (size_t)4096 * 1024, 1024, scr, it, F.lane);
        else if (it < J1) tr_item(F.in[3] + 416, 4448, 62, WIN + (size_t)2048 * 1024, 1024, scr, it - J0, F.lane);
        else if (it < J2) tr_item(F.in[3] + 2400, 4448, 64, WIN, 1024, scr, it - J1, F.lane);
        else if (it < J3) tr_item(F.in[7], 768, 24, (bf16*)(ws + WS_WUQ), 256, scr, it - J2, F.lane);
        else if (it < J4) tr_item(F.in[8], 1024, 32, (bf16*)(ws + WS_WUKV), 128, scr, it - J3, F.lane);
        else if (it < J5) tr_item(F.in[17], 512, 16, (bf16*)(ws + WS_WL1), 128, scr, it - J4, F.lane);
        else if (it < J6) tr_item(F.in[15], 512, 16, (bf16*)(ws + WS_WL1) + 512 * 128 + 64, 128, scr, it - J5, F.lane);
        else if (it < J7) tr_item(F.in[15] + 64 * 512, 512, 16, (bf16*)(ws + WS_WL2), 128, scr, it - J6, F.lane);
        else if (it < J8) tr_item(F.in[18], 512, 16, (bf16*)(ws + WS_WGF), 128, scr, it - J7, F.lane);
        else if (it < J9) tr_item(F.in[18] + 128 * 512, 512, 16, (bf16*)(ws + WS_WGB), 128, scr, it - J8, F.lane);
        else if (it < J10) tr_item(F.in[24], 1024, 32, (bf16*)(ws + WS_WO), 1024, scr, it - J9, F.lane);
        else if (it < J11) tr_item(F.in[25], 1024, 32, (bf16*)(ws + WS_WM), 1024, scr, it - J10, F.lane);
        else if (it < J12) tr_item(F.in[27], 2816, 88, (bf16*)(ws + WS_WGU), 1024, scr, it - J11, F.lane, F.in[26]);
        else if (it < J13) tr_item(F.in[28], 2816, 88, (bf16*)(ws + WS_WGU) + (size_t)2816 * 1024, 1024, scr, it - J12, F.lane, F.in[26]);
        else tr_item(F.in[31], 1024, 32, (bf16*)(ws + WS_WD), 2816, scr, it - J13, F.lane);
    }
    zero_fill(F, WIN + (size_t)4032 * 1024, 64, 1024, 1024);
    zero_fill(F, WIN + (size_t)4512 * 1024, 96, 1024, 1024);
    zero_fill(F, (bf16*)(ws + WS_WL1) + 64, 512, 64, 128);
    zero_fill(F, (bf16*)(ws + WS_WL1) + 512 * 128, 512, 64, 128);
    zero_fill(F, (bf16*)(ws + WS_WL2) + 64, 512, 64, 128);
    for (int i = F.bid * 512 + F.tid; i < NTOK; i += F.G * 512) ((float*)(ws + WS_RSQ))[i] = 0.f;
    for (int m = gw; m < NTOK; m += NGW) rms_row(F.in[0] + (size_t)m * DM, F.in[2], (bf16*)(ws + WS_XN) + (size_t)m * DM, F.lane);
}

template <class Fn> struct Epi8 {
    static constexpr bool PERM = true, AFTER_DRAIN = false; Fn f;
    __device__ __forceinline__ void operator()(const pg8::f32x4 (&acc)[2][2][4][2], const pg8::Unit& u, int wr, int wc, int fr, int fq) const {
#pragma unroll
        for (int ai = 0; ai < 2; ++ai)
#pragma unroll
            for (int m = 0; m < 4; ++m)
#pragma unroll
                for (int bj = 0; bj < 2; ++bj) f(u.pm * 256 + ai * 128 + wr * 64 + m * 16 + fr, u.pn * 256 + bj * 128 + wc * 32 + 8 * fq, acc[ai][bj][m][0], acc[ai][bj][m][1]);
    }
};
__device__ __forceinline__ v4u pack8(f32x4 a, f32x4 b) { v4u w; w.x = pk2(a[0], a[1]); w.y = pk2(a[2], a[3]); w.z = pk2(b[0], b[1]); w.w = pk2(b[2], b[3]); return w; }
__device__ __forceinline__ v4u pack8s(f32x4 a, f32x4 b) { v4u w; w.x = pk2s(a[0], a[1]); w.y = pk2s(a[2], a[3]); w.z = pk2s(b[0], b[1]); w.w = pk2s(b[2], b[3]); return w; }
__device__ __forceinline__ void unpack8(v4u w, f32x4& a, f32x4& b) { a = (f32x4){bflo(w.x), bfhi(w.x), bflo(w.y), bfhi(w.y)}; b = (f32x4){bflo(w.z), bfhi(w.z), bflo(w.w), bfhi(w.w)}; }

struct FnIn {
    bf16* PG; bf16* PR; bf16* PM; const float* bg;
    __device__ __forceinline__ void operator()(int row, int col, f32x4 a, f32x4 b) const {
        if (col < 2048) { const f32x4 b0 = *(const f32x4*)(bg + col), b1 = *(const f32x4*)(bg + col + 4);
#pragma unroll
            for (int i = 0; i < 4; ++i) { a[i] = sigm(a[i] + b0[i]); b[i] = sigm(b[i] + b1[i]); }
            *(v4u*)(PG + (size_t)row * 2048 + col) = pack8(a, b); }
        else if (col < 4096) *(v4u*)(PR + (size_t)row * 2048 + (col - 2048)) = pack8(a, b);
        else *(v4u*)(PM + (size_t)row * 512 + (col - 4096)) = pack8(a, b);
    }
};
__device__ __forceinline__ float logdecay(float z) {
    const float x = -z, sp = fmaxf(x, 0.f) + __builtin_amdgcn_logf(1.f + fexp(-fabsf(x))) * 0.6931471805599453f;
    return -fexp(-sp - 0.5f);
}
struct FnLora1 {
    bf16* ASIG; bf16* DEC; const float* a0; const float* w0;
    __device__ __forceinline__ void operator()(int row, int col, f32x4 a, f32x4 b) const {
        if (col < 512) { const f32x4 b0 = *(const f32x4*)(a0 + col), b1 = *(const f32x4*)(a0 + col + 4);
#pragma unroll
            for (int i = 0; i < 4; ++i) { a[i] = sigm(a[i] + b0[i]); b[i] = sigm(b[i] + b1[i]); }
            *(v4u*)(ASIG + (size_t)row * 512 + col) = pack8(a, b); }
        else { const int c = col - 512; const f32x4 b0 = *(const f32x4*)(w0 + c), b1 = *(const f32x4*)(w0 + c + 4);
#pragma unroll
            for (int i = 0; i < 4; ++i) { a[i] = logdecay(a[i] + b0[i]); b[i] = logdecay(b[i] + b1[i]); }
            *(v4u*)(DEC + (size_t)row * 512 + c) = pack8(a, b); }
    }
};
struct FnLora2 {
    bf16* DEC; const float* w0;
    __device__ __forceinline__ void operator()(int row, int col, f32x4 a, f32x4 b) const {
        const f32x4 b0 = *(const f32x4*)(w0 + col), b1 = *(const f32x4*)(w0 + col + 4);
#pragma unroll
        for (int i = 0; i < 4; ++i) { a[i] = logdecay(a[i] + b0[i]); b[i] = logdecay(b[i] + b1[i]); }
        *(v4u*)(DEC + (size_t)row * 512 + col) = pack8(a, b);
    }
};
template <int ACC> struct FnMulAcc {
    bf16* O; int ldo; const bf16* S; int lds_; int soff;
    __device__ __forceinline__ void operator()(int row, int col, f32x4 a, f32x4 b) const {
        f32x4 s0, s1; unpack8(*(const v4u*)(S + (size_t)row * lds_ + soff + col), s0, s1);
        a = a * s0; b = b * s1;
        if (ACC) { f32x4 o0, o1; unpack8(*(const v4u*)(O + (size_t)row * ldo + col), o0, o1); a = a + o0; b = b + o1; }
        *(v4u*)(O + (size_t)row * ldo + col) = pack8(a, b);
    }
};
struct FnResid {
    const float* base; float* out;
    __device__ __forceinline__ void operator()(int row, int col, f32x4 a, f32x4 b) const {
        const size_t o = (size_t)row * 1024 + col; const f32x4 x0 = *(const f32x4*)(base + o), x1 = *(const f32x4*)(base + o + 4);
        *(f32x4*)(out + o) = x0 + a; *(f32x4*)(out + o + 4) = x1 + b;
    }
};
struct FnStore {
    bf16* O; int ldo;
    __device__ __forceinline__ void operator()(int row, int col, f32x4 a, f32x4 b) const { *(v4u*)(O + (size_t)row * ldo + col) = pack8(a, b); }
};
struct FnResidNorm {
    const float* base; float* out; bf16* XB; float* rsq;
    __device__ __forceinline__ void operator()(int row, int col, f32x4 a, f32x4 b) const {
        const size_t o = (size_t)row * 1024 + col; const f32x4 x0 = *(const f32x4*)(base + o) + a, x1 = *(const f32x4*)(base + o + 4) + b;
        *(v4u*)(XB + o) = pack8(x0, x1);
        float ss = (x0[0] * x0[0] + x0[1] * x0[1]) + (x0[2] * x0[2] + x0[3] * x0[3]) + (x1[0] * x1[0] + x1[1] * x1[1]) + (x1[2] * x1[2] + x1[3] * x1[3]);
        ss += __shfl_xor(ss, 16); ss += __shfl_xor(ss, 32);
        if (((col >> 3) & 3) == 0) atomicAdd(rsq + row, ss);
    }
};
struct FnResidBf {
    const bf16* XB; float* out;
    __device__ __forceinline__ void operator()(int row, int col, f32x4 a, f32x4 b) const {
        const size_t o = (size_t)row * 1024 + col; f32x4 x0, x1; unpack8(*(const v4u*)(XB + o), x0, x1);
        *(f32x4*)(out + o) = x0 + a; *(f32x4*)(out + o + 4) = x1 + b;
    }
};
struct FnStoreScaled {
    bf16* O; int ldo; const float* rsq;
    __device__ __forceinline__ void operator()(int row, int col, f32x4 a, f32x4 b) const { const float rs = 1.f / sqrtf(rsq[row] * (1.f / 1024.f) + 1e-6f); *(v4u*)(O + (size_t)row * ldo + col) = pack8(a * rs, b * rs); }
};
struct FnConvAct {
    const bf16* G; bf16* ACT; const float* cw; const float* cb; const float* rsq;
    __device__ __forceinline__ void operator()(int row, int col, f32x4 a, f32x4 b) const {
        { const float rs = 1.f / sqrtf(rsq[row] * (1.f / 1024.f) + 1e-6f); a = a * rs; b = b * rs; }
        const int s = row & (SEQ - 1); const bf16* g = G + (size_t)row * 2816 + col;
        f32x4 c0, c1, p0 = {0.f, 0.f, 0.f, 0.f}, p1 = p0, n0 = p0, n1 = p0;
        unpack8(*(const v4u*)g, c0, c1);
        if (s > 0) unpack8(*(const v4u*)(g - 2816), p0, p1);
        if (s < SEQ - 1) unpack8(*(const v4u*)(g + 2816), n0, n1);
        const f32x4 wa0 = *(const f32x4*)(cw + col), wa1 = *(const f32x4*)(cw + col + 4), wb0 = *(const f32x4*)(cw + 2816 + col), wb1 = *(const f32x4*)(cw + 2816 + col + 4),
                    wc0 = *(const f32x4*)(cw + 5632 + col), wc1 = *(const f32x4*)(cw + 5632 + col + 4), bb0 = *(const f32x4*)(cb + col), bb1 = *(const f32x4*)(cb + col + 4);
        f32x4 g0 = p0 * wa0 + c0 * wb0 + n0 * wc0 + bb0, g1 = p1 * wa1 + c1 * wb1 + n1 * wc1 + bb1;
#pragma unroll
        for (int i = 0; i < 4; ++i) { g0[i] = g0[i] * sigm(g0[i]) * a[i]; g1[i] = g1[i] * sigm(g1[i]) * b[i]; }
        *(v4u*)(ACT + (size_t)row * 2816 + col) = pack8(g0, g1);
    }
};
template <class Fn> __device__ __forceinline__ void run_gemm(Frame& F, const bf16* A, int lda, const bf16* Bt, int ldb, int N, int K, const Fn& fn) {
    asm volatile("" : "+s"(K));
    pg8::Gemm g{A, Bt, NTOK, N, K, lda, ldb}; pg8::StaticOrder S; S.init(NTOK, N, F.G, F.bid);
    Epi8<Fn> E{fn};
    pg8::gemm_phase<Epi8<Fn>, pg8::StaticOrder, true, true>(F.lds, g, S, E);
}

__device__ __forceinline__ void p2_shift(Frame& F) {
    const bf16* PR = (const bf16*)(F.ws + WS_PR); bf16* RKV = (bf16*)(F.ws + WS_RKV); bf16* LI = (bf16*)(F.ws + WS_LI); bf16* SG = (bf16*)(F.ws + WS_SG);
    const float* mu = F.in[13];
    for (int idx = F.bid * 512 + F.tid; idx < NTOK * 256; idx += F.G * 512) {
        const int m = idx >> 8, ch = idx & 255, s = m & (SEQ - 1), c = ch * 8;
        if (ch >= 248) { *(v4u*)(LI + (size_t)m * 256 + 192 + (ch - 248) * 8) = (v4u){0u, 0u, 0u, 0u}; continue; }
        const bf16* p = PR + (size_t)m * 2048 + c;
        f32x4 c0, c1, p0 = {0.f, 0.f, 0.f, 0.f}, p1 = p0, n0 = p0, n1 = p0;
        unpack8(*(const v4u*)p, c0, c1);
        if (s > 0) unpack8(*(const v4u*)(p - 2048), p0, p1);
        if (s < SEQ - 1) unpack8(*(const v4u*)(p + 2048), n0, n1);
        const f32x4 mp0 = *(const f32x4*)(mu + c), mp1 = *(const f32x4*)(mu + c + 4), mn0 = *(const f32x4*)(mu + 1984 + c), mn1 = *(const f32x4*)(mu + 1984 + c + 4);
        f32x4 u0 = c0 + mp0 * (p0 - c0) + mn0 * (n0 - c0), u1 = c1 + mp1 * (p1 - c1) + mn1 * (n1 - c1);
        if (c < 1536) *(v4u*)(RKV + (size_t)m * 1536 + c) = pack8(u0, u1);
        else if (c < 1600) *(v4u*)(LI + (size_t)m * 256 + (c - 1536)) = pack8(u0, u1);
        else if (c < 1728) {
#pragma unroll
            for (int i = 0; i < 4; ++i) { u0[i] = ftanh(u0[i]); u1[i] = ftanh(u1[i]); }
            *(v4u*)(LI + (size_t)m * 256 + 64 + (c - 1600)) = pack8(u0, u1); }
        else {
#pragma unroll
            for (int i = 0; i < 4; ++i) { u0[i] = sigm(u0[i]); u1[i] = sigm(u1[i]); }
            *(v4u*)(SG + (size_t)m * 256 + (c - 1728)) = pack8(u0, u1); }
    }
}

__device__ __forceinline__ void p5_gn(Frame& F) {
    const bf16* RKV = (const bf16*)(F.ws + WS_RKV); const bf16* ASIG = (const bf16*)(F.ws + WS_ASIG); bf16* OF = (bf16*)(F.ws + WS_OF); bf16* OB = (bf16*)(F.ws + WS_OB);
    const float *k_a = F.in[20], *r_k = F.in[21], *lng = F.in[22], *lnb = F.in[23];
    for (int idx = F.bid * 512 + F.tid; idx < NTOK * 64; idx += F.G * 512) {
        const int m = idx >> 6, c = (idx & 63) * 8;
        float r[8], k[8], v[8], a[8], of[8], ob[8];
        { f32x4 x0, x1; unpack8(*(const v4u*)(RKV + (size_t)m * 1536 + c), x0, x1); for (int i = 0; i < 4; ++i) { r[i] = x0[i]; r[4 + i] = x1[i]; }
          unpack8(*(const v4u*)(RKV + (size_t)m * 1536 + 512 + c), x0, x1); for (int i = 0; i < 4; ++i) { k[i] = x0[i]; k[4 + i] = x1[i]; }
          unpack8(*(const v4u*)(RKV + (size_t)m * 1536 + 1024 + c), x0, x1); for (int i = 0; i < 4; ++i) { v[i] = x0[i]; v[4 + i] = x1[i]; }
          unpack8(*(const v4u*)(ASIG + (size_t)m * 512 + c), x0, x1); for (int i = 0; i < 4; ++i) { a[i] = x0[i]; a[4 + i] = x1[i]; }
          unpack8(*(const v4u*)(OF + (size_t)m * 512 + c), x0, x1); for (int i = 0; i < 4; ++i) { of[i] = x0[i]; of[4 + i] = x1[i]; }
          unpack8(*(const v4u*)(OB + (size_t)m * 512 + c), x0, x1); for (int i = 0; i < 4; ++i) { ob[i] = x0[i]; ob[4 + i] = x1[i]; } }
        float bs = 0.f, sf = 0.f, sb = 0.f;
#pragma unroll
        for (int i = 0; i < 8; ++i) { const float kp = k[i] * (1.f + (a[i] - 1.f) * k_a[c + i]); bs += r[i] * kp * r_k[c + i]; sf += of[i]; sb += ob[i]; }
        bs = red8(bs); const float muf = red8(sf) * (1.f / 64.f), mub = red8(sb) * (1.f / 64.f);
        float qf = 0.f, qb = 0.f;
#pragma unroll
        for (int i = 0; i < 8; ++i) { of[i] -= muf; ob[i] -= mub; qf += of[i] * of[i]; qb += ob[i] * ob[i]; }
        const float rf = 1.f / sqrtf(red8(qf) * (1.f / 64.f) + 64e-5f), rb = 1.f / sqrtf(red8(qb) * (1.f / 64.f) + 64e-5f);
        f32x4 o0, o1, o2, o3;
#pragma unroll
        for (int i = 0; i < 4; ++i) {
            o0[i] = of[i] * rf * lng[c + i] + lnb[c + i] + bs * v[i];             o1[i] = of[4 + i] * rf * lng[c + 4 + i] + lnb[c + 4 + i] + bs * v[4 + i];
            o2[i] = ob[i] * rb * lng[c + i] + lnb[c + i] + bs * v[i];             o3[i] = ob[4 + i] * rb * lng[c + 4 + i] + lnb[c + 4 + i] + bs * v[4 + i]; }
        *(v4u*)(OF + (size_t)m * 512 + c) = pack8(o0, o1); *(v4u*)(OB + (size_t)m * 512 + c) = pack8(o2, o3);
    }
}

__device__ __forceinline__ void p11_conv(Frame& F) {
    bf16* GU = (bf16*)(F.ws + WS_GU); const float* cw = F.in[29]; const float* cb = F.in[30];
    for (int idx = F.bid * 512 + F.tid; idx < NTOK * 352; idx += F.G * 512) {
        const int m = idx / 352, c = (idx - m * 352) * 8, s = m & (SEQ - 1);
        bf16* g = GU + (size_t)m * 5632 + c;
        f32x4 c0, c1, p0 = {0.f, 0.f, 0.f, 0.f}, p1 = p0, n0 = p0, n1 = p0, u0, u1;
        unpack8(*(const v4u*)g, c0, c1); unpack8(*(const v4u*)(g + 2816), u0, u1);
        if (s > 0) unpack8(*(const v4u*)(g - 5632), p0, p1);
        if (s < SEQ - 1) unpack8(*(const v4u*)(g + 5632), n0, n1);
        const f32x4 wa0 = *(const f32x4*)(cw + c), wa1 = *(const f32x4*)(cw + c + 4), wb0 = *(const f32x4*)(cw + 2816 + c), wb1 = *(const f32x4*)(cw + 2816 + c + 4),
                    wc0 = *(const f32x4*)(cw + 5632 + c), wc1 = *(const f32x4*)(cw + 5632 + c + 4), bb0 = *(const f32x4*)(cb + c), bb1 = *(const f32x4*)(cb + c + 4);
        f32x4 g0 = p0 * wa0 + c0 * wb0 + n0 * wc0 + bb0, g1 = p1 * wa1 + c1 * wb1 + n1 * wc1 + bb1;
#pragma unroll
        for (int i = 0; i < 4; ++i) { g0[i] = g0[i] * sigm(g0[i]) * u0[i]; g1[i] = g1[i] * sigm(g1[i]) * u1[i]; }
        *(v4u*)(g + 2816) = pack8(g0, g1);
    }
}

#define MFMA32(a, b, c) __builtin_amdgcn_mfma_f32_32x32x16_bf16((a), (b), (c), 0, 0, 0)
__device__ __forceinline__ float ssq8(v4u w) { float a0 = bflo(w.x), a1 = bfhi(w.x), a2 = bflo(w.y), a3 = bfhi(w.y), a4 = bflo(w.z), a5 = bfhi(w.z), a6 = bflo(w.w), a7 = bfhi(w.w);
    return (a0 * a0 + a1 * a1) + (a2 * a2 + a3 * a3) + (a4 * a4 + a5 * a5) + (a6 * a6 + a7 * a7); }
__device__ __forceinline__ v4u scale8(v4u w, float rs, const float* g) { const f32x4 g0 = *(const f32x4*)g, g1 = *(const f32x4*)(g + 4); v4u o;
    o.x = pk2(bflo(w.x) * rs * g0[0], bfhi(w.x) * rs * g0[1]); o.y = pk2(bflo(w.y) * rs * g0[2], bfhi(w.y) * rs * g0[3]);
    o.z = pk2(bflo(w.z) * rs * g1[0], bfhi(w.z) * rs * g1[1]); o.w = pk2(bflo(w.w) * rs * g1[2], bfhi(w.w) * rs * g1[3]); return o; }
__device__ __forceinline__ float rope_inv_freq(int e, int hi) {
    constexpr float T[16] = {1.000000000e+00f, 5.623413324e-01f, 3.162277639e-01f, 1.778279394e-01f, 1.000000015e-01f, 5.623413250e-02f, 3.162277490e-02f, 1.778279431e-02f,
                             9.999999776e-03f, 5.623413250e-03f, 3.162277630e-03f, 1.778279431e-03f, 1.000000047e-03f, 5.623413017e-04f, 3.162277571e-04f, 1.778279402e-04f};
    const int i0 = (e & 3) + 8 * (e >> 2); return hi ? T[i0 + 4] : T[i0]; }
__device__ __forceinline__ void mla_item(Frame& F, int item) {
    const int tile = item >> 1, hg = item & 1, lane = F.lane, r32 = lane & 31, hi = lane >> 5;
    const int m = tile * 256 + F.wave * 32 + r32, b = m >> 12, s = m & (SEQ - 1);
    const bf16* PM = (const bf16*)(F.ws + WS_PM) + (size_t)m * 512;
    bf16* Qo = (bf16*)(F.ws + WS_Q); bf16* Ko = (bf16*)(F.ws + WS_K); bf16* VTo = (bf16*)(F.ws + WS_VT);
    v4u cq[16], ckv[8];
    float sq = 0.f, skv = 0.f;
#pragma unroll
    for (int i = 0; i < 16; ++i) { cq[i] = *(const v4u*)(PM + 16 * i + 8 * hi); sq += ssq8(cq[i]); }
#pragma unroll
    for (int i = 0; i < 8; ++i) { ckv[i] = *(const v4u*)(PM + 256 + 16 * i + 8 * hi); skv += ssq8(ckv[i]); }
    sq += __shfl_xor(sq, 32); skv += __shfl_xor(skv, 32);
    const float rq = 1.f / sqrtf(sq * (1.f / 256.f) + 1e-6f), rkv = 1.f / sqrtf(skv * (1.f / 128.f) + 1e-6f);
#pragma unroll
    for (int i = 0; i < 16; ++i) cq[i] = scale8(cq[i], rq, F.in[5] + 16 * i + 8 * hi);
#pragma unroll
    for (int i = 0; i < 8; ++i) ckv[i] = scale8(ckv[i], rkv, F.in[6] + 16 * i + 8 * hi);
    float cs[8], sn[8];
    { const float pos = (float)((const int*)F.in[1])[m];
#pragma unroll
      for (int e = 0; e < 8; ++e) { const float inv = rope_inv_freq(e, hi); const float ang = pos * inv;
          const float kq = rintf(ang * 0.15915494309189535f); float rr = fmaf(-kq, 6.28125f, ang); rr = fmaf(-kq, 1.9353071795864769e-3f, rr);
          rr *= 0.15915494309189535f; sn[e] = __builtin_amdgcn_sinf(rr); cs[e] = __builtin_amdgcn_cosf(rr); } }
    { float t1[8], t2[8];
      const v2u a0 = *(const v2u*)(PM + 384 + 4 * hi), a1 = *(const v2u*)(PM + 384 + 8 + 4 * hi), b0 = *(const v2u*)(PM + 384 + 16 + 4 * hi), b1 = *(const v2u*)(PM + 384 + 24 + 4 * hi);
      t1[0] = bflo(a0.x); t1[1] = bfhi(a0.x); t1[2] = bflo(a0.y); t1[3] = bfhi(a0.y); t1[4] = bflo(a1.x); t1[5] = bfhi(a1.x); t1[6] = bflo(a1.y); t1[7] = bfhi(a1.y);
      t2[0] = bflo(b0.x); t2[1] = bfhi(b0.x); t2[2] = bflo(b0.y); t2[3] = bfhi(b0.y); t2[4] = bflo(b1.x); t2[5] = bfhi(b1.x); t2[6] = bflo(b1.y); t2[7] = bfhi(b1.y);
      float ss = 0.f;
#pragma unroll
      for (int e = 0; e < 8; ++e) ss += t1[e] * t1[e] + t2[e] * t2[e];
      ss += __shfl_xor(ss, 32);
      const float rs = 1.f / sqrtf(ss * (1.f / 32.f) + 1e-6f);
      float o1[8], o2[8];
#pragma unroll
      for (int e = 0; e < 8; ++e) { const int i = crow(e, hi); const float x1 = t1[e] * rs * F.in[12][i], x2 = t2[e] * rs * F.in[12][i + 16]; o1[e] = x1 * cs[e] - x2 * sn[e]; o2[e] = x2 * cs[e] + x1 * sn[e]; }
#pragma unroll
      for (int hh = 0; hh < 4; ++hh) { bf16* kp = Ko + ((size_t)(b * 8 + hg * 4 + hh) * SEQ + s) * 96 + 64;
          *(v2u*)(kp + 4 * hi) = (v2u){pk2s(o1[0], o1[1]), pk2s(o1[2], o1[3])}; *(v2u*)(kp + 8 + 4 * hi) = (v2u){pk2s(o1[4], o1[5]), pk2s(o1[6], o1[7])};
          *(v2u*)(kp + 16 + 4 * hi) = (v2u){pk2s(o2[0], o2[1]), pk2s(o2[2], o2[3])}; *(v2u*)(kp + 24 + 4 * hi) = (v2u){pk2s(o2[4], o2[5]), pk2s(o2[6], o2[7])}; } }
    const bf16* WUQ = (const bf16*)(F.ws + WS_WUQ); const bf16* WUKV = (const bf16*)(F.ws + WS_WUKV);
    LAS unsigned char* lq = F.lds; LAS unsigned char* lkv = F.lds + 96 * 528;
    for (int hh = 0; hh < 4; ++hh) {
        const int h = hg * 4 + hh;
        __syncthreads();
        { const v4u* src = (const v4u*)(WUQ + (size_t)h * 96 * 256);
#pragma unroll
          for (int j = 0; j < 6; ++j) { const int i = j * 512 + F.tid; *(LAS v4u*)(lq + (i >> 5) * 528 + (i & 31) * 16) = src[i]; }
          const v4u* src2 = (const v4u*)(WUKV + (size_t)h * 128 * 128);
#pragma unroll
          for (int j = 0; j < 4; ++j) { const int i = j * 512 + F.tid; *(LAS v4u*)(lkv + (i >> 4) * 272 + (i & 15) * 16) = src2[i]; } }
        __syncthreads();
        const size_t rowq = ((size_t)(b * 8 + h) * SEQ + s) * 96;
        f32x16 qa[3];
#pragma unroll
        for (int j = 0; j < 3; ++j) { qa[j] = (f32x16){};
#pragma unroll
            for (int i = 0; i < 16; ++i) { const bf16x8 a = *(const LAS bf16x8*)(lq + (32 * j + r32) * 528 + 32 * i + 16 * hi); qa[j] = MFMA32(a, __builtin_bit_cast(bf16x8, cq[i]), qa[j]); } }
        { float ss = 0.f;
#pragma unroll
          for (int r = 0; r < 16; ++r) ss += qa[0][r] * qa[0][r] + qa[1][r] * qa[1][r];
          ss += __shfl_xor(ss, 32);
          const float rs = QSCALE / sqrtf(ss * (1.f / 64.f) + 1e-6f);
#pragma unroll
          for (int j = 0; j < 2; ++j)
#pragma unroll
              for (int g4 = 0; g4 < 4; ++g4) { const int col = 32 * j + 8 * g4 + 4 * hi; const f32x4 gg = *(const f32x4*)(F.in[9] + col);
                  *(v2u*)(Qo + rowq + col) = (v2u){pk2s(qa[j][4 * g4] * rs * gg[0], qa[j][4 * g4 + 1] * rs * gg[1]), pk2s(qa[j][4 * g4 + 2] * rs * gg[2], qa[j][4 * g4 + 3] * rs * gg[3])}; }
          float s2 = 0.f;
#pragma unroll
          for (int r = 0; r < 16; ++r) s2 += qa[2][r] * qa[2][r];
          s2 += __shfl_xor(s2, 32);
          const float r2 = 1.f / sqrtf(s2 * (1.f / 32.f) + 1e-6f);
          float o1[8], o2[8];
#pragma unroll
          for (int e = 0; e < 8; ++e) { const int i = crow(e, hi); const float x1 = qa[2][e] * r2 * F.in[10][i], x2 = qa[2][e + 8] * r2 * F.in[10][i + 16];
              o1[e] = (x1 * cs[e] - x2 * sn[e]) * QSCALE; o2[e] = (x2 * cs[e] + x1 * sn[e]) * QSCALE; }
          bf16* qp = Qo + rowq + 64;
          *(v2u*)(qp + 4 * hi) = (v2u){pk2s(o1[0], o1[1]), pk2s(o1[2], o1[3])}; *(v2u*)(qp + 8 + 4 * hi) = (v2u){pk2s(o1[4], o1[5]), pk2s(o1[6], o1[7])};
          *(v2u*)(qp + 16 + 4 * hi) = (v2u){pk2s(o2[0], o2[1]), pk2s(o2[2], o2[3])}; *(v2u*)(qp + 24 + 4 * hi) = (v2u){pk2s(o2[4], o2[5]), pk2s(o2[6], o2[7])}; }
        f32x16 ka[2];
#pragma unroll
        for (int j = 0; j < 2; ++j) { ka[j] = (f32x16){};
#pragma unroll
            for (int i = 0; i < 8; ++i) { const bf16x8 a = *(const LAS bf16x8*)(lkv + (32 * j + r32) * 272 + 32 * i + 16 * hi); ka[j] = MFMA32(a, __builtin_bit_cast(bf16x8, ckv[i]), ka[j]); } }
        { float ss = 0.f;
#pragma unroll
          for (int r = 0; r < 16; ++r) ss += ka[0][r] * ka[0][r] + ka[1][r] * ka[1][r];
          ss += __shfl_xor(ss, 32);
          const float rs = 1.f / sqrtf(ss * (1.f / 64.f) + 1e-6f);
#pragma unroll
          for (int j = 0; j < 2; ++j)
#pragma unroll
              for (int g4 = 0; g4 < 4; ++g4) { const int col = 32 * j + 8 * g4 + 4 * hi; const f32x4 gg = *(const f32x4*)(F.in[11] + col);
                  *(v2u*)(Ko + rowq + col) = (v2u){pk2s(ka[j][4 * g4] * rs * gg[0], ka[j][4 * g4 + 1] * rs * gg[1]), pk2s(ka[j][4 * g4 + 2] * rs * gg[2], ka[j][4 * g4 + 3] * rs * gg[3])}; } }
#pragma unroll
        for (int j = 0; j < 2; ++j) { f32x16 va = (f32x16){};
#pragma unroll
            for (int i = 0; i < 8; ++i) { const bf16x8 a = *(const LAS bf16x8*)(lkv + (64 + 32 * j + r32) * 272 + 32 * i + 16 * hi); va = MFMA32(a, __builtin_bit_cast(bf16x8, ckv[i]), va); }
#pragma unroll
            for (int r = 0; r < 16; r += 2) { const unsigned w = pk2s(va[r], va[r + 1]); const int d = 32 * j + crow(r, hi);
                VTo[((size_t)(b * 8 + h) * 64 + d) * SEQ + s] = (bf16)(w & 0xffffu); VTo[((size_t)(b * 8 + h) * 64 + d + 1) * SEQ + s] = (bf16)(w >> 16); } }
    }
    __syncthreads();
}

constexpr int AK_STRIDE = 208, AV_STRIDE = 136, AK_BYTES = 64 * AK_STRIDE, AV_BYTES = 64 * AV_STRIDE, AV_OFF = 2 * AK_BYTES;
__device__ __forceinline__ void attn_unit(Frame& F, int bh, int qb) {
    const int tid = F.tid, lane = F.lane, wid = F.wave, r32 = lane & 31, hi = lane >> 5;
    const bf16* Qp = (const bf16*)(F.ws + WS_Q) + ((size_t)bh * SEQ + qb * 256 + wid * 32 + r32) * 96;
    const bf16* Kb = (const bf16*)(F.ws + WS_K) + (size_t)bh * SEQ * 96; const bf16* Vb = (const bf16*)(F.ws + WS_VT) + (size_t)bh * 64 * SEQ;
    LAS unsigned char* lds = F.lds;
    bf16x8 qf[6];
#pragma unroll
    for (int d0 = 0; d0 < 6; ++d0) qf[d0] = *(const bf16x8*)(Qp + 16 * d0 + 8 * hi);
    const int kl0 = (tid / 12) * AK_STRIDE + (tid % 12) * 16, i1 = 512 + tid, kl1 = (i1 / 12) * AK_STRIDE + (i1 % 12) * 16;
    const int vd = tid >> 3, vc = tid & 7, vl = AV_OFF + vd * AV_STRIDE + vc * 16;
    const v4u* kg = (const v4u*)Kb; const bf16* vg = Vb + (size_t)vd * SEQ + vc * 8;
    v4u sk0, sk1 = {0u, 0u, 0u, 0u}, sv;
    sk0 = kg[tid]; if (tid < 256) sk1 = kg[512 + tid]; sv = *(const v4u*)vg;
    __syncthreads();
    *(LAS v4u*)(lds + kl0) = sk0; if (tid < 256) *(LAS v4u*)(lds + kl1) = sk1;
    *(LAS v2u*)(lds + vl) = (v2u){sv.x, sv.y}; *(LAS v2u*)(lds + vl + 8) = (v2u){sv.z, sv.w};
    __syncthreads();
    float mrun = -1e30f, lrun = 0.f;
    f32x16 o0 = (f32x16){}, o1 = (f32x16){};
    for (int t = 0; t < 64; ++t) {
        const int cur = t & 1, nxt = cur ^ 1;
        if (t + 1 < 64) { const v4u* kgn = kg + (size_t)(t + 1) * 768; sk0 = kgn[tid]; if (tid < 256) sk1 = kgn[512 + tid]; sv = *(const v4u*)(vg + (t + 1) * 64); }
        const LAS unsigned char* kb_ = lds + cur * AK_BYTES; const LAS unsigned char* vb_ = lds + AV_OFF + cur * AV_BYTES;
        f32x16 p0 = (f32x16){}, p1 = (f32x16){};
#pragma unroll
        for (int d0 = 0; d0 < 6; ++d0) {
            const bf16x8 a0 = *(const LAS bf16x8*)(kb_ + r32 * AK_STRIDE + 32 * d0 + 16 * hi), a1 = *(const LAS bf16x8*)(kb_ + (32 + r32) * AK_STRIDE + 32 * d0 + 16 * hi);
            p0 = MFMA32(a0, qf[d0], p0); p1 = MFMA32(a1, qf[d0], p1); }
        float mx = fmaxf(p0[0], p1[0]);
#pragma unroll
        for (int r = 1; r < 16; ++r) mx = fmaxf(mx, fmaxf(p0[r], p1[r]));
        mx = fmaxf(mx, __shfl_xor(mx, 32));
        const float mnew = fmaxf(mrun, mx), alpha = __builtin_amdgcn_exp2f(mrun - mnew);
        mrun = mnew;
        float ls = 0.f;
#pragma unroll
        for (int r = 0; r < 16; ++r) { p0[r] = __builtin_amdgcn_exp2f(p0[r] - mnew); p1[r] = __builtin_amdgcn_exp2f(p1[r] - mnew); ls += p0[r] + p1[r]; }
        lrun = lrun * alpha + ls;
#pragma unroll
        for (int r = 0; r < 16; ++r) { o0[r] *= alpha; o1[r] *= alpha; }
        v4u pb[4];
        pb[0] = (v4u){pk2(p0[0], p0[1]), pk2(p0[2], p0[3]), pk2(p0[4], p0[5]), pk2(p0[6], p0[7])};
        pb[1] = (v4u){pk2(p0[8], p0[9]), pk2(p0[10], p0[11]), pk2(p0[12], p0[13]), pk2(p0[14], p0[15])};
        pb[2] = (v4u){pk2(p1[0], p1[1]), pk2(p1[2], p1[3]), pk2(p1[4], p1[5]), pk2(p1[6], p1[7])};
        pb[3] = (v4u){pk2(p1[8], p1[9]), pk2(p1[10], p1[11]), pk2(p1[12], p1[13]), pk2(p1[14], p1[15])};
#pragma unroll
        for (int sl = 0; sl < 4; ++sl) {
            const LAS unsigned char* va = vb_ + r32 * AV_STRIDE + 2 * (16 * sl + 4 * hi);
            const v2u x0 = *(const LAS v2u*)va, x1 = *(const LAS v2u*)(va + 16), y0 = *(const LAS v2u*)(va + 32 * AV_STRIDE), y1 = *(const LAS v2u*)(va + 32 * AV_STRIDE + 16);
            const bf16x8 pbf = __builtin_bit_cast(bf16x8, pb[sl]);
            o0 = MFMA32(__builtin_bit_cast(bf16x8, ((v4u){x0.x, x0.y, x1.x, x1.y})), pbf, o0);
            o1 = MFMA32(__builtin_bit_cast(bf16x8, ((v4u){y0.x, y0.y, y1.x, y1.y})), pbf, o1); }
        if (t + 1 < 64) { LAS unsigned char* kn = lds + nxt * AK_BYTES; LAS unsigned char* vn = lds + nxt * AV_BYTES;
            *(LAS v4u*)(kn + kl0) = sk0; if (tid < 256) *(LAS v4u*)(kn + kl1) = sk1;
            *(LAS v2u*)(vn + vl) = (v2u){sv.x, sv.y}; *(LAS v2u*)(vn + vl + 8) = (v2u){sv.z, sv.w}; }
        __syncthreads();
    }
    lrun += __shfl_xor(lrun, 32);
    const float inv = 1.f / lrun;
    const int b = bh >> 3, h = bh & 7;
    bf16* op = (bf16*)(F.ws + WS_OA) + ((size_t)b * SEQ + qb * 256 + wid * 32 + r32) * 512 + h * 64;
#pragma unroll
    for (int g4 = 0; g4 < 4; ++g4) {
        *(v2u*)(op + 8 * g4 + 4 * hi) = (v2u){pk2(o0[4 * g4] * inv, o0[4 * g4 + 1] * inv), pk2(o0[4 * g4 + 2] * inv, o0[4 * g4 + 3] * inv)};
        *(v2u*)(op + 32 + 8 * g4 + 4 * hi) = (v2u){pk2(o1[4 * g4] * inv, o1[4 * g4 + 1] * inv), pk2(o1[4 * g4 + 2] * inv, o1[4 * g4 + 3] * inv)}; }
}

constexpr int SC_STEP = 1408, SC_BUF = 32 * SC_STEP, SC_OB = 2 * SC_BUF;
__device__ __forceinline__ float ffma_s(float a, float b, float c) { float d; asm("v_fma_f32 %0, %1, %2, %3" : "=v"(d) : "v"(a), "v"(b), "v"(c)); return d; }
__device__ __forceinline__ float fmul_s(float a, float b) { float d; asm("v_mul_f32_e32 %0, %1, %2" : "=v"(d) : "v"(a), "v"(b)); return d; }
__device__ __forceinline__ void scan_item(Frame& F, int item) {
    const int b = item >> 5, h = (item >> 2) & 7, dir = (item >> 1) & 1, half = item & 1;
    const int tid = F.tid, lane = F.lane, wid = F.wave;
    LAS unsigned char* lds = F.lds;
    const bf16* RKV = (const bf16*)(F.ws + WS_RKV); const bf16* ASIG = (const bf16*)(F.ws + WS_ASIG);
    const bf16* DEC = (const bf16*)(F.ws + (dir ? WS_DECB : WS_DECF)); bf16* OUT = (bf16*)(F.ws + (dir ? WS_OB : WS_OF));
    const bool loader = wid >= 4;
    const int lt = tid - 256, lj = lt >> 3, lg = lt & 7;
    float kk8[8], ka8[8];
    if (loader) {
#pragma unroll
        for (int i = 0; i < 8; ++i) { kk8[i] = F.in[19][h * 64 + 8 * lg + i]; ka8[i] = F.in[20][h * 64 + 8 * lg + i]; } }
    auto tok = [&](int c, int j) { const int s = dir ? (SEQ - 1 - (32 * c + j)) : (32 * c + j); return b * SEQ + s; };
    v4u g_r8, g_k8, g_a8, g_w8, g_v8 = {0u, 0u, 0u, 0u};
    auto issue_chunk = [&](int c) {
        const size_t m = (size_t)tok(c, lj); const int col = h * 64 + 8 * lg;
        g_r8 = *(const v4u*)(RKV + m * 1536 + col); g_k8 = *(const v4u*)(RKV + m * 1536 + 512 + col); g_a8 = *(const v4u*)(ASIG + m * 512 + col); g_w8 = *(const v4u*)(DEC + m * 512 + col);
        if (lg < 4) g_v8 = *(const v4u*)(RKV + m * 1536 + 1024 + h * 64 + half * 32 + 8 * lg);
    };
    auto commit_chunk = [&](int bufi) {
        f32x4 r0, r1, k0, k1, a0, a1, w0, w1; unpack8(g_r8, r0, r1); unpack8(g_k8, k0, k1); unpack8(g_a8, a0, a1); unpack8(g_w8, w0, w1);
        float kf[8], ss = 0.f;
#pragma unroll
        for (int i = 0; i < 4; ++i) { kf[i] = k0[i] * kk8[i]; kf[4 + i] = k1[i] * kk8[4 + i]; }
#pragma unroll
        for (int i = 0; i < 8; ++i) ss += kf[i] * kf[i];
        ss = red8(ss);
        const float inv = 1.f / fmaxf(sqrtf(ss), 1e-12f);
        f32x4 na0, na1, bb0, bb1, kp0, kp1, d0, d1;
#pragma unroll
        for (int i = 0; i < 4; ++i) { const float q0 = kf[i] * inv, q1 = kf[4 + i] * inv; na0[i] = -q0; na1[i] = -q1; bb0[i] = q0 * a0[i]; bb1[i] = q1 * a1[i];
            kp0[i] = k0[i] * (1.f + (a0[i] - 1.f) * ka8[i]); kp1[i] = k1[i] * (1.f + (a1[i] - 1.f) * ka8[4 + i]); d0[i] = fexp(w0[i]); d1[i] = fexp(w1[i]); }
        LAS float* sp = (LAS float*)(lds + bufi * SC_BUF + lj * SC_STEP) + 8 * lg;
        *(LAS f32x4*)(sp) = r0; *(LAS f32x4*)(sp + 4) = r1; *(LAS f32x4*)(sp + 64) = d0; *(LAS f32x4*)(sp + 68) = d1; *(LAS f32x4*)(sp + 128) = kp0; *(LAS f32x4*)(sp + 132) = kp1;
        *(LAS f32x4*)(sp + 192) = na0; *(LAS f32x4*)(sp + 196) = na1; *(LAS f32x4*)(sp + 256) = bb0; *(LAS f32x4*)(sp + 260) = bb1;
        if (lg < 4) { f32x4 v0, v1; unpack8(g_v8, v0, v1); *(LAS f32x4*)(sp + 320) = v0; *(LAS f32x4*)(sp + 324) = v1; }
    };
    auto flush_chunk = [&](int c, int bufi) {
        if (lg < 4) { const LAS float* ob = (const LAS float*)(lds + SC_OB + bufi * 4096) + lj * 32 + 8 * lg; const f32x4 x0 = *(const LAS f32x4*)ob, x1 = *(const LAS f32x4*)(ob + 4);
            *(v4u*)(OUT + (size_t)tok(c, lj) * 512 + h * 64 + half * 32 + 8 * lg) = pack8(x0, x1); }
    };
    f32x2 S[4]; S[0] = S[1] = S[2] = S[3] = (f32x2){0.f, 0.f};
    const int rowl = wid * 8 + (lane >> 3), jj = lane & 7;
#define SC_BAR() do { asm volatile("s_waitcnt lgkmcnt(0)" ::: "memory"); __builtin_amdgcn_s_barrier(); asm volatile("" ::: "memory"); } while (0)
    __syncthreads();
    if (loader) { issue_chunk(0); commit_chunk(0); issue_chunk(1); }
    SC_BAR();
    for (int c = 0; c < 128; ++c) {
        if (loader) { if (c + 1 < 128) commit_chunk((c + 1) & 1); if (c + 2 < 128) issue_chunk(c + 2); if (c > 0) flush_chunk(c - 1, (c - 1) & 1); }
        else {
            const LAS float* base = (const LAS float*)(lds + (c & 1) * SC_BUF) + 8 * jj; LAS float* ob = (LAS float*)(lds + SC_OB + (c & 1) * 4096) + rowl;
#define SC_LOAD(X, j) do { const LAS float* p_ = base + (j) * (SC_STEP / 4); \
                X##r0 = *(const LAS f32x4*)p_; X##r1 = *(const LAS f32x4*)(p_ + 4); X##w0 = *(const LAS f32x4*)(p_ + 64); X##w1 = *(const LAS f32x4*)(p_ + 68); X##k0 = *(const LAS f32x4*)(p_ + 128); X##k1 = *(const LAS f32x4*)(p_ + 132); \
                X##a0 = *(const LAS f32x4*)(p_ + 192); X##a1 = *(const LAS f32x4*)(p_ + 196); X##b0 = *(const LAS f32x4*)(p_ + 256); X##b1 = *(const LAS f32x4*)(p_ + 260); X##v = p_[320 - 8 * jj + rowl]; } while (0)
#define SC_COMP(X, j) do { \
                f32x2 t_ = S[0] * (f32x2){X##a0[0], X##a0[1]} + S[1] * (f32x2){X##a0[2], X##a0[3]}; f32x2 t2_ = S[2] * (f32x2){X##a1[0], X##a1[1]} + S[3] * (f32x2){X##a1[2], X##a1[3]}; t_ = t_ + t2_; \
                const float sa_ = red8(t_.x + t_.y); const f32x2 sa2_ = {sa_, sa_}, v2_ = {X##v, X##v}; \
                S[0] = S[0] * (f32x2){X##w0[0], X##w0[1]} + (sa2_ * (f32x2){X##b0[0], X##b0[1]} + v2_ * (f32x2){X##k0[0], X##k0[1]}); \
                S[1] = S[1] * (f32x2){X##w0[2], X##w0[3]} + (sa2_ * (f32x2){X##b0[2], X##b0[3]} + v2_ * (f32x2){X##k0[2], X##k0[3]}); \
                S[2] = S[2] * (f32x2){X##w1[0], X##w1[1]} + (sa2_ * (f32x2){X##b1[0], X##b1[1]} + v2_ * (f32x2){X##k1[0], X##k1[1]}); \
                S[3] = S[3] * (f32x2){X##w1[2], X##w1[3]} + (sa2_ * (f32x2){X##b1[2], X##b1[3]} + v2_ * (f32x2){X##k1[2], X##k1[3]}); \
                f32x2 q_ = S[0] * (f32x2){X##r0[0], X##r0[1]} + S[1] * (f32x2){X##r0[2], X##r0[3]}; f32x2 q2_ = S[2] * (f32x2){X##r1[0], X##r1[1]} + S[3] * (f32x2){X##r1[2], X##r1[3]}; q_ = q_ + q2_; \
                const float o_ = red8(q_.x + q_.y); if (jj == 0) ob[(j) * 32] = o_; } while (0)
            f32x4 Ar0, Ar1, Aw0, Aw1, Ak0, Ak1, Aa0, Aa1, Ab0, Ab1, Br0, Br1, Bw0, Bw1, Bk0, Bk1, Ba0, Ba1, Bb0, Bb1; float Av, Bv;
            SC_LOAD(A, 0);
#pragma unroll 2
            for (int j = 0; j < 32; j += 2) {
                SC_LOAD(B, j + 1);
                __builtin_amdgcn_sched_barrier(0);
                SC_COMP(A, j);
                if (j + 2 < 32) SC_LOAD(A, j + 2);
                __builtin_amdgcn_sched_barrier(0);
                SC_COMP(B, j + 1);
            }
#undef SC_LOAD
#undef SC_COMP
        }
        SC_BAR();
    }
    if (loader) flush_chunk(127, 1);
    __syncthreads();
}

constexpr int FV_STRIDE = 144, FV_BYTES = 64 * FV_STRIDE;
constexpr int FS_STEP = 896;
constexpr int FS_ABUF = 0, FS_SBUF = 45056, FS_SBYTES = 16 * FS_STEP, FS_OBUF = FS_SBUF + 2 * FS_SBYTES, FS_OBYTES = 16 * 256 * 4;
typedef _Float16 h4 __attribute__((ext_vector_type(4)));
template <int HL> __device__ __forceinline__ float mixfma(unsigned h, float s, float c) { float d;
    if (HL) asm("v_fma_mix_f32 %0, %1, %2, %3 op_sel:[1,0,0] op_sel_hi:[1,0,0]" : "=v"(d) : "v"(h), "v"(s), "v"(c));
    else    asm("v_fma_mix_f32 %0, %1, %2, %3 op_sel:[0,0,0] op_sel_hi:[1,0,0]" : "=v"(d) : "v"(h), "v"(s), "v"(c));
    return d; }
template <int HL> __device__ __forceinline__ float mixmul(unsigned h, float s) { float d;
    if (HL) asm("v_fma_mix_f32 %0, %1, %2, 0 op_sel:[1,0,0] op_sel_hi:[1,0,0]" : "=v"(d) : "v"(h), "v"(s));
    else    asm("v_fma_mix_f32 %0, %1, %2, 0 op_sel:[0,0,0] op_sel_hi:[1,0,0]" : "=v"(d) : "v"(h), "v"(s));
    return d; }
__device__ __forceinline__ float red16(float x) { x += dppf<0xB1>(x); x += dppf<0x4E>(x); x += dppf<0x141>(x); x += dppf<0x140>(x); return x; }
template <int MODE  > __device__ __forceinline__ void p4_fused(Frame& F) {
    const int tid = F.tid, lane = F.lane, wid = F.wave, r32 = lane & 31, hi = lane >> 5;
    LAS unsigned char* lds = F.lds;
    const int vb = ((F.bid & 7) << 5) | (F.bid >> 3);
    const int item = vb, sb = item >> 5, sh = (item >> 2) & 7, dir = (item >> 1) & 1, half = item & 1;
    const bf16* RKV = (const bf16*)(F.ws + WS_RKV); const bf16* ASIG = (const bf16*)(F.ws + WS_ASIG);
    const bf16* DEC = (const bf16*)(F.ws + (dir ? WS_DECB : WS_DECF)); bf16* OUT = (bf16*)(F.ws + (dir ? WS_OB : WS_OF));
    const bool loader = wid < 4;
    const int lt = tid & 255, lj = lt >> 4, lg = lt & 15;
    const bool stager = !loader;
    float kk4[4], ka4[4];
    if (stager) {
#pragma unroll
        for (int i = 0; i < 4; ++i) { kk4[i] = F.in[19][sh * 64 + 4 * lg + i]; ka4[i] = F.in[20][sh * 64 + 4 * lg + i]; } }
    auto tok = [&](int c, int j) { const int s = dir ? (SEQ - 1 - (16 * c + j)) : (16 * c + j); return sb * SEQ + s; };
    v2u g_r, g_k, g_a, g_w, g_v = {0u, 0u};
    auto issue_chunk = [&](int c) {
        const size_t m = (size_t)tok(c, lj); const int col = sh * 64 + 4 * lg;
        g_r = *(const v2u*)(RKV + m * 1536 + col); g_k = *(const v2u*)(RKV + m * 1536 + 512 + col); g_a = *(const v2u*)(ASIG + m * 512 + col); g_w = *(const v2u*)(DEC + m * 512 + col);
        if (lg < 8) g_v = *(const v2u*)(RKV + m * 1536 + 1024 + sh * 64 + half * 32 + 4 * lg);
    };
    auto commit_chunk = [&](int bufi) {
        const f32x4 r = {bflo(g_r.x), bfhi(g_r.x), bflo(g_r.y), bfhi(g_r.y)}, k = {bflo(g_k.x), bfhi(g_k.x), bflo(g_k.y), bfhi(g_k.y)},
                    a = {bflo(g_a.x), bfhi(g_a.x), bflo(g_a.y), bfhi(g_a.y)}, w = {bflo(g_w.x), bfhi(g_w.x), bflo(g_w.y), bfhi(g_w.y)};
        float kf[4], ss = 0.f;
#pragma unroll
        for (int i = 0; i < 4; ++i) { kf[i] = k[i] * kk4[i]; ss += kf[i] * kf[i]; }
        ss = red16(ss);
        const float inv = 1.f / fmaxf(sqrtf(ss), 1e-12f);
        f32x4 na, bb, kp, d;
#pragma unroll
        for (int i = 0; i < 4; ++i) { const float q = kf[i] * inv; na[i] = -q; bb[i] = q * a[i]; kp[i] = k[i] * (1.f + (a[i] - 1.f) * ka4[i]); d[i] = fexp(w[i]); }
        LAS unsigned char* sp = lds + FS_SBUF + bufi * FS_SBYTES + lj * FS_STEP;
        *(LAS h4*)(sp + 8 * lg) = (h4){(_Float16)r[0], (_Float16)r[1], (_Float16)r[2], (_Float16)r[3]};
        *(LAS h4*)(sp + 128 + 8 * lg) = (h4){(_Float16)kp[0], (_Float16)kp[1], (_Float16)kp[2], (_Float16)kp[3]};
        *(LAS h4*)(sp + 256 + 8 * lg) = (h4){(_Float16)na[0], (_Float16)na[1], (_Float16)na[2], (_Float16)na[3]};
        *(LAS h4*)(sp + 384 + 8 * lg) = (h4){(_Float16)bb[0], (_Float16)bb[1], (_Float16)bb[2], (_Float16)bb[3]};
        *(LAS f32x4*)(sp + 512 + 16 * lg) = d;
        if (lg < 8) *(LAS f32x4*)(sp + 768 + 16 * lg) = (f32x4){bflo(g_v.x), bfhi(g_v.x), bflo(g_v.y), bfhi(g_v.y)};
    };
    auto flush_chunk = [&](int c, int bufi) {
        const LAS float* ob = (const LAS float*)(lds + FS_OBUF + bufi * FS_OBYTES) + lj * 256 + 16 * lg;
        const f32x4 x0 = *(const LAS f32x4*)ob, x1 = *(const LAS f32x4*)(ob + 4), x2 = *(const LAS f32x4*)(ob + 8), x3 = *(const LAS f32x4*)(ob + 12);
        const float ra = ((x0[0] + x0[1]) + (x0[2] + x0[3])) + ((x1[0] + x1[1]) + (x1[2] + x1[3])), rb = ((x2[0] + x2[1]) + (x2[2] + x2[3])) + ((x3[0] + x3[1]) + (x3[2] + x3[3]));
        *(unsigned*)(OUT + (size_t)tok(c, lj) * 512 + sh * 64 + half * 32 + 2 * lg) = pk2(ra, rb);
    };
    float Sx[8];
#pragma unroll
    for (int i = 0; i < 8; ++i) Sx[i] = 0.f;
    const int rowl = (wid & 3) * 8 + (lane >> 3), jj = lane & 7;
    const int at = tid & 255;
    const int qb = vb & 15, bh0 = vb >> 4;
    auto kptr = [&](int ss_) { const int bh = bh0 + 16 * (ss_ >> 6); return (const v4u*)((const bf16*)(F.ws + WS_K) + (size_t)bh * SEQ * 96) + (size_t)(ss_ & 63) * 768; };
    auto vptr = [&](int ss_, int c) { const int bh = bh0 + 16 * (ss_ >> 6); return (const v4u*)((const bf16*)(F.ws + WS_VT) + (size_t)bh * 64 * SEQ + (size_t)(c >> 3) * SEQ + (c & 7) * 8 + (ss_ & 63) * 64); };
    auto klds = [&](int c) { return (c / 12) * AK_STRIDE + (c % 12) * 16; };
    auto vlds = [&](int c) { return AV_OFF + (c >> 3) * FV_STRIDE + ((c & 7) >> 1) * 32 + (c & 1) * 8; };
    v4u sk0, sk1, sk2, sv0, sv1;
    __syncthreads();
    if (loader) {
        if (MODE & 2) {
        const v4u* kg = kptr(0); sk0 = kg[at]; sk1 = kg[at + 256]; sk2 = kg[at + 512]; sv0 = *vptr(0, at); sv1 = *vptr(0, at + 256);
        *(LAS v4u*)(lds + klds(at)) = sk0; *(LAS v4u*)(lds + klds(at + 256)) = sk1; *(LAS v4u*)(lds + klds(at + 512)) = sk2;
        *(LAS v2u*)(lds + vlds(at)) = (v2u){sv0.x, sv0.y}; *(LAS v2u*)(lds + vlds(at) + 16) = (v2u){sv0.z, sv0.w};
        *(LAS v2u*)(lds + vlds(at + 256)) = (v2u){sv1.x, sv1.y}; *(LAS v2u*)(lds + vlds(at + 256) + 16) = (v2u){sv1.z, sv1.w}; }
    }
    if (stager && (MODE & 1)) { issue_chunk(0); commit_chunk(0); issue_chunk(1); }
    SC_BAR();
    if (loader) {
        __builtin_amdgcn_s_setprio(3);
        for (int ss = 0; ss < 256; ++ss) {
            const int cur = ss & 1, nxt = cur ^ 1;
            if ((MODE & 2) && ss + 1 < 256) { const v4u* kgn = kptr(ss + 1); sk0 = kgn[at]; sk1 = kgn[at + 256]; sk2 = kgn[at + 512]; sv0 = *vptr(ss + 1, at); sv1 = *vptr(ss + 1, at + 256); }
            const LAS unsigned char* base = lds + FS_SBUF + cur * FS_SBYTES + 16 * jj; LAS float* ob = (LAS float*)(lds + FS_OBUF + cur * FS_OBYTES) + (tid & 255);
#define SC_LOAD(X, j) do { const LAS unsigned char* p_ = base + (j) * FS_STEP; \
                X##r = *(const LAS v4u*)p_; X##k = *(const LAS v4u*)(p_ + 128); X##a = *(const LAS v4u*)(p_ + 256); X##b = *(const LAS v4u*)(p_ + 384); \
                X##w0 = *(const LAS f32x4*)(p_ + 512 + 16 * jj); X##w1 = *(const LAS f32x4*)(p_ + 528 + 16 * jj); X##v = *(const LAS float*)(p_ + 768 - 16 * jj + 4 * rowl); } while (0)
#define SC_EL(X, i, d, hl, wv) do { float u_ = mixmul<hl>(X##k[d], X##v); u_ = mixfma<hl>(X##b[d], sa_, u_); Sx[i] = fmaf(Sx[i], wv, u_); } while (0)
#define SC_COMP(X, j) do { \
                float t0_ = mixmul<0>(X##a[0], Sx[0]), t1_ = mixmul<1>(X##a[0], Sx[1]); t0_ = mixfma<0>(X##a[1], Sx[2], t0_); t1_ = mixfma<1>(X##a[1], Sx[3], t1_); \
                t0_ = mixfma<0>(X##a[2], Sx[4], t0_); t1_ = mixfma<1>(X##a[2], Sx[5], t1_); t0_ = mixfma<0>(X##a[3], Sx[6], t0_); t1_ = mixfma<1>(X##a[3], Sx[7], t1_); \
                const float sa_ = red8(t0_ + t1_); \
                SC_EL(X, 0, 0, 0, X##w0[0]); SC_EL(X, 1, 0, 1, X##w0[1]); SC_EL(X, 2, 1, 0, X##w0[2]); SC_EL(X, 3, 1, 1, X##w0[3]); \
                SC_EL(X, 4, 2, 0, X##w1[0]); SC_EL(X, 5, 2, 1, X##w1[1]); SC_EL(X, 6, 3, 0, X##w1[2]); SC_EL(X, 7, 3, 1, X##w1[3]); \
                float q0_ = mixmul<0>(X##r[0], Sx[0]), q1_ = mixmul<1>(X##r[0], Sx[1]); q0_ = mixfma<0>(X##r[1], Sx[2], q0_); q1_ = mixfma<1>(X##r[1], Sx[3], q1_); \
                q0_ = mixfma<0>(X##r[2], Sx[4], q0_); q1_ = mixfma<1>(X##r[2], Sx[5], q1_); q0_ = mixfma<0>(X##r[3], Sx[6], q0_); q1_ = mixfma<1>(X##r[3], Sx[7], q1_); \
                ob[(j) * 256] = q0_ + q1_; } while (0)
            v4u Ar, Ak, Aa, Ab, Br, Bk, Ba, Bb; f32x4 Aw0, Aw1, Bw0, Bw1; float Av, Bv;
            if (MODE & 1) {
            SC_LOAD(A, 0);
#pragma unroll
            for (int j = 0; j < 16; j += 2) {
                SC_LOAD(B, j + 1);
                __builtin_amdgcn_sched_barrier(0);
                SC_COMP(A, j);
                if (j + 2 < 16) SC_LOAD(A, j + 2);
                __builtin_amdgcn_sched_barrier(0);
                SC_COMP(B, j + 1);
            }
            }
#undef SC_LOAD
#undef SC_EL
#undef SC_COMP
            if ((MODE & 2) && ss + 1 < 256) { LAS unsigned char* kn = lds + nxt * AK_BYTES; LAS unsigned char* vn = lds + nxt * FV_BYTES;
                *(LAS v4u*)(kn + klds(at)) = sk0; *(LAS v4u*)(kn + klds(at + 256)) = sk1; *(LAS v4u*)(kn + klds(at + 512)) = sk2;
                *(LAS v2u*)(vn + vlds(at)) = (v2u){sv0.x, sv0.y}; *(LAS v2u*)(vn + vlds(at) + 16) = (v2u){sv0.z, sv0.w};
                *(LAS v2u*)(vn + vlds(at + 256)) = (v2u){sv1.x, sv1.y}; *(LAS v2u*)(vn + vlds(at + 256) + 16) = (v2u){sv1.z, sv1.w}; }
            SC_BAR();
        }
        __builtin_amdgcn_s_setprio(0);
    } else {
        bf16x8 qf[2][6]; float mrun[2], lrun[2]; f32x16 o0[2], o1[2];
        const int aw = wid - 4;
        for (int ss = 0; ss < 256; ++ss) {
            const int t = ss & 63, bh = bh0 + 16 * (ss >> 6), cur = ss & 1, nxt = cur ^ 1;
            if ((MODE & 1) && ss + 1 < 256) commit_chunk(nxt);
            if ((MODE & 1) && ss + 2 < 256) issue_chunk(ss + 2);
            if ((MODE & 1) && ss > 0) flush_chunk(ss - 1, nxt);
            if (MODE & 2) {
            if (t == 0) {
#pragma unroll
                for (int qq = 0; qq < 2; ++qq) { const bf16* Qp = (const bf16*)(F.ws + WS_Q) + ((size_t)bh * SEQ + qb * 256 + aw * 64 + qq * 32 + r32) * 96;
#pragma unroll
                    for (int d0 = 0; d0 < 6; ++d0) qf[qq][d0] = *(const bf16x8*)(Qp + 16 * d0 + 8 * hi);
                    mrun[qq] = -1e30f; lrun[qq] = 0.f; o0[qq] = (f32x16){}; o1[qq] = (f32x16){}; } }
            const LAS unsigned char* kb_ = lds + cur * AK_BYTES; const LAS unsigned char* vb_ = lds + AV_OFF + cur * FV_BYTES;
#pragma unroll
            for (int qq = 0; qq < 2; ++qq) {
                f32x16 p0, p1;
#pragma unroll
                for (int r = 0; r < 16; ++r) { p0[r] = -8.f; p1[r] = -8.f; }
#pragma unroll
                for (int d0 = 0; d0 < 6; ++d0) {
                    const bf16x8 a0 = *(const LAS bf16x8*)(kb_ + r32 * AK_STRIDE + 32 * d0 + 16 * hi), a1 = *(const LAS bf16x8*)(kb_ + (32 + r32) * AK_STRIDE + 32 * d0 + 16 * hi);
                    p0 = MFMA32(a0, qf[qq][d0], p0); p1 = MFMA32(a1, qf[qq][d0], p1); }
                float ls = 0.f;
#pragma unroll
                for (int r = 0; r < 16; ++r) { p0[r] = __builtin_amdgcn_exp2f(p0[r]); p1[r] = __builtin_amdgcn_exp2f(p1[r]); ls += p0[r] + p1[r]; }
                lrun[qq] += ls;
                v4u pb[4];
                pb[0] = (v4u){pk2(p0[0], p0[1]), pk2(p0[2], p0[3]), pk2(p0[4], p0[5]), pk2(p0[6], p0[7])};
                pb[1] = (v4u){pk2(p0[8], p0[9]), pk2(p0[10], p0[11]), pk2(p0[12], p0[13]), pk2(p0[14], p0[15])};
                pb[2] = (v4u){pk2(p1[0], p1[1]), pk2(p1[2], p1[3]), pk2(p1[4], p1[5]), pk2(p1[6], p1[7])};
                pb[3] = (v4u){pk2(p1[8], p1[9]), pk2(p1[10], p1[11]), pk2(p1[12], p1[13]), pk2(p1[14], p1[15])};
#pragma unroll
                for (int sl = 0; sl < 4; ++sl) {
                    const LAS unsigned char* va = vb_ + r32 * FV_STRIDE + 32 * sl + 16 * hi;
                    const bf16x8 vx = *(const LAS bf16x8*)va, vy = *(const LAS bf16x8*)(va + 32 * FV_STRIDE);
                    const bf16x8 pbf = __builtin_bit_cast(bf16x8, pb[sl]);
                    o0[qq] = MFMA32(vx, pbf, o0[qq]);
                    o1[qq] = MFMA32(vy, pbf, o1[qq]); }
                if (t == 63) {
                    const float lt_ = lrun[qq] + __shfl_xor(lrun[qq], 32);
                    const float inv = 1.f / lt_;
                    bf16* op = (bf16*)(F.ws + WS_OA) + ((size_t)(bh >> 3) * SEQ + qb * 256 + aw * 64 + qq * 32 + r32) * 512 + (bh & 7) * 64;
#pragma unroll
                    for (int g4 = 0; g4 < 4; ++g4) {
                        *(v2u*)(op + 8 * g4 + 4 * hi) = (v2u){pk2(o0[qq][4 * g4] * inv, o0[qq][4 * g4 + 1] * inv), pk2(o0[qq][4 * g4 + 2] * inv, o0[qq][4 * g4 + 3] * inv)};
                        *(v2u*)(op + 32 + 8 * g4 + 4 * hi) = (v2u){pk2(o1[qq][4 * g4] * inv, o1[qq][4 * g4 + 1] * inv), pk2(o1[qq][4 * g4 + 2] * inv, o1[qq][4 * g4 + 3] * inv)}; } }
            }
            }
            SC_BAR();
        }
        if (MODE & 1) flush_chunk(255, 1);
    }
    __syncthreads();
}

template <int MODE> __device__ __forceinline__ void p4_fused2(Frame& F) {
    const int tid = F.tid, lane = F.lane, wid = F.wave, r32 = lane & 31, hi = lane >> 5;
    LAS unsigned char* lds = F.lds;
    const int item = F.bid, sb = item >> 5, sh = (item >> 2) & 7, dir = (item >> 1) & 1, half = item & 1;
    const bf16* RKV = (const bf16*)(F.ws + WS_RKV); const bf16* ASIG = (const bf16*)(F.ws + WS_ASIG);
    const bf16* DEC = (const bf16*)(F.ws + (dir ? WS_DECB : WS_DECF)); bf16* OUT = (bf16*)(F.ws + (dir ? WS_OB : WS_OF));
    const bool isScan = wid < 2, isHelp = (wid == 2) || (wid == 3);
    const int ht = tid & 127, lj = ht >> 3, lg = ht & 7;
    const int qb = F.bid & 15, bh0 = F.bid >> 4;
    auto tok = [&](int c, int j) { const int s = dir ? (SEQ - 1 - (16 * c + j)) : (16 * c + j); return sb * SEQ + s; };
    auto kptr = [&](int ss_) { const int bh = bh0 + 16 * (ss_ >> 6); return (const v4u*)((const bf16*)(F.ws + WS_K) + (size_t)bh * SEQ * 96) + (size_t)(ss_ & 63) * 768; };
    auto vptr = [&](int ss_, int c) { const int bh = bh0 + 16 * (ss_ >> 6); return (const v4u*)((const bf16*)(F.ws + WS_VT) + (size_t)bh * 64 * SEQ + (size_t)(c >> 3) * SEQ + (c & 7) * 8 + (ss_ & 63) * 64); };
    auto klds = [&](int c) { return (c / 12) * AK_STRIDE + (c % 12) * 16; };
    auto vlds = [&](int c) { return AV_OFF + (c >> 3) * AV_STRIDE + (c & 7) * 16; };
    __syncthreads();
    if (isHelp) {
        float kk8[8], ka8[8];
#pragma unroll
        for (int i = 0; i < 8; ++i) { kk8[i] = F.in[19][sh * 64 + 8 * lg + i]; ka8[i] = F.in[20][sh * 64 + 8 * lg + i]; }
        v4u g_r8, g_k8, g_a8, g_w8, g_v8 = {0u, 0u, 0u, 0u};
        v4u sk[6], sv[4];
        auto issue_chunk = [&](int c) {
            const size_t m = (size_t)tok(c, lj); const int col = sh * 64 + 8 * lg;
            g_r8 = *(const v4u*)(RKV + m * 1536 + col); g_k8 = *(const v4u*)(RKV + m * 1536 + 512 + col); g_a8 = *(const v4u*)(ASIG + m * 512 + col); g_w8 = *(const v4u*)(DEC + m * 512 + col);
            if (lg < 4) g_v8 = *(const v4u*)(RKV + m * 1536 + 1024 + sh * 64 + half * 32 + 8 * lg);
        };
        auto commit_chunk = [&](int bufi) {
            f32x4 r0, r1, k0, k1, a0, a1, w0, w1; unpack8(g_r8, r0, r1); unpack8(g_k8, k0, k1); unpack8(g_a8, a0, a1); unpack8(g_w8, w0, w1);
            float kf[8], ss = 0.f;
#pragma unroll
            for (int i = 0; i < 4; ++i) { kf[i] = k0[i] * kk8[i]; kf[4 + i] = k1[i] * kk8[4 + i]; }
#pragma unroll
            for (int i = 0; i < 8; ++i) ss += kf[i] * kf[i];
            ss = red8(ss);
            const float inv = 1.f / fmaxf(sqrtf(ss), 1e-12f);
            f32x4 na0, na1, bb0, bb1, kp0, kp1, d0, d1;
#pragma unroll
            for (int i = 0; i < 4; ++i) { const float q0 = kf[i] * inv, q1 = kf[4 + i] * inv; na0[i] = -q0; na1[i] = -q1; bb0[i] = q0 * a0[i]; bb1[i] = q1 * a1[i];
                kp0[i] = k0[i] * (1.f + (a0[i] - 1.f) * ka8[i]); kp1[i] = k1[i] * (1.f + (a1[i] - 1.f) * ka8[4 + i]); d0[i] = fexp(w0[i]); d1[i] = fexp(w1[i]); }
            LAS float* sp = (LAS float*)(lds + FS_SBUF + bufi * FS_SBYTES + lj * SC_STEP) + 8 * lg;
            *(LAS f32x4*)(sp) = r0; *(LAS f32x4*)(sp + 4) = r1; *(LAS f32x4*)(sp + 64) = d0; *(LAS f32x4*)(sp + 68) = d1; *(LAS f32x4*)(sp + 128) = kp0; *(LAS f32x4*)(sp + 132) = kp1;
            *(LAS f32x4*)(sp + 192) = na0; *(LAS f32x4*)(sp + 196) = na1; *(LAS f32x4*)(sp + 256) = bb0; *(LAS f32x4*)(sp + 260) = bb1;
            if (lg < 4) { f32x4 v0, v1; unpack8(g_v8, v0, v1); *(LAS f32x4*)(sp + 320) = v0; *(LAS f32x4*)(sp + 324) = v1; }
        };
        auto flush_chunk = [&](int c, int bufi) {
            const LAS float* ob = (const LAS float*)(lds + FS_OBUF + bufi * FS_OBYTES) + lj * 256 + 32 * lg;
            float rs[4];
#pragma unroll
            for (int q = 0; q < 4; ++q) { const f32x4 x0 = *(const LAS f32x4*)(ob + 8 * q), x1 = *(const LAS f32x4*)(ob + 8 * q + 4); rs[q] = ((x0[0] + x0[1]) + (x0[2] + x0[3])) + ((x1[0] + x1[1]) + (x1[2] + x1[3])); }
            *(v2u*)(OUT + (size_t)tok(c, lj) * 512 + sh * 64 + half * 32 + 4 * lg) = (v2u){pk2(rs[0], rs[1]), pk2(rs[2], rs[3])};
        };
        auto kv_issue = [&](int ss_) { const v4u* kg = kptr(ss_);
#pragma unroll
            for (int i = 0; i < 6; ++i) sk[i] = kg[ht + 128 * i];
#pragma unroll
            for (int i = 0; i < 4; ++i) sv[i] = *vptr(ss_, ht + 128 * i); };
        auto kv_commit = [&](int bufi) { LAS unsigned char* kn = lds + bufi * AK_BYTES; LAS unsigned char* vn = lds + bufi * AV_BYTES;
#pragma unroll
            for (int i = 0; i < 6; ++i) *(LAS v4u*)(kn + klds(ht + 128 * i)) = sk[i];
#pragma unroll
            for (int i = 0; i < 4; ++i) { *(LAS v2u*)(vn + vlds(ht + 128 * i)) = (v2u){sv[i].x, sv[i].y}; *(LAS v2u*)(vn + vlds(ht + 128 * i) + 8) = (v2u){sv[i].z, sv[i].w}; } };
        if (MODE & 2) { kv_issue(0); kv_commit(0); }
        if (MODE & 1) { issue_chunk(0); commit_chunk(0); issue_chunk(1); }
        SC_BAR();
        for (int ss = 0; ss < 256; ++ss) {
            const int nxt = (ss & 1) ^ 1;
            if ((MODE & 2) && ss + 1 < 256) kv_issue(ss + 1);
            if ((MODE & 1) && ss + 1 < 256) commit_chunk(nxt);
            if ((MODE & 1) && ss + 2 < 256) issue_chunk(ss + 2);
            if ((MODE & 1) && ss > 0) flush_chunk(ss - 1, nxt);
            if ((MODE & 2) && ss + 1 < 256) kv_commit(nxt);
            SC_BAR();
        }
        if (MODE & 1) flush_chunk(255, 1);
    } else if (isScan) {
        __builtin_amdgcn_s_setprio(3);
        f32x2 SA[4], SB[4];
#pragma unroll
        for (int i = 0; i < 4; ++i) { SA[i] = (f32x2){0.f, 0.f}; SB[i] = (f32x2){0.f, 0.f}; }
        const int jj = lane & 7, rowA = wid * 16 + (lane >> 3), rowB = rowA + 8;
        SC_BAR();
        for (int ss = 0; ss < 256; ++ss) {
            const int cur = ss & 1;
            if (MODE & 1) {
            const LAS float* base = (const LAS float*)(lds + FS_SBUF + cur * FS_SBYTES) + 8 * jj; LAS float* ob = (LAS float*)(lds + FS_OBUF + cur * FS_OBYTES) + wid * 128 + lane;
#define SC_LOAD(X, j) do { const LAS float* p_ = base + (j) * (SC_STEP / 4); \
                X##r0 = *(const LAS f32x4*)p_; X##r1 = *(const LAS f32x4*)(p_ + 4); X##w0 = *(const LAS f32x4*)(p_ + 64); X##w1 = *(const LAS f32x4*)(p_ + 68); X##k0 = *(const LAS f32x4*)(p_ + 128); X##k1 = *(const LAS f32x4*)(p_ + 132); \
                X##a0 = *(const LAS f32x4*)(p_ + 192); X##a1 = *(const LAS f32x4*)(p_ + 196); X##b0 = *(const LAS f32x4*)(p_ + 256); X##b1 = *(const LAS f32x4*)(p_ + 260); \
                X##va = p_[320 - 8 * jj + rowA]; X##vb = p_[320 - 8 * jj + rowB]; } while (0)
#define SC_ROW(S, X, vv, oidx) do { \
                f32x2 t_ = S[0] * (f32x2){X##a0[0], X##a0[1]} + S[1] * (f32x2){X##a0[2], X##a0[3]}; f32x2 t2_ = S[2] * (f32x2){X##a1[0], X##a1[1]} + S[3] * (f32x2){X##a1[2], X##a1[3]}; t_ = t_ + t2_; \
                const float sa_ = red8(t_.x + t_.y); const f32x2 sa2_ = {sa_, sa_}, v2_ = {vv, vv}; \
                S[0] = S[0] * (f32x2){X##w0[0], X##w0[1]} + (sa2_ * (f32x2){X##b0[0], X##b0[1]} + v2_ * (f32x2){X##k0[0], X##k0[1]}); \
                S[1] = S[1] * (f32x2){X##w0[2], X##w0[3]} + (sa2_ * (f32x2){X##b0[2], X##b0[3]} + v2_ * (f32x2){X##k0[2], X##k0[3]}); \
                S[2] = S[2] * (f32x2){X##w1[0], X##w1[1]} + (sa2_ * (f32x2){X##b1[0], X##b1[1]} + v2_ * (f32x2){X##k1[0], X##k1[1]}); \
                S[3] = S[3] * (f32x2){X##w1[2], X##w1[3]} + (sa2_ * (f32x2){X##b1[2], X##b1[3]} + v2_ * (f32x2){X##k1[2], X##k1[3]}); \
                f32x2 q_ = S[0] * (f32x2){X##r0[0], X##r0[1]} + S[1] * (f32x2){X##r0[2], X##r0[3]}; f32x2 q2_ = S[2] * (f32x2){X##r1[0], X##r1[1]} + S[3] * (f32x2){X##r1[2], X##r1[3]}; q_ = q_ + q2_; \
                ob[(oidx)] = q_.x + q_.y; } while (0)
#define SC_COMP(X, j) do { SC_ROW(SA, X, X##va, (j) * 256); SC_ROW(SB, X, X##vb, (j) * 256 + 64); } while (0)
            f32x4 Ar0, Ar1, Aw0, Aw1, Ak0, Ak1, Aa0, Aa1, Ab0, Ab1, Br0, Br1, Bw0, Bw1, Bk0, Bk1, Ba0, Ba1, Bb0, Bb1; float Ava, Avb, Bva, Bvb;
            SC_LOAD(A, 0);
#pragma unroll
            for (int j = 0; j < 16; j += 2) {
                SC_LOAD(B, j + 1);
                __builtin_amdgcn_sched_barrier(0);
                SC_COMP(A, j);
                if (j + 2 < 16) SC_LOAD(A, j + 2);
                __builtin_amdgcn_sched_barrier(0);
                SC_COMP(B, j + 1);
            }
#undef SC_LOAD
#undef SC_ROW
#undef SC_COMP
            }
            SC_BAR();
        }
        __builtin_amdgcn_s_setprio(0);
    } else {
        SC_BAR();
        bf16x8 qf[2][6]; float mrun[2], lrun[2]; f32x16 o0[2], o1[2];
        const int aw = wid - 4;
        for (int ss = 0; ss < 256; ++ss) {
            const int t = ss & 63, bh = bh0 + 16 * (ss >> 6), cur = ss & 1;
            if (MODE & 2) {
            if (t == 0) {
#pragma unroll
                for (int qq = 0; qq < 2; ++qq) { const bf16* Qp = (const bf16*)(F.ws + WS_Q) + ((size_t)bh * SEQ + qb * 256 + aw * 64 + qq * 32 + r32) * 96;
#pragma unroll
                    for (int d0 = 0; d0 < 6; ++d0) qf[qq][d0] = *(const bf16x8*)(Qp + 16 * d0 + 8 * hi);
                    mrun[qq] = -1e30f; lrun[qq] = 0.f; o0[qq] = (f32x16){}; o1[qq] = (f32x16){}; } }
            const LAS unsigned char* kb_ = lds + cur * AK_BYTES; const LAS unsigned char* vb_ = lds + AV_OFF + cur * AV_BYTES;
#pragma unroll
            for (int qq = 0; qq < 2; ++qq) {
                f32x16 p0, p1;
#pragma unroll
                for (int r = 0; r < 16; ++r) { p0[r] = -8.f; p1[r] = -8.f; }
#pragma unroll
                for (int d0 = 0; d0 < 6; ++d0) {
                    const bf16x8 a0 = *(const LAS bf16x8*)(kb_ + r32 * AK_STRIDE + 32 * d0 + 16 * hi), a1 = *(const LAS bf16x8*)(kb_ + (32 + r32) * AK_STRIDE + 32 * d0 + 16 * hi);
                    p0 = MFMA32(a0, qf[qq][d0], p0); p1 = MFMA32(a1, qf[qq][d0], p1); }
                float ls = 0.f;
#pragma unroll
                for (int r = 0; r < 16; ++r) { p0[r] = __builtin_amdgcn_exp2f(p0[r]); p1[r] = __builtin_amdgcn_exp2f(p1[r]); ls += p0[r] + p1[r]; }
                lrun[qq] += ls;
                v4u pb[4];
                pb[0] = (v4u){pk2(p0[0], p0[1]), pk2(p0[2], p0[3]), pk2(p0[4], p0[5]), pk2(p0[6], p0[7])};
                pb[1] = (v4u){pk2(p0[8], p0[9]), pk2(p0[10], p0[11]), pk2(p0[12], p0[13]), pk2(p0[14], p0[15])};
                pb[2] = (v4u){pk2(p1[0], p1[1]), pk2(p1[2], p1[3]), pk2(p1[4], p1[5]), pk2(p1[6], p1[7])};
                pb[3] = (v4u){pk2(p1[8], p1[9]), pk2(p1[10], p1[11]), pk2(p1[12], p1[13]), pk2(p1[14], p1[15])};
#pragma unroll
                for (int sl = 0; sl < 4; ++sl) {
                    const LAS unsigned char* va = vb_ + r32 * AV_STRIDE + 2 * (16 * sl + 4 * hi);
                    const v2u x0 = *(const LAS v2u*)va, x1 = *(const LAS v2u*)(va + 16), y0 = *(const LAS v2u*)(va + 32 * AV_STRIDE), y1 = *(const LAS v2u*)(va + 32 * AV_STRIDE + 16);
                    const bf16x8 pbf = __builtin_bit_cast(bf16x8, pb[sl]);
                    o0[qq] = MFMA32(__builtin_bit_cast(bf16x8, ((v4u){x0.x, x0.y, x1.x, x1.y})), pbf, o0[qq]);
                    o1[qq] = MFMA32(__builtin_bit_cast(bf16x8, ((v4u){y0.x, y0.y, y1.x, y1.y})), pbf, o1[qq]); }
                if (t == 63) {
                    const float lt_ = lrun[qq] + __shfl_xor(lrun[qq], 32);
                    const float inv = 1.f / lt_;
                    bf16* op = (bf16*)(F.ws + WS_OA) + ((size_t)(bh >> 3) * SEQ + qb * 256 + aw * 64 + qq * 32 + r32) * 512 + (bh & 7) * 64;
#pragma unroll
                    for (int g4 = 0; g4 < 4; ++g4) {
                        *(v2u*)(op + 8 * g4 + 4 * hi) = (v2u){pk2(o0[qq][4 * g4] * inv, o0[qq][4 * g4 + 1] * inv), pk2(o0[qq][4 * g4 + 2] * inv, o0[qq][4 * g4 + 3] * inv)};
                        *(v2u*)(op + 32 + 8 * g4 + 4 * hi) = (v2u){pk2(o1[qq][4 * g4] * inv, o1[qq][4 * g4 + 1] * inv), pk2(o1[qq][4 * g4 + 2] * inv, o1[qq][4 * g4 + 3] * inv)}; } }
            }
            }
            SC_BAR();
        }
    }
    __syncthreads();
}

#define XB_TMO      128
#define XB_XCNT(j)  (256  + 64 * (j))
#define XB_XSUB(j)  (1280 + 64 * (j))
#define XB_XGEN(j)  (2304 + 64 * (j))
#define XB_TOP      3328
#define XB_TOPGEN   3392
#define XCD_BAR_WORDS 3456
#define XB_SPIN_CAP (1u << 18)

__device__ __forceinline__ unsigned xb_ld(unsigned* p)              { return __hip_atomic_load(p, __ATOMIC_RELAXED, __HIP_MEMORY_SCOPE_AGENT); }
__device__ __forceinline__ unsigned xb_add(unsigned* p, unsigned v) { return __hip_atomic_fetch_add(p, v, __ATOMIC_RELAXED, __HIP_MEMORY_SCOPE_AGENT); }
__device__ __forceinline__ unsigned xb_xcc_id() { return (unsigned)__builtin_amdgcn_s_getreg((3 << 11) | 20) & 0xFu; }
#define XB_SPIN(cond, bar) do { unsigned _sp = 0; while (cond) { __builtin_amdgcn_s_sleep(1); \
    if ((++_sp & 255u) == 0u) { if (xb_ld(&(bar)[XB_TMO])) break; if (_sp > XB_SPIN_CAP) { atomicAdd(&(bar)[XB_TMO], 1u); break; } } } } while (0)

struct XcdBarrier {
    unsigned* bar; unsigned x;
    volatile LAS unsigned* st;
};

__device__ __forceinline__ XcdBarrier xcd_barrier_post(unsigned* bar, volatile LAS unsigned* st) {
    XcdBarrier b; b.bar = bar; b.x = xb_xcc_id(); b.st = st;
    if (threadIdx.x == 0) (void)xb_add(&bar[XB_XCNT(b.x)], 1u);
    return b;
}
__device__ __forceinline__ void xcd_barrier_complete(unsigned* bar, unsigned x, unsigned& nloc, unsigned& nx) {
    const unsigned G = gridDim.x * gridDim.y * gridDim.z;
    unsigned sum, cnt, mine, sp = 0u;
    for (;;) {
        sum = 0u; cnt = 0u; mine = 0u;
#pragma unroll
        for (unsigned j = 0; j < 16; ++j) { const unsigned c = xb_ld(&bar[XB_XCNT(j)]); sum += c; cnt += (c > 0u) ? 1u : 0u; mine = (j == x) ? c : mine; }
        if (sum == G) break;
        __builtin_amdgcn_s_sleep(1);
        if ((++sp & 255u) == 0u) { if (xb_ld(&bar[XB_TMO])) break; if (sp > XB_SPIN_CAP) { atomicAdd(&bar[XB_TMO], 1u); break; } }
    }
    nloc = mine > 0u ? mine : 1u; nx = cnt > 0u ? cnt : 1u;
}

__device__ __forceinline__ void xcd_barrier(const XcdBarrier& b) {
    asm volatile("s_waitcnt vmcnt(0)" ::: "memory");
    __syncthreads();
    if (threadIdx.x == 0) {
        unsigned* bar = b.bar;
        __builtin_amdgcn_s_waitcnt(0);
        unsigned nloc = b.st[0], nx = b.st[1];
        if (nloc == 0u) { xcd_barrier_complete(bar, b.x, nloc, nx); b.st[0] = nloc; b.st[1] = nx; }
        const unsigned old = xb_add(&bar[XB_XSUB(b.x)], 1u);
        const unsigned gen = old / nloc;
        if (old + 1u == (gen + 1u) * nloc) {
            __builtin_amdgcn_fence(__ATOMIC_RELEASE, "agent");
            asm volatile("s_waitcnt vmcnt(0)" ::: "memory");
            const unsigned og = xb_add(&bar[XB_TOP], 1u);
            const unsigned tg = og / nx;
            if (og + 1u == (tg + 1u) * nx) xb_add(&bar[XB_TOPGEN], 1u);
            else XB_SPIN(xb_ld(&bar[XB_TOPGEN]) == tg, bar);
            __builtin_amdgcn_fence(__ATOMIC_ACQUIRE, "agent");
            xb_add(&bar[XB_XGEN(b.x)], 1u);
            asm volatile("s_waitcnt vmcnt(0)" ::: "memory");
        } else {
            XB_SPIN(xb_ld(&bar[XB_XGEN(b.x)]) == gen, bar);
            __builtin_amdgcn_fence(__ATOMIC_ACQUIRE, "agent");
            asm volatile("s_waitcnt vmcnt(0)" ::: "memory");
        }
    }
    __syncthreads();
}

constexpr int N_PHASES = 13;
__global__ void __launch_bounds__(512, 2) fwd_kernel(Args args) {
    extern __shared__ __attribute__((aligned(16))) unsigned char lds_raw[];
    cg::grid_group grid = cg::this_grid();
    Frame F;
    F.lds = (LAS unsigned char*)lds_raw;
    F.tid = threadIdx.x; F.lane = F.tid & 63; F.wave = __builtin_amdgcn_readfirstlane(F.tid >> 6); F.G = gridDim.x; F.bid = blockIdx.x;
#pragma unroll
    for (int i = 0; i < 32; ++i) F.in[i] = args.in[i];
    F.out = args.out; F.ws = args.ws;
    unsigned char* ws = args.ws;
    const int lo = args.ph_lo, hi = args.ph_hi;
#ifndef SKIPMASK
#define SKIPMASK 0
#endif
#define IN(k) (lo <= (k) && (k) < hi && !((SKIPMASK >> (k)) & 1))
    volatile LAS unsigned* xst = (volatile LAS unsigned*)(F.lds + 131072 + 64);
    if (F.tid == 0) { xst[0] = 0u; xst[1] = 0u; }
    __syncthreads();
    if (args.ph_hi < 0) grid.sync();
    const XcdBarrier xbar = xcd_barrier_post((unsigned*)ws, xst);
#define SEAM(k) do { if (IN(k) && IN((k) + 1)) { xcd_barrier(xbar); } } while (0)
#ifndef REPMASK
#define REPMASK 0
#endif
#define REP(k) for (int rep_ = 0; rep_ < 1 + ((REPMASK >> (k)) & 1); ++rep_)
    bf16* PG = (bf16*)F.out;
    if (IN(0)) REP(0) { p0_prologue(F); } SEAM(0);
    if (IN(1)) { run_gemm(F, (const bf16*)(ws + WS_XN), 1024, (const bf16*)(ws + WS_WIN), 1024, 4608, 1024, FnIn{PG, (bf16*)(ws + WS_PR), (bf16*)(ws + WS_PM), F.in[4]});
#ifdef DUP1
        run_gemm(F, (const bf16*)(ws + WS_XN), 1024, (const bf16*)(ws + WS_WIN), 1024, 4608, 1024, FnIn{PG, (bf16*)(ws + WS_PR), (bf16*)(ws + WS_PM), F.in[4]});
#endif
    } SEAM(1);
    if (IN(2)) REP(2) { if (!((SKIPMASK >> 13) & 1)) p2_shift(F); } SEAM(2);
    if (IN(3)) {
        if (!((SKIPMASK >> 14) & 1)) for (int it = (F.G == 256) ? (((F.bid & 7) << 5) | (F.bid >> 3)) : F.bid; it < 256; it += F.G) mla_item(F, it);
        run_gemm(F, (const bf16*)(ws + WS_LI), 256, (const bf16*)(ws + WS_WL1), 128, 1024, 128, FnLora1{(bf16*)(ws + WS_ASIG), (bf16*)(ws + WS_DECF), F.in[16], F.in[14]});
        run_gemm(F, (const bf16*)(ws + WS_LI) + 128, 256, (const bf16*)(ws + WS_WL2), 128, 512, 128, FnLora2{(bf16*)(ws + WS_DECB), F.in[14] + 512});

#ifdef DUP3
#if DUP3 & 1
        if (!((SKIPMASK >> 14) & 1)) for (int it = (F.G == 256) ? (((F.bid & 7) << 5) | (F.bid >> 3)) : F.bid; it < 256; it += F.G) mla_item(F, it);
#endif
#if DUP3 & 2
        run_gemm(F, (const bf16*)(ws + WS_LI), 256, (const bf16*)(ws + WS_WL1), 128, 1024, 128, FnLora1{(bf16*)(ws + WS_ASIG), (bf16*)(ws + WS_DECF), F.in[16], F.in[14]});
        run_gemm(F, (const bf16*)(ws + WS_LI) + 128, 256, (const bf16*)(ws + WS_WL2), 128, 512, 128, FnLora2{(bf16*)(ws + WS_DECB), F.in[14] + 512});


#endif
#endif
    } SEAM(3);
    if (IN(4)) {
#ifndef REP_SCAN
#define REP_SCAN 1
#endif
#ifndef REP_ATTN
#define REP_ATTN 1
#endif
#ifndef P4FORM
#define P4FORM 1
#endif
        if (F.G == 256) { if (P4FORM == 2) p4_fused2<3>(F); else p4_fused<3>(F);
#ifdef DUP4
            if (P4FORM == 2) p4_fused2<DUP4>(F); else p4_fused<DUP4>(F);
#endif
        }
        else {
        for (int rep = 0; rep < REP_SCAN; ++rep) for (int it = F.bid; it < 256; it += F.G) scan_item(F, it);
        for (int rep = 0; rep < REP_ATTN; ++rep) for (int u = F.bid; u < 1024; u += F.G) attn_unit(F, u >> 4, u & 15);
        }
    } SEAM(4);
    if (IN(5)) { p5_gn(F); } SEAM(5);
    if (IN(6)) {
        run_gemm(F, (const bf16*)(ws + WS_SG), 256, (const bf16*)(ws + WS_WGF), 128, 512, 128, FnMulAcc<0>{(bf16*)(ws + WS_OBC), 512, (const bf16*)(ws + WS_OF), 512, 0});
        run_gemm(F, (const bf16*)(ws + WS_SG) + 128, 256, (const bf16*)(ws + WS_WGB), 128, 512, 128, FnMulAcc<1>{(bf16*)(ws + WS_OBC), 512, (const bf16*)(ws + WS_OB), 512, 0});

#ifdef DUP67

        run_gemm(F, (const bf16*)(ws + WS_SG), 256, (const bf16*)(ws + WS_WGF), 128, 512, 128, FnMulAcc<0>{(bf16*)(ws + WS_OBC), 512, (const bf16*)(ws + WS_OF), 512, 0});
        run_gemm(F, (const bf16*)(ws + WS_SG) + 128, 256, (const bf16*)(ws + WS_WGB), 128, 512, 128, FnMulAcc<1>{(bf16*)(ws + WS_OBC), 512, (const bf16*)(ws + WS_OB), 512, 0});

#endif
    } SEAM(6);
    if (IN(7)) {
        run_gemm(F, (const bf16*)(ws + WS_OA), 512, (const bf16*)(ws + WS_WO), 1024, 1024, 512, FnMulAcc<0>{(bf16*)(ws + WS_M), 1024, PG, 2048, 0});
        run_gemm(F, (const bf16*)(ws + WS_OBC), 512, (const bf16*)(ws + WS_WO) + 512, 1024, 1024, 512, FnMulAcc<1>{(bf16*)(ws + WS_M), 1024, PG, 2048, 1024});

#ifdef DUP67

        run_gemm(F, (const bf16*)(ws + WS_OA), 512, (const bf16*)(ws + WS_WO), 1024, 1024, 512, FnMulAcc<0>{(bf16*)(ws + WS_M), 1024, PG, 2048, 0});
        run_gemm(F, (const bf16*)(ws + WS_OBC), 512, (const bf16*)(ws + WS_WO) + 512, 1024, 1024, 512, FnMulAcc<1>{(bf16*)(ws + WS_M), 1024, PG, 2048, 1024});

#endif
    } SEAM(7);
    if (IN(8)) { run_gemm(F, (const bf16*)(ws + WS_M), 1024, (const bf16*)(ws + WS_WM), 1024, 1024, 1024, FnResidNorm{F.in[0], F.out, (bf16*)(ws + WS_XN), (float*)(ws + WS_RSQ)}); } SEAM(8);
    if (IN(10)) { run_gemm(F, (const bf16*)(ws + WS_XN), 1024, (const bf16*)(ws + WS_WGU), 1024, 2816, 1024, FnStoreScaled{(bf16*)(ws + WS_GU), 2816, (const float*)(ws + WS_RSQ)});
#ifdef DUP10
        run_gemm(F, (const bf16*)(ws + WS_XN), 1024, (const bf16*)(ws + WS_WGU), 1024, 2816, 1024, FnStoreScaled{(bf16*)(ws + WS_GU), 2816, (const float*)(ws + WS_RSQ)});
#endif
    } SEAM(10);
    if (IN(11)) { run_gemm(F, (const bf16*)(ws + WS_XN), 1024, (const bf16*)(ws + WS_WGU) + (size_t)2816 * 1024, 1024, 2816, 1024, FnConvAct{(const bf16*)(ws + WS_GU), (bf16*)(ws + WS_ACT), F.in[29], F.in[30], (const float*)(ws + WS_RSQ)}); } SEAM(11);
    if (IN(12)) { run_gemm(F, (const bf16*)(ws + WS_ACT), 2816, (const bf16*)(ws + WS_WD), 2816, 1024, 2816, FnResidBf{(const bf16*)(ws + WS_XN), F.out}); }
#ifdef XSYNC
    for (int i = 0; i < XSYNC; ++i) xcd_barrier(xbar);
#endif
#undef IN
#undef SEAM
}

#ifndef MK_PER_PHASE
#define MK_PER_PHASE 0
#endif
extern "C" void kernel_launch(void* const* d_in, const int* in_sizes, int n_in, void* d_out, int out_size, void* d_ws, size_t ws_size, hipStream_t stream) {
    static int grid = 0;
    if (grid == 0) {
        if (n_in != 32 || out_size != NTOK * DM || ws_size < WS_END) { fprintf(stderr, "kernel_launch: unexpected problem (n_in %d out %d ws %zu)\n", n_in, out_size, ws_size); grid = -1; return; }
        int dev = 0, cus = 0, per_cu = 0;
        hipGetDevice(&dev); hipDeviceGetAttribute(&cus, hipDeviceAttributeMultiprocessorCount, dev);
        hipFuncSetAttribute((const void*)fwd_kernel, hipFuncAttributeMaxDynamicSharedMemorySize, LDS_BYTES);
        if (hipOccupancyMaxActiveBlocksPerMultiprocessor(&per_cu, (const void*)fwd_kernel, 512, LDS_BYTES) != hipSuccess || per_cu < 1) per_cu = 1;
        (void)hipGetLastError();
        grid = cus * per_cu;
    }
    if (grid < 0) return;
    Args a{};
    for (int i = 0; i < 32; ++i) a.in[i] = (const float*)d_in[i];
    a.out = (float*)d_out; a.ws = (unsigned char*)d_ws;
    if (hipMemsetAsync(d_ws, 0, 16384, stream) != hipSuccess) { fprintf(stderr, "kernel_launch: memset of the barrier word failed\n"); return; }
    void* params[] = {&a};
#if MK_PER_PHASE
    for (int p = 0; p < N_PHASES; ++p) { a.ph_lo = p; a.ph_hi = p + 1;
        hipError_t e = hipLaunchCooperativeKernel((void*)fwd_kernel, dim3(grid), dim3(512), params, LDS_BYTES, stream);
        if (e != hipSuccess) { fprintf(stderr, "launch %d failed: %s\n", p, hipGetErrorString(e)); break; } }
#else
    a.ph_lo = 0; a.ph_hi = N_PHASES;
    hipError_t e = hipLaunchCooperativeKernel((void*)fwd_kernel, dim3(grid), dim3(512), params, LDS_BYTES, stream);
    if (e != hipSuccess) fprintf(stderr, "cooperative launch failed: %s (grid %d)\n", hipGetErrorString(e), grid);
#endif
}
```

```cpp
#include <hip/hip_runtime.h>
#include <hip/hip_cooperative_groups.h>
#include <cstdio>
#include <cstdint>
namespace cg = cooperative_groups;
namespace pg8 {
#define PG8_LAS __attribute__((address_space(3)))
typedef unsigned short bf16_t;
typedef short bf16x8 __attribute__((ext_vector_type(8)));
typedef float f32x4 __attribute__((ext_vector_type(4)));
typedef unsigned u32x4 __attribute__((ext_vector_type(4)));
constexpr int BM = 256, BK = 64, HALF = 128, HTB = HALF * BK * 2  , STAGE_BYTES = 8 * HTB, NXCD = 8, WGM = 8;

__host__ __device__ __forceinline__ int lds_byte(int r, int c) { const int st = (r >> 4) * 2 + (c >> 5), rr = r & 15, cc = c & 31, ob = rr * 64 + cc * 2; return st * 1024 + (ob ^ (((ob >> 9) & 1) << 5)); }
__host__ __device__ __forceinline__ void stage_rc(int b, int& R, int& C) { const int st = b / 1024, sb = b % 1024, swz = sb ^ (((sb >> 9) & 1) << 5); R = (st >> 1) * 16 + swz / 64; C = (st & 1) * 32 + (swz % 64) / 2; }
__host__ __device__ __forceinline__ int perm32(int rho) { const int n = rho >> 4, i = rho & 15; return 8 * (i >> 2) + 4 * n + (i & 3); }

struct Unit { int pm, pn; };
struct Gemm { const bf16_t* A; const bf16_t* Bt; int M, N, K, lda, ldb; };

struct StaticOrder {
    int nM, nN, nwg, G, c;
    __host__ __device__ void init(int M, int N, int G_, int c_) { nM = M / BM; nN = N / BM; nwg = nM * nN; G = G_; c = c_; }
    __host__ __device__ bool next(int i, Unit& u) const {
        const long L = (long)i * G + c; if (L >= nwg) return false;
        int wgid = (int)L; { const int q = nwg / NXCD, r = nwg % NXCD, xcd = wgid % NXCD, off = wgid / NXCD; wgid = (xcd < r ? xcd * (q + 1) : r * (q + 1) + (xcd - r) * q) + off; }
        const int nig = WGM * nN, gid = wgid / nig, fm = gid * WGM, gsz = (nM - fm) < WGM ? (nM - fm) : WGM;
        u.pm = fm + ((wgid % nig) % gsz); u.pn = (wgid % nig) / gsz; return true;
    }
    __device__ __forceinline__ void a_ready(const Unit&) const {}
    __device__ __forceinline__ void done(const Unit&) const {}
};

__device__ __forceinline__ unsigned cvt_pk_bf16(float lo, float hi) { unsigned r; asm volatile("v_cvt_pk_bf16_f32 %0, %1, %2" : "=v"(r) : "v"(lo), "v"(hi)); return r; }
template <class Epi, class Sched, bool ALIGN_EPI = false, bool SP2 = false>
__device__ __forceinline__ void gemm_phase(PG8_LAS unsigned char* lds, const Gemm g, const Sched& S, const Epi& E) {
    const int tid = threadIdx.x, wid = __builtin_amdgcn_readfirstlane(tid >> 6), lane = tid & 63, wr = wid >> 2, wc = wid & 3, fr = lane & 15, fq = lane >> 4;
    const int K = g.K, nt = K / BK;
    unsigned voffA[2], voffB[2];
#pragma unroll
    for (int i = 0; i < 2; ++i) { int R, C; stage_rc(tid * 16 + i * 8192, R, C); const int Rb = Epi::PERM ? ((R & ~31) + perm32(R & 31)) : R;
        voffA[i] = (unsigned)(R * g.lda + C) * 2u; voffB[i] = (unsigned)(Rb * g.ldb + C) * 2u; }
    const size_t kstep = (size_t)(BK * 2);
    const size_t hstepA = (size_t)HALF * g.lda * 2, hstepB = (size_t)HALF * g.ldb * 2;
    const size_t tstepA = 2 * hstepA, tstepB = 2 * hstepB;
    const unsigned ldsw = (unsigned)wid * 1024u;
    const int aoff = lds_byte(wr * 64 + fr, fq * 8), boff = lds_byte(wc * 32 + fr, fq * 8);
#define PG8_SA(b, h) (((b) * 2 + (h)) * HTB)
#define PG8_SB(b, h) ((4 + (b) * 2 + (h)) * HTB)
#define PG8_STAGE(bufoff, gbase, voff) do { _Pragma("unroll") for (int _i = 0; _i < 2; ++_i) \
        __builtin_amdgcn_global_load_lds((const unsigned*)((const char*)(gbase) + (voff)[_i]), (PG8_LAS unsigned*)(lds + (bufoff) + ldsw + _i * 8192), 16, 0, 0); } while (0)
#define PG8_LDA(dst, b, h) do { _Pragma("unroll") for (int m = 0; m < 4; ++m) _Pragma("unroll") for (int k = 0; k < 2; ++k) dst[m][k] = *(const PG8_LAS bf16x8*)(lds + PG8_SA(b, h) + aoff + m * 2048 + k * 1024); } while (0)
#define PG8_LDB(dst, b, h) do { _Pragma("unroll") for (int n = 0; n < 2; ++n) _Pragma("unroll") for (int k = 0; k < 2; ++k) dst[n][k] = *(const PG8_LAS bf16x8*)(lds + PG8_SB(b, h) + boff + n * 2048 + k * 1024); } while (0)
#define PG8_MMA(ai, bj, At, Bt) do { __builtin_amdgcn_s_setprio(1); _Pragma("unroll") for (int m = 0; m < 4; ++m) _Pragma("unroll") for (int n = 0; n < 2; ++n) _Pragma("unroll") for (int k = 0; k < 2; ++k) \
        acc[ai][bj][m][n] = __builtin_amdgcn_mfma_f32_16x16x32_bf16(Bt[n][k], At[m][k], acc[ai][bj][m][n], 0, 0, 0); __builtin_amdgcn_s_setprio(0); } while (0)
#define PG8_WAIT_V(n) asm volatile("s_waitcnt vmcnt(" #n ")" ::: "memory")
#define PG8_WAIT_L(n) asm volatile("s_waitcnt lgkmcnt(" #n ")" ::: "memory")
#define PG8_BAR __builtin_amdgcn_s_barrier()
#define PG8_SCHED __builtin_amdgcn_sched_barrier(0)
    Unit cur, nxt; int ui = 0;
    if (!S.next(0, cur)) return;
    f32x4 acc[2][2][4][2];
#pragma unroll
    for (int a = 0; a < 2; ++a)
#pragma unroll
        for (int b = 0; b < 2; ++b)
#pragma unroll
            for (int m = 0; m < 4; ++m)
#pragma unroll
                for (int n = 0; n < 2; ++n) acc[a][b][m][n] = (f32x4){0.f, 0.f, 0.f, 0.f};
    bf16x8 At[4][2], B0[2][2], B1[2][2];
    const char* cA = (const char*)g.A + (size_t)cur.pm * tstepA; const char* cB = (const char*)g.Bt + (size_t)cur.pn * tstepB;
    S.a_ready(cur);
    if constexpr (SP2) {
        PG8_STAGE(PG8_SB(0, 0), cB, voffB); PG8_STAGE(PG8_SB(0, 1), cB + hstepB, voffB); PG8_STAGE(PG8_SA(0, 0), cA, voffA); PG8_STAGE(PG8_SA(0, 1), cA + hstepA, voffA);
        if (wr == 1) PG8_BAR;
        PG8_WAIT_V(2); PG8_BAR;
        PG8_STAGE(PG8_SB(1, 0), cB + kstep, voffB); PG8_STAGE(PG8_SA(1, 0), cA + kstep, voffA); PG8_STAGE(PG8_SB(1, 1), cB + hstepB + kstep, voffB);
        PG8_WAIT_V(6); PG8_BAR;
    } else {
        PG8_STAGE(PG8_SB(0, 0), cB, voffB); PG8_STAGE(PG8_SA(0, 0), cA, voffA); PG8_STAGE(PG8_SB(0, 1), cB + hstepB, voffB); PG8_STAGE(PG8_SA(0, 1), cA + hstepA, voffA);
        if (wr == 1) PG8_BAR;
        PG8_WAIT_V(4); PG8_BAR;
        PG8_STAGE(PG8_SB(1, 0), cB + kstep, voffB); PG8_STAGE(PG8_SA(1, 0), cA + kstep, voffA); PG8_STAGE(PG8_SB(1, 1), cB + hstepB + kstep, voffB);
        PG8_WAIT_V(6); PG8_BAR;
    }
    for (;;) {
        const bool has_next = S.next(ui + 1, nxt);
        const char* nA = has_next ? (const char*)g.A + (size_t)nxt.pm * tstepA : cA; const char* nB = has_next ? (const char*)g.Bt + (size_t)nxt.pn * tstepB : cB;
        for (int t = 0; t < nt; t += 2) {
            const bool last = (t == nt - 2);
            const char* a1 = cA + (size_t)(t + 1) * kstep;
            const char* a2 = last ? nA : cA + (size_t)(t + 2) * kstep; const char* b2 = last ? nB : cB + (size_t)(t + 2) * kstep;
            const char* a3 = a2 + kstep; const char* b3 = b2 + kstep;
            if (last && has_next) S.a_ready(nxt);
            if constexpr (SP2) {
            PG8_LDB(B0, 0, 0); PG8_LDB(B1, 0, 1); PG8_SCHED; PG8_LDA(At, 0, 0); PG8_STAGE(PG8_SA(1, 1), a1 + hstepA, voffA);
            PG8_WAIT_V(8); PG8_WAIT_L(0); PG8_BAR; PG8_MMA(0, 0, At, B0); PG8_MMA(0, 1, At, B1); PG8_BAR; PG8_SCHED;
            PG8_LDA(At, 0, 1); PG8_STAGE(PG8_SB(0, 0), b2, voffB); PG8_STAGE(PG8_SB(0, 1), b2 + hstepB, voffB); PG8_STAGE(PG8_SA(0, 0), a2, voffA);
            PG8_WAIT_V(8); PG8_WAIT_L(0); PG8_BAR; PG8_MMA(1, 0, At, B0); PG8_MMA(1, 1, At, B1); PG8_BAR; PG8_SCHED;
            PG8_LDB(B0, 1, 0); PG8_LDB(B1, 1, 1); PG8_SCHED; PG8_LDA(At, 1, 0); PG8_STAGE(PG8_SA(0, 1), a2 + hstepA, voffA);
            PG8_WAIT_V(8); PG8_WAIT_L(0); PG8_BAR; PG8_MMA(0, 0, At, B0); PG8_MMA(0, 1, At, B1); PG8_BAR; PG8_SCHED;
            PG8_LDA(At, 1, 1); PG8_STAGE(PG8_SB(1, 0), b3, voffB); PG8_STAGE(PG8_SB(1, 1), b3 + hstepB, voffB); PG8_STAGE(PG8_SA(1, 0), a3, voffA);
            PG8_WAIT_V(8); PG8_WAIT_L(0); PG8_BAR; PG8_MMA(1, 0, At, B0); PG8_MMA(1, 1, At, B1); PG8_BAR; PG8_SCHED;
            } else {
            PG8_LDB(B0, 0, 0); PG8_SCHED; PG8_LDA(At, 0, 0); PG8_STAGE(PG8_SA(1, 1), a1 + hstepA, voffA);
            PG8_WAIT_L(8); PG8_BAR; PG8_WAIT_L(0); PG8_MMA(0, 0, At, B0); PG8_BAR; PG8_SCHED;
            PG8_LDB(B1, 0, 1); PG8_STAGE(PG8_SB(0, 0), b2, voffB);
            PG8_BAR; PG8_WAIT_L(0); PG8_MMA(0, 1, At, B1); PG8_BAR;
            PG8_LDA(At, 0, 1); PG8_STAGE(PG8_SA(0, 0), a2, voffA);
            PG8_BAR; PG8_WAIT_L(0); PG8_MMA(1, 0, At, B0); PG8_BAR; PG8_SCHED;
            PG8_STAGE(PG8_SB(0, 1), b2 + hstepB, voffB);
            PG8_WAIT_V(6); PG8_BAR; PG8_MMA(1, 1, At, B1); PG8_BAR;
            PG8_LDB(B0, 1, 0); PG8_SCHED; PG8_LDA(At, 1, 0); PG8_STAGE(PG8_SA(0, 1), a2 + hstepA, voffA);
            PG8_WAIT_L(8); PG8_BAR; PG8_WAIT_L(0); PG8_MMA(0, 0, At, B0); PG8_BAR; PG8_SCHED;
            PG8_LDB(B1, 1, 1); PG8_STAGE(PG8_SB(1, 0), b3, voffB);
            PG8_BAR; PG8_WAIT_L(0); PG8_MMA(0, 1, At, B1); PG8_BAR;
            PG8_LDA(At, 1, 1); PG8_STAGE(PG8_SA(1, 0), a3, voffA);
            PG8_BAR; PG8_WAIT_L(0); PG8_MMA(1, 0, At, B0); PG8_BAR; PG8_SCHED;
            PG8_STAGE(PG8_SB(1, 1), b3 + hstepB, voffB);
            PG8_WAIT_V(6); PG8_BAR; PG8_MMA(1, 1, At, B1); PG8_BAR;
            }
        }
        if constexpr (ALIGN_EPI) { if (wr == 0) PG8_BAR; }
        if constexpr (!Epi::AFTER_DRAIN) { E(acc, cur, wr, wc, fr, fq); S.done(cur); }
        if (!has_next) break;
#pragma unroll
        for (int a = 0; a < 2; ++a)
#pragma unroll
            for (int b = 0; b < 2; ++b)
#pragma unroll
                for (int m = 0; m < 4; ++m)
#pragma unroll
                    for (int n = 0; n < 2; ++n) acc[a][b][m][n] = (f32x4){0.f, 0.f, 0.f, 0.f};
        cur = nxt; cA = nA; cB = nB; ++ui;
        if constexpr (ALIGN_EPI) { if (wr == 1) PG8_BAR; }
    }
    PG8_WAIT_V(0);
    if constexpr (!ALIGN_EPI) { if (wr == 0) PG8_BAR; }
    PG8_BAR;
    if constexpr (Epi::AFTER_DRAIN) { E.fused(acc, cur, wr, wc, fr, fq, lds, wid, lane); S.done(cur); }
#undef PG8_SA
#undef PG8_SB
#undef PG8_STAGE
#undef PG8_LDA
#undef PG8_LDB
#undef PG8_MMA
#undef PG8_WAIT_V
#undef PG8_WAIT_L
#undef PG8_BAR
#undef PG8_SCHED
}
}

#define GAS __attribute__((address_space(1)))
#define LAS __attribute__((address_space(3)))
typedef unsigned short bf16;
typedef unsigned v4u __attribute__((ext_vector_type(4)));
typedef unsigned v2u __attribute__((ext_vector_type(2)));
typedef float f32x4 __attribute__((ext_vector_type(4)));
typedef float f32x2 __attribute__((ext_vector_type(2)));
typedef float f32x16 __attribute__((ext_vector_type(16)));
typedef short bf16x8 __attribute__((ext_vector_type(8)));

constexpr int NTOK = 32768, SEQ = 4096, DM = 1024;
constexpr size_t MiB = 1u << 20;
constexpr size_t WS_WIN = 1 * MiB, WS_WUQ = 10 * MiB, WS_WUKV = 10 * MiB + 512 * 1024, WS_WL1 = 10 * MiB + 768 * 1024, WS_WL2 = 11 * MiB, WS_WGF = 11 * MiB + 128 * 1024,
                 WS_WGB = 11 * MiB + 256 * 1024, WS_WO = 12 * MiB, WS_WM = 14 * MiB, WS_WGU = 16 * MiB, WS_WD = 27 * MiB;
constexpr size_t WS_XN = 33 * MiB, WS_PR = 97 * MiB, WS_PM = 225 * MiB, WS_RKV = 257 * MiB, WS_LI = 353 * MiB, WS_SG = 369 * MiB, WS_VT = 385 * MiB, WS_OF = 417 * MiB, WS_OB = 449 * MiB;
constexpr size_t WS_ASIG = 33 * MiB, WS_DECF = 65 * MiB, WS_DECB = 97 * MiB, WS_Q = 129 * MiB, WS_K = 177 * MiB, WS_OA = 225 * MiB, WS_OBC = 65 * MiB, WS_M = 97 * MiB, WS_GU = 97 * MiB, WS_ACT = 273 * MiB;
constexpr size_t WS_END = 481 * MiB, WS_RSQ = 65536;
constexpr int LDS_BYTES = 135168;
constexpr float LOG2E = 1.4426950408889634f;
constexpr float QSCALE = 0.10206207261596575f * 1.4426950408889634f;

struct Args { const float* in[32]; float* out; unsigned char* ws; int ph_lo, ph_hi; };

typedef __bf16 bf16x2_t __attribute__((ext_vector_type(2)));
__device__ __forceinline__ unsigned pk2(float lo, float hi) { unsigned r; asm volatile("v_cvt_pk_bf16_f32 %0, %1, %2" : "=v"(r) : "v"(lo), "v"(hi)); return r; }
__device__ __forceinline__ unsigned pk2s(float lo, float hi) { const f32x2 v = {lo, hi}; return __builtin_bit_cast(unsigned, __builtin_convertvector(v, bf16x2_t)); }
__device__ __forceinline__ float bflo(unsigned u) { return __uint_as_float(u << 16); }
__device__ __forceinline__ float bfhi(unsigned u) { return __uint_as_float(u & 0xffff0000u); }
__device__ __forceinline__ float bf1(bf16 b) { return __uint_as_float((unsigned)b << 16); }
__device__ __forceinline__ float fexp(float x) { return __builtin_amdgcn_exp2f(x * LOG2E); }
__device__ __forceinline__ float sigm(float x) { return __builtin_amdgcn_rcpf(1.f + fexp(-x)); }
__device__ __forceinline__ float ftanh(float x) { return 1.f - 2.f * __builtin_amdgcn_rcpf(1.f + fexp(2.f * x)); }
__device__ __forceinline__ float wave_sum(float v) {
#pragma unroll
    for (int o = 1; o < 64; o <<= 1) v += __shfl_xor(v, o);
    return v;
}
template <int CTRL> __device__ __forceinline__ float dppf(float x) { return __int_as_float(__builtin_amdgcn_update_dpp(0, __float_as_int(x), CTRL, 0xf, 0xf, true)); }
__device__ __forceinline__ float red8(float x) { x += dppf<0xB1>(x); x += dppf<0x4E>(x); x += dppf<0x141>(x); return x; }
__device__ __forceinline__ int crow(int r, int hi) { return (r & 3) + 8 * (r >> 2) + 4 * hi; }

struct Frame {
    LAS unsigned char* lds;
    int tid, lane, wave, G, bid;
    const float* in[32]; float* out; unsigned char* ws;
};

__device__ __forceinline__ void tr_item(const float* W, int ldn, int nblk, bf16* WT, int ldk, LAS float* scr, int item, int lane, const float* ksc = nullptr) {
    const int kb = item / nblk, nb = item % nblk, k0 = 64 * kb, n0 = 32 * nb;
#pragma unroll 8
    for (int i = 0; i < 32; ++i) { const int kk = 2 * i + (lane >> 5); float w_ = __builtin_nontemporal_load(&W[(size_t)(k0 + kk) * ldn + n0 + (lane & 31)]); if (ksc) w_ *= ksc[k0 + kk]; scr[kk * 33 + (lane & 31)] = w_; }
    asm volatile("s_waitcnt lgkmcnt(0)" ::: "memory");
    const int c = lane & 7;
#pragma unroll
    for (int j = 0; j < 4; ++j) { const int n = (lane >> 3) + 8 * j; const LAS float* s = scr + (8 * c) * 33 + n;
        v4u o; o.x = pk2(s[0 * 33], s[1 * 33]); o.y = pk2(s[2 * 33], s[3 * 33]); o.z = pk2(s[4 * 33], s[5 * 33]); o.w = pk2(s[6 * 33], s[7 * 33]);
        *(v4u*)(WT + (size_t)(n0 + n) * ldk + k0 + 8 * c) = o; }
    asm volatile("s_waitcnt lgkmcnt(0)" ::: "memory");
}
__device__ __forceinline__ void rms_row(const float* xrow, const float* g, bf16* orow, int lane) {
    const f32x4* xr = (const f32x4*)xrow + lane; const f32x4* gr = (const f32x4*)g + lane;
    f32x4 v[4]; float s = 0.f;
#pragma unroll
    for (int j = 0; j < 4; ++j) { v[j] = __builtin_nontemporal_load(&xr[64 * j]); s += (v[j].x * v[j].x + v[j].y * v[j].y) + (v[j].z * v[j].z + v[j].w * v[j].w); }
    const float rstd = 1.f / sqrtf(wave_sum(s) * (1.f / 1024.f) + 1e-6f);
    v2u* o8 = (v2u*)orow + lane;
#pragma unroll
    for (int j = 0; j < 4; ++j) { const f32x4 gg = gr[64 * j]; v2u o; o.x = pk2(v[j].x * rstd * gg.x, v[j].y * rstd * gg.y); o.y = pk2(v[j].z * rstd * gg.z, v[j].w * rstd * gg.w); o8[64 * j] = o; }
}
__device__ __forceinline__ void zero_fill(Frame& F, bf16* p, int rows, int cols, int ld) {
    const int cpr = cols / 8, n = rows * cpr;
    for (int i = F.bid * 512 + F.tid; i < n; i += F.G * 512) { const int r = i / cpr, c = i % cpr; *(v4u*)(p + (size_t)r * ld + 8 * c) = (v4u){0u, 0u, 0u, 0u}; }
}
__device__ __forceinline__ void p0_prologue(Frame& F) {
    LAS float* scr = (LAS float*)(F.lds + F.wave * 16384);
    const int gw = F.bid * 8 + F.wave, NGW = F.G * 8;
    unsigned char* ws = F.ws;
    bf16* WIN = (bf16*)(ws + WS_WIN);
    constexpr int J0 = 16 * 13, J1 = J0 + 16 * 62, J2 = J1 + 16 * 64, J3 = J2 + 4 * 24, J4 = J3 + 2 * 32, J5 = J4 + 16, J6 = J5 + 16, J7 = J6 + 16, J8 = J7 + 32, J9 = J8 + 32,
                  J10 = J9 + 512, J11 = J10 + 512, J12 = J11 + 1408, J13 = J12 + 1408, J14 = J13 + 1408;
    for (int it = gw; it < J14; it += NGW) {
        if (it < J0) tr_item(F.in[3], 4448, 13, WIN + (size_t)4096 * 1024, 1024, scr, it, F.lane);
        else if (it < J1) tr_item(F.in[3] + 416, 4448, 62, WIN + (size_t)2048 * 1024, 1024, scr, it - J0, F.lane);
        else if (it < J2) tr_item(F.in[3] + 2400, 4448, 64, WIN, 1024, scr, it - J1, F.lane);
        else if (it < J3) tr_item(F.in[7], 768, 24, (bf16*)(ws + WS_WUQ), 256, scr, it - J2, F.lane);
        else if (it < J4) tr_item(F.in[8], 1024, 32, (bf16*)(ws + WS_WUKV), 128, scr, it - J3, F.lane);
        else if (it < J5) tr_item(F.in[17], 512, 16, (bf16*)(ws + WS_WL1), 128, scr, it - J4, F.lane);
        else if (it < J6) tr_item(F.in[15], 512, 16, (bf16*)(ws + WS_WL1) + 512 * 128 + 64, 128, scr, it - J5, F.lane);
        else if (it < J7) tr_item(F.in[15] + 64 * 512, 512, 16, (bf16*)(ws + WS_WL2), 128, scr, it - J6, F.lane);
        else if (it < J8) tr_item(F.in[18], 512, 16, (bf16*)(ws + WS_WGF), 128, scr, it - J7, F.lane);
        else if (it < J9) tr_item(F.in[18] + 128 * 512, 512, 16, (bf16*)(ws + WS_WGB), 128, scr, it - J8, F.lane);
        else if (it < J10) tr_item(F.in[24], 1024, 32, (bf16*)(ws + WS_WO), 1024, scr, it - J9, F.lane);
        else if (it < J11) tr_item(F.in[25], 1024, 32, (bf16*)(ws + WS_WM), 1024, scr, it - J10, F.lane);
        else if (it < J12) tr_item(F.in[27], 2816, 88, (bf16*)(ws + WS_WGU), 1024, scr, it - J11, F.lane, F.in[26]);
        else if (it < J13) tr_item(F.in[28], 2816, 88, (bf16*)(ws + WS_WGU) + (size_t)2816 * 1024, 1024, scr, it - J12, F.lane, F.in[26]);
        else tr_item(F.in[31], 1024, 32, (bf16*)(ws + WS_WD), 2816, scr, it - J13, F.lane);
    }
    zero_fill(F, WIN + (size_t)4032 * 1024, 64, 1024, 1024);
    zero_fill(F, WIN + (size_t)4512 * 1024, 96, 1024, 1024);
    zero_fill(F, (bf16*)(ws + WS_WL1) + 64, 512, 64, 128);
    zero_fill(F, (bf16*)(ws + WS_WL1) + 512 * 128, 512, 64, 128);
    zero_fill(F, (bf16*)(ws + WS_WL2) + 64, 512, 64, 128);
    for (int i = F.bid * 512 + F.tid; i < NTOK; i += F.G * 512) ((float*)(ws + WS_RSQ))[i] = 0.f;
    for (int m = gw; m < NTOK; m += NGW) rms_row(F.in[0] + (size_t)m * DM, F.in[2], (bf16*)(ws + WS_XN) + (size_t)m * DM, F.lane);
}

template <class Fn> struct Epi8 {
    static constexpr bool PERM = true, AFTER_DRAIN = false; Fn f;
    __device__ __forceinline__ void operator()(const pg8::f32x4 (&acc)[2][2][4][2], const pg8::Unit& u, int wr, int wc, int fr, int fq) const {
#pragma unroll
        for (int ai = 0; ai < 2; ++ai)
#pragma unroll
            for (int m = 0; m < 4; ++m)
#pragma unroll
                for (int bj = 0; bj < 2; ++bj) f(u.pm * 256 + ai * 128 + wr * 64 + m * 16 + fr, u.pn * 256 + bj * 128 + wc * 32 + 8 * fq, acc[ai][bj][m][0], acc[ai][bj][m][1]);
    }
};
__device__ __forceinline__ v4u pack8(f32x4 a, f32x4 b) { v4u w; w.x = pk2(a[0], a[1]); w.y = pk2(a[2], a[3]); w.z = pk2(b[0], b[1]); w.w = pk2(b[2], b[3]); return w; }
__device__ __forceinline__ v4u pack8s(f32x4 a, f32x4 b) { v4u w; w.x = pk2s(a[0], a[1]); w.y = pk2s(a[2], a[3]); w.z = pk2s(b[0], b[1]); w.w = pk2s(b[2], b[3]); return w; }
__device__ __forceinline__ void unpack8(v4u w, f32x4& a, f32x4& b) { a = (f32x4){bflo(w.x), bfhi(w.x), bflo(w.y), bfhi(w.y)}; b = (f32x4){bflo(w.z), bfhi(w.z), bflo(w.w), bfhi(w.w)}; }

struct FnIn {
    bf16* PG; bf16* PR; bf16* PM; const float* bg;
    __device__ __forceinline__ void operator()(int row, int col, f32x4 a, f32x4 b) const {
        if (col < 2048) { const f32x4 b0 = *(const f32x4*)(bg + col), b1 = *(const f32x4*)(bg + col + 4);
#pragma unroll
            for (int i = 0; i < 4; ++i) { a[i] = sigm(a[i] + b0[i]); b[i] = sigm(b[i] + b1[i]); }
            *(v4u*)(PG + (size_t)row * 2048 + col) = pack8(a, b); }
        else if (col < 4096) *(v4u*)(PR + (size_t)row * 2048 + (col - 2048)) = pack8(a, b);
        else *(v4u*)(PM + (size_t)row * 512 + (col - 4096)) = pack8(a, b);
    }
};
__device__ __forceinline__ float logdecay(float z) {
    const float x = -z, sp = fmaxf(x, 0.f) + __builtin_amdgcn_logf(1.f + fexp(-fabsf(x))) * 0.6931471805599453f;
    return -fexp(-sp - 0.5f);
}
struct FnLora1 {
    bf16* ASIG; bf16* DEC; const float* a0; const float* w0;
    __device__ __forceinline__ void operator()(int row, int col, f32x4 a, f32x4 b) const {
        if (col < 512) { const f32x4 b0 = *(const f32x4*)(a0 + col), b1 = *(const f32x4*)(a0 + col + 4);
#pragma unroll
            for (int i = 0; i < 4; ++i) { a[i] = sigm(a[i] + b0[i]); b[i] = sigm(b[i] + b1[i]); }
            *(v4u*)(ASIG + (size_t)row * 512 + col) = pack8(a, b); }
        else { const int c = col - 512; const f32x4 b0 = *(const f32x4*)(w0 + c), b1 = *(const f32x4*)(w0 + c + 4);
#pragma unroll
            for (int i = 0; i < 4; ++i) { a[i] = logdecay(a[i] + b0[i]); b[i] = logdecay(b[i] + b1[i]); }
            *(v4u*)(DEC + (size_t)row * 512 + c) = pack8(a, b); }
    }
};
struct FnLora2 {
    bf16* DEC; const float* w0;
    __device__ __forceinline__ void operator()(int row, int col, f32x4 a, f32x4 b) const {
        const f32x4 b0 = *(const f32x4*)(w0 + col), b1 = *(const f32x4*)(w0 + col + 4);
#pragma unroll
        for (int i = 0; i < 4; ++i) { a[i] = logdecay(a[i] + b0[i]); b[i] = logdecay(b[i] + b1[i]); }
        *(v4u*)(DEC + (size_t)row * 512 + col) = pack8(a, b);
    }
};
template <int ACC> struct FnMulAcc {
    bf16* O; int ldo; const bf16* S; int lds_; int soff;
    __device__ __forceinline__ void operator()(int row, int col, f32x4 a, f32x4 b) const {
        f32x4 s0, s1; unpack8(*(const v4u*)(S + (size_t)row * lds_ + soff + col), s0, s1);
        a = a * s0; b = b * s1;
        if (ACC) { f32x4 o0, o1; unpack8(*(const v4u*)(O + (size_t)row * ldo + col), o0, o1); a = a + o0; b = b + o1; }
        *(v4u*)(O + (size_t)row * ldo + col) = pack8(a, b);
    }
};
struct FnResid {
    const float* base; float* out;
    __device__ __forceinline__ void operator()(int row, int col, f32x4 a, f32x4 b) const {
        const size_t o = (size_t)row * 1024 + col; const f32x4 x0 = *(const f32x4*)(base + o), x1 = *(const f32x4*)(base + o + 4);
        *(f32x4*)(out + o) = x0 + a; *(f32x4*)(out + o + 4) = x1 + b;
    }
};
struct FnStore {
    bf16* O; int ldo;
    __device__ __forceinline__ void operator()(int row, int col, f32x4 a, f32x4 b) const { *(v4u*)(O + (size_t)row * ldo + col) = pack8(a, b); }
};
struct FnResidNorm {
    const float* base; float* out; bf16* XB; float* rsq;
    __device__ __forceinline__ void operator()(int row, int col, f32x4 a, f32x4 b) const {
        const size_t o = (size_t)row * 1024 + col; const f32x4 x0 = *(const f32x4*)(base + o) + a, x1 = *(const f32x4*)(base + o + 4) + b;
        *(v4u*)(XB + o) = pack8(x0, x1);
        float ss = (x0[0] * x0[0] + x0[1] * x0[1]) + (x0[2] * x0[2] + x0[3] * x0[3]) + (x1[0] * x1[0] + x1[1] * x1[1]) + (x1[2] * x1[2] + x1[3] * x1[3]);
        ss += __shfl_xor(ss, 16); ss += __shfl_xor(ss, 32);
        if (((col >> 3) & 3) == 0) atomicAdd(rsq + row, ss);
    }
};
struct FnResidBf {
    const bf16* XB; float* out;
    __device__ __forceinline__ void operator()(int row, int col, f32x4 a, f32x4 b) const {
        const size_t o = (size_t)row * 1024 + col; f32x4 x0, x1; unpack8(*(const v4u*)(XB + o), x0, x1);
        *(f32x4*)(out + o) = x0 + a; *(f32x4*)(out + o + 4) = x1 + b;
    }
};
struct FnStoreScaled {
    bf16* O; int ldo; const float* rsq;
    __device__ __forceinline__ void operator()(int row, int col, f32x4 a, f32x4 b) const { const float rs = __builtin_amdgcn_rsqf(rsq[row] * (1.f / 1024.f) + 1e-6f); *(v4u*)(O + (size_t)row * ldo + col) = pack8(a * rs, b * rs); }
};
struct FnConvAct {
    const bf16* G; bf16* ACT; const float* cw; const float* cb; const float* rsq;
    __device__ __forceinline__ void operator()(int row, int col, f32x4 a, f32x4 b) const {
        { const float rs = __builtin_amdgcn_rsqf(rsq[row] * (1.f / 1024.f) + 1e-6f); a = a * rs; b = b * rs; }
        const int s = row & (SEQ - 1); const bf16* g = G + (size_t)row * 2816 + col;
        f32x4 c0, c1, p0 = {0.f, 0.f, 0.f, 0.f}, p1 = p0, n0 = p0, n1 = p0;
        unpack8(*(const v4u*)g, c0, c1);
        if (s > 0) unpack8(*(const v4u*)(g - 2816), p0, p1);
        if (s < SEQ - 1) unpack8(*(const v4u*)(g + 2816), n0, n1);
        const f32x4 wa0 = *(const f32x4*)(cw + col), wa1 = *(const f32x4*)(cw + col + 4), wb0 = *(const f32x4*)(cw + 2816 + col), wb1 = *(const f32x4*)(cw + 2816 + col + 4),
                    wc0 = *(const f32x4*)(cw + 5632 + col), wc1 = *(const f32x4*)(cw + 5632 + col + 4), bb0 = *(const f32x4*)(cb + col), bb1 = *(const f32x4*)(cb + col + 4);
        f32x4 g0 = p0 * wa0 + c0 * wb0 + n0 * wc0 + bb0, g1 = p1 * wa1 + c1 * wb1 + n1 * wc1 + bb1;
#pragma unroll
        for (int i = 0; i < 4; ++i) { g0[i] = g0[i] * sigm(g0[i]) * a[i]; g1[i] = g1[i] * sigm(g1[i]) * b[i]; }
        *(v4u*)(ACT + (size_t)row * 2816 + col) = pack8(g0, g1);
    }
};
template <class Fn> __device__ __forceinline__ void run_gemm(Frame& F, const bf16* A, int lda, const bf16* Bt, int ldb, int N, int K, const Fn& fn) {
    asm volatile("" : "+s"(K));
    pg8::Gemm g{A, Bt, NTOK, N, K, lda, ldb}; pg8::StaticOrder S; S.init(NTOK, N, F.G, F.bid);
    Epi8<Fn> E{fn};
    pg8::gemm_phase<Epi8<Fn>, pg8::StaticOrder, true, true>(F.lds, g, S, E);
}

__device__ __forceinline__ void p2_shift(Frame& F) {
    const bf16* PR = (const bf16*)(F.ws + WS_PR); bf16* RKV = (bf16*)(F.ws + WS_RKV); bf16* LI = (bf16*)(F.ws + WS_LI); bf16* SG = (bf16*)(F.ws + WS_SG);
    const float* mu = F.in[13];
    for (int idx = F.bid * 512 + F.tid; idx < NTOK * 256; idx += F.G * 512) {
        const int m = idx >> 8, ch = idx & 255, s = m & (SEQ - 1), c = ch * 8;
        if (ch >= 248) { *(v4u*)(LI + (size_t)m * 256 + 192 + (ch - 248) * 8) = (v4u){0u, 0u, 0u, 0u}; continue; }
        const bf16* p = PR + (size_t)m * 2048 + c;
        f32x4 c0, c1, p0 = {0.f, 0.f, 0.f, 0.f}, p1 = p0, n0 = p0, n1 = p0;
        unpack8(*(const v4u*)p, c0, c1);
        if (s > 0) unpack8(*(const v4u*)(p - 2048), p0, p1);
        if (s < SEQ - 1) unpack8(*(const v4u*)(p + 2048), n0, n1);
        const f32x4 mp0 = *(const f32x4*)(mu + c), mp1 = *(const f32x4*)(mu + c + 4), mn0 = *(const f32x4*)(mu + 1984 + c), mn1 = *(const f32x4*)(mu + 1984 + c + 4);
        f32x4 u0 = c0 + mp0 * (p0 - c0) + mn0 * (n0 - c0), u1 = c1 + mp1 * (p1 - c1) + mn1 * (n1 - c1);
        if (c < 1536) *(v4u*)(RKV + (size_t)m * 1536 + c) = pack8(u0, u1);
        else if (c < 1600) *(v4u*)(LI + (size_t)m * 256 + (c - 1536)) = pack8(u0, u1);
        else if (c < 1728) {
#pragma unroll
            for (int i = 0; i < 4; ++i) { u0[i] = ftanh(u0[i]); u1[i] = ftanh(u1[i]); }
            *(v4u*)(LI + (size_t)m * 256 + 64 + (c - 1600)) = pack8(u0, u1); }
        else {
#pragma unroll
            for (int i = 0; i < 4; ++i) { u0[i] = sigm(u0[i]); u1[i] = sigm(u1[i]); }
            *(v4u*)(SG + (size_t)m * 256 + (c - 1728)) = pack8(u0, u1); }
    }
}

__device__ __forceinline__ void p5_gn(Frame& F) {
    const bf16* RKV = (const bf16*)(F.ws + WS_RKV); const bf16* ASIG = (const bf16*)(F.ws + WS_ASIG); bf16* OF = (bf16*)(F.ws + WS_OF); bf16* OB = (bf16*)(F.ws + WS_OB);
    const float *k_a = F.in[20], *r_k = F.in[21], *lng = F.in[22], *lnb = F.in[23];
    for (int idx = F.bid * 512 + F.tid; idx < NTOK * 64; idx += F.G * 512) {
        const int m = idx >> 6, c = (idx & 63) * 8;
        float r[8], k[8], v[8], a[8], of[8], ob[8];
        { f32x4 x0, x1; unpack8(*(const v4u*)(RKV + (size_t)m * 1536 + c), x0, x1); for (int i = 0; i < 4; ++i) { r[i] = x0[i]; r[4 + i] = x1[i]; }
          unpack8(*(const v4u*)(RKV + (size_t)m * 1536 + 512 + c), x0, x1); for (int i = 0; i < 4; ++i) { k[i] = x0[i]; k[4 + i] = x1[i]; }
          unpack8(*(const v4u*)(RKV + (size_t)m * 1536 + 1024 + c), x0, x1); for (int i = 0; i < 4; ++i) { v[i] = x0[i]; v[4 + i] = x1[i]; }
          unpack8(*(const v4u*)(ASIG + (size_t)m * 512 + c), x0, x1); for (int i = 0; i < 4; ++i) { a[i] = x0[i]; a[4 + i] = x1[i]; }
          unpack8(*(const v4u*)(OF + (size_t)m * 512 + c), x0, x1); for (int i = 0; i < 4; ++i) { of[i] = x0[i]; of[4 + i] = x1[i]; }
          unpack8(*(const v4u*)(OB + (size_t)m * 512 + c), x0, x1); for (int i = 0; i < 4; ++i) { ob[i] = x0[i]; ob[4 + i] = x1[i]; } }
        float bs = 0.f, sf = 0.f, sb = 0.f;
#pragma unroll
        for (int i = 0; i < 8; ++i) { const float kp = k[i] * (1.f + (a[i] - 1.f) * k_a[c + i]); bs += r[i] * kp * r_k[c + i]; sf += of[i]; sb += ob[i]; }
        bs = red8(bs); const float muf = red8(sf) * (1.f / 64.f), mub = red8(sb) * (1.f / 64.f);
        float qf = 0.f, qb = 0.f;
#pragma unroll
        for (int i = 0; i < 8; ++i) { of[i] -= muf; ob[i] -= mub; qf += of[i] * of[i]; qb += ob[i] * ob[i]; }
        const float rf = __builtin_amdgcn_rsqf(red8(qf) * (1.f / 64.f) + 64e-5f), rb = __builtin_amdgcn_rsqf(red8(qb) * (1.f / 64.f) + 64e-5f);
        f32x4 o0, o1, o2, o3;
#pragma unroll
        for (int i = 0; i < 4; ++i) {
            o0[i] = of[i] * rf * lng[c + i] + lnb[c + i] + bs * v[i];             o1[i] = of[4 + i] * rf * lng[c + 4 + i] + lnb[c + 4 + i] + bs * v[4 + i];
            o2[i] = ob[i] * rb * lng[c + i] + lnb[c + i] + bs * v[i];             o3[i] = ob[4 + i] * rb * lng[c + 4 + i] + lnb[c + 4 + i] + bs * v[4 + i]; }
        *(v4u*)(OF + (size_t)m * 512 + c) = pack8(o0, o1); *(v4u*)(OB + (size_t)m * 512 + c) = pack8(o2, o3);
    }
}

__device__ __forceinline__ void p11_conv(Frame& F) {
    bf16* GU = (bf16*)(F.ws + WS_GU); const float* cw = F.in[29]; const float* cb = F.in[30];
    for (int idx = F.bid * 512 + F.tid; idx < NTOK * 352; idx += F.G * 512) {
        const int m = idx / 352, c = (idx - m * 352) * 8, s = m & (SEQ - 1);
        bf16* g = GU + (size_t)m * 5632 + c;
        f32x4 c0, c1, p0 = {0.f, 0.f, 0.f, 0.f}, p1 = p0, n0 = p0, n1 = p0, u0, u1;
        unpack8(*(const v4u*)g, c0, c1); unpack8(*(const v4u*)(g + 2816), u0, u1);
        if (s > 0) unpack8(*(const v4u*)(g - 5632), p0, p1);
        if (s < SEQ - 1) unpack8(*(const v4u*)(g + 5632), n0, n1);
        const f32x4 wa0 = *(const f32x4*)(cw + c), wa1 = *(const f32x4*)(cw + c + 4), wb0 = *(const f32x4*)(cw + 2816 + c), wb1 = *(const f32x4*)(cw + 2816 + c + 4),
                    wc0 = *(const f32x4*)(cw + 5632 + c), wc1 = *(const f32x4*)(cw + 5632 + c + 4), bb0 = *(const f32x4*)(cb + c), bb1 = *(const f32x4*)(cb + c + 4);
        f32x4 g0 = p0 * wa0 + c0 * wb0 + n0 * wc0 + bb0, g1 = p1 * wa1 + c1 * wb1 + n1 * wc1 + bb1;
#pragma unroll
        for (int i = 0; i < 4; ++i) { g0[i] = g0[i] * sigm(g0[i]) * u0[i]; g1[i] = g1[i] * sigm(g1[i]) * u1[i]; }
        *(v4u*)(g + 2816) = pack8(g0, g1);
    }
}

#define MFMA32(a, b, c) __builtin_amdgcn_mfma_f32_32x32x16_bf16((a), (b), (c), 0, 0, 0)
__device__ __forceinline__ float ssq8(v4u w) { float a0 = bflo(w.x), a1 = bfhi(w.x), a2 = bflo(w.y), a3 = bfhi(w.y), a4 = bflo(w.z), a5 = bfhi(w.z), a6 = bflo(w.w), a7 = bfhi(w.w);
    return (a0 * a0 + a1 * a1) + (a2 * a2 + a3 * a3) + (a4 * a4 + a5 * a5) + (a6 * a6 + a7 * a7); }
__device__ __forceinline__ v4u scale8(v4u w, float rs, const float* g) { const f32x4 g0 = *(const f32x4*)g, g1 = *(const f32x4*)(g + 4); v4u o;
    o.x = pk2(bflo(w.x) * rs * g0[0], bfhi(w.x) * rs * g0[1]); o.y = pk2(bflo(w.y) * rs * g0[2], bfhi(w.y) * rs * g0[3]);
    o.z = pk2(bflo(w.z) * rs * g1[0], bfhi(w.z) * rs * g1[1]); o.w = pk2(bflo(w.w) * rs * g1[2], bfhi(w.w) * rs * g1[3]); return o; }
__device__ __forceinline__ float rope_inv_freq(int e, int hi) {
    constexpr float T[16] = {1.000000000e+00f, 5.623413324e-01f, 3.162277639e-01f, 1.778279394e-01f, 1.000000015e-01f, 5.623413250e-02f, 3.162277490e-02f, 1.778279431e-02f,
                             9.999999776e-03f, 5.623413250e-03f, 3.162277630e-03f, 1.778279431e-03f, 1.000000047e-03f, 5.623413017e-04f, 3.162277571e-04f, 1.778279402e-04f};
    const int i0 = (e & 3) + 8 * (e >> 2); return hi ? T[i0 + 4] : T[i0]; }
__device__ __forceinline__ void mla_item(Frame& F, int item) {
    const int tile = item >> 1, hg = item & 1, lane = F.lane, r32 = lane & 31, hi = lane >> 5;
    const int m = tile * 256 + F.wave * 32 + r32, b = m >> 12, s = m & (SEQ - 1);
    const bf16* PM = (const bf16*)(F.ws + WS_PM) + (size_t)m * 512;
    bf16* Qo = (bf16*)(F.ws + WS_Q); bf16* Ko = (bf16*)(F.ws + WS_K); bf16* VTo = (bf16*)(F.ws + WS_VT);
    v4u cq[16], ckv[8];
    float sq = 0.f, skv = 0.f;
#pragma unroll
    for (int i = 0; i < 16; ++i) { cq[i] = *(const v4u*)(PM + 16 * i + 8 * hi); sq += ssq8(cq[i]); }
#pragma unroll
    for (int i = 0; i < 8; ++i) { ckv[i] = *(const v4u*)(PM + 256 + 16 * i + 8 * hi); skv += ssq8(ckv[i]); }
    sq += __shfl_xor(sq, 32); skv += __shfl_xor(skv, 32);
    const float rq = 1.f / sqrtf(sq * (1.f / 256.f) + 1e-6f), rkv = 1.f / sqrtf(skv * (1.f / 128.f) + 1e-6f);
#pragma unroll
    for (int i = 0; i < 16; ++i) cq[i] = scale8(cq[i], rq, F.in[5] + 16 * i + 8 * hi);
#pragma unroll
    for (int i = 0; i < 8; ++i) ckv[i] = scale8(ckv[i], rkv, F.in[6] + 16 * i + 8 * hi);
    float cs[8], sn[8];
    { const float pos = (float)((const int*)F.in[1])[m];
#pragma unroll
      for (int e = 0; e < 8; ++e) { const float inv = rope_inv_freq(e, hi); const float ang = pos * inv;
          const float kq = rintf(ang * 0.15915494309189535f); float rr = fmaf(-kq, 6.28125f, ang); rr = fmaf(-kq, 1.9353071795864769e-3f, rr);
          rr *= 0.15915494309189535f; sn[e] = __builtin_amdgcn_sinf(rr); cs[e] = __builtin_amdgcn_cosf(rr); } }
    { float t1[8], t2[8];
      const v2u a0 = *(const v2u*)(PM + 384 + 4 * hi), a1 = *(const v2u*)(PM + 384 + 8 + 4 * hi), b0 = *(const v2u*)(PM + 384 + 16 + 4 * hi), b1 = *(const v2u*)(PM + 384 + 24 + 4 * hi);
      t1[0] = bflo(a0.x); t1[1] = bfhi(a0.x); t1[2] = bflo(a0.y); t1[3] = bfhi(a0.y); t1[4] = bflo(a1.x); t1[5] = bfhi(a1.x); t1[6] = bflo(a1.y); t1[7] = bfhi(a1.y);
      t2[0] = bflo(b0.x); t2[1] = bfhi(b0.x); t2[2] = bflo(b0.y); t2[3] = bfhi(b0.y); t2[4] = bflo(b1.x); t2[5] = bfhi(b1.x); t2[6] = bflo(b1.y); t2[7] = bfhi(b1.y);
      float ss = 0.f;
#pragma unroll
      for (int e = 0; e < 8; ++e) ss += t1[e] * t1[e] + t2[e] * t2[e];
      ss += __shfl_xor(ss, 32);
      const float rs = 1.f / sqrtf(ss * (1.f / 32.f) + 1e-6f);
      float o1[8], o2[8];
#pragma unroll
      for (int e = 0; e < 8; ++e) { const int i = crow(e, hi); const float x1 = t1[e] * rs * F.in[12][i], x2 = t2[e] * rs * F.in[12][i + 16]; o1[e] = x1 * cs[e] - x2 * sn[e]; o2[e] = x2 * cs[e] + x1 * sn[e]; }
#pragma unroll
      for (int hh = 0; hh < 4; ++hh) { bf16* kp = Ko + ((size_t)(b * 8 + hg * 4 + hh) * SEQ + s) * 96 + 64;
          *(v2u*)(kp + 4 * hi) = (v2u){pk2s(o1[0], o1[1]), pk2s(o1[2], o1[3])}; *(v2u*)(kp + 8 + 4 * hi) = (v2u){pk2s(o1[4], o1[5]), pk2s(o1[6], o1[7])};
          *(v2u*)(kp + 16 + 4 * hi) = (v2u){pk2s(o2[0], o2[1]), pk2s(o2[2], o2[3])}; *(v2u*)(kp + 24 + 4 * hi) = (v2u){pk2s(o2[4], o2[5]), pk2s(o2[6], o2[7])}; } }
    const bf16* WUQ = (const bf16*)(F.ws + WS_WUQ); const bf16* WUKV = (const bf16*)(F.ws + WS_WUKV);
    LAS unsigned char* lq = F.lds; LAS unsigned char* lkv = F.lds + 96 * 528;
    for (int hh = 0; hh < 4; ++hh) {
        const int h = hg * 4 + hh;
        __syncthreads();
        { const v4u* src = (const v4u*)(WUQ + (size_t)h * 96 * 256);
#pragma unroll
          for (int j = 0; j < 6; ++j) { const int i = j * 512 + F.tid; *(LAS v4u*)(lq + (i >> 5) * 528 + (i & 31) * 16) = src[i]; }
          const v4u* src2 = (const v4u*)(WUKV + (size_t)h * 128 * 128);
#pragma unroll
          for (int j = 0; j < 4; ++j) { const int i = j * 512 + F.tid; *(LAS v4u*)(lkv + (i >> 4) * 272 + (i & 15) * 16) = src2[i]; } }
        __syncthreads();
        const size_t rowq = ((size_t)(b * 8 + h) * SEQ + s) * 96;
        f32x16 qa[3];
#pragma unroll
        for (int j = 0; j < 3; ++j) { qa[j] = (f32x16){};
#pragma unroll
            for (int i = 0; i < 16; ++i) { const bf16x8 a = *(const LAS bf16x8*)(lq + (32 * j + r32) * 528 + 32 * i + 16 * hi); qa[j] = MFMA32(a, __builtin_bit_cast(bf16x8, cq[i]), qa[j]); } }
        { float ss = 0.f;
#pragma unroll
          for (int r = 0; r < 16; ++r) ss += qa[0][r] * qa[0][r] + qa[1][r] * qa[1][r];
          ss += __shfl_xor(ss, 32);
          const float rs = QSCALE / sqrtf(ss * (1.f / 64.f) + 1e-6f);
#pragma unroll
          for (int j = 0; j < 2; ++j)
#pragma unroll
              for (int g4 = 0; g4 < 4; ++g4) { const int col = 32 * j + 8 * g4 + 4 * hi; const f32x4 gg = *(const f32x4*)(F.in[9] + col);
                  *(v2u*)(Qo + rowq + col) = (v2u){pk2s(qa[j][4 * g4] * rs * gg[0], qa[j][4 * g4 + 1] * rs * gg[1]), pk2s(qa[j][4 * g4 + 2] * rs * gg[2], qa[j][4 * g4 + 3] * rs * gg[3])}; }
          float s2 = 0.f;
#pragma unroll
          for (int r = 0; r < 16; ++r) s2 += qa[2][r] * qa[2][r];
          s2 += __shfl_xor(s2, 32);
          const float r2 = 1.f / sqrtf(s2 * (1.f / 32.f) + 1e-6f);
          float o1[8], o2[8];
#pragma unroll
          for (int e = 0; e < 8; ++e) { const int i = crow(e, hi); const float x1 = qa[2][e] * r2 * F.in[10][i], x2 = qa[2][e + 8] * r2 * F.in[10][i + 16];
              o1[e] = (x1 * cs[e] - x2 * sn[e]) * QSCALE; o2[e] = (x2 * cs[e] + x1 * sn[e]) * QSCALE; }
          bf16* qp = Qo + rowq + 64;
          *(v2u*)(qp + 4 * hi) = (v2u){pk2s(o1[0], o1[1]), pk2s(o1[2], o1[3])}; *(v2u*)(qp + 8 + 4 * hi) = (v2u){pk2s(o1[4], o1[5]), pk2s(o1[6], o1[7])};
          *(v2u*)(qp + 16 + 4 * hi) = (v2u){pk2s(o2[0], o2[1]), pk2s(o2[2], o2[3])}; *(v2u*)(qp + 24 + 4 * hi) = (v2u){pk2s(o2[4], o2[5]), pk2s(o2[6], o2[7])}; }
        f32x16 ka[2];
#pragma unroll
        for (int j = 0; j < 2; ++j) { ka[j] = (f32x16){};
#pragma unroll
            for (int i = 0; i < 8; ++i) { const bf16x8 a = *(const LAS bf16x8*)(lkv + (32 * j + r32) * 272 + 32 * i + 16 * hi); ka[j] = MFMA32(a, __builtin_bit_cast(bf16x8, ckv[i]), ka[j]); } }
        { float ss = 0.f;
#pragma unroll
          for (int r = 0; r < 16; ++r) ss += ka[0][r] * ka[0][r] + ka[1][r] * ka[1][r];
          ss += __shfl_xor(ss, 32);
          const float rs = 1.f / sqrtf(ss * (1.f / 64.f) + 1e-6f);
#pragma unroll
          for (int j = 0; j < 2; ++j)
#pragma unroll
              for (int g4 = 0; g4 < 4; ++g4) { const int col = 32 * j + 8 * g4 + 4 * hi; const f32x4 gg = *(const f32x4*)(F.in[11] + col);
                  *(v2u*)(Ko + rowq + col) = (v2u){pk2s(ka[j][4 * g4] * rs * gg[0], ka[j][4 * g4 + 1] * rs * gg[1]), pk2s(ka[j][4 * g4 + 2] * rs * gg[2], ka[j][4 * g4 + 3] * rs * gg[3])}; } }
#pragma unroll
        for (int j = 0; j < 2; ++j) { f32x16 va = (f32x16){};
#pragma unroll
            for (int i = 0; i < 8; ++i) { const bf16x8 a = *(const LAS bf16x8*)(lkv + (64 + 32 * j + r32) * 272 + 32 * i + 16 * hi); va = MFMA32(a, __builtin_bit_cast(bf16x8, ckv[i]), va); }
#pragma unroll
            for (int r = 0; r < 16; r += 2) { const unsigned w = pk2s(va[r], va[r + 1]); const int d = 32 * j + crow(r, hi);
                VTo[((size_t)(b * 8 + h) * 64 + d) * SEQ + s] = (bf16)(w & 0xffffu); VTo[((size_t)(b * 8 + h) * 64 + d + 1) * SEQ + s] = (bf16)(w >> 16); } }
    }
    __syncthreads();
}

constexpr int AK_STRIDE = 208, AV_STRIDE = 136, AK_BYTES = 64 * AK_STRIDE, AV_BYTES = 64 * AV_STRIDE, AV_OFF = 2 * AK_BYTES;
__device__ __forceinline__ void attn_unit(Frame& F, int bh, int qb) {
    const int tid = F.tid, lane = F.lane, wid = F.wave, r32 = lane & 31, hi = lane >> 5;
    const bf16* Qp = (const bf16*)(F.ws + WS_Q) + ((size_t)bh * SEQ + qb * 256 + wid * 32 + r32) * 96;
    const bf16* Kb = (const bf16*)(F.ws + WS_K) + (size_t)bh * SEQ * 96; const bf16* Vb = (const bf16*)(F.ws + WS_VT) + (size_t)bh * 64 * SEQ;
    LAS unsigned char* lds = F.lds;
    bf16x8 qf[6];
#pragma unroll
    for (int d0 = 0; d0 < 6; ++d0) qf[d0] = *(const bf16x8*)(Qp + 16 * d0 + 8 * hi);
    const int kl0 = (tid / 12) * AK_STRIDE + (tid % 12) * 16, i1 = 512 + tid, kl1 = (i1 / 12) * AK_STRIDE + (i1 % 12) * 16;
    const int vd = tid >> 3, vc = tid & 7, vl = AV_OFF + vd * AV_STRIDE + vc * 16;
    const v4u* kg = (const v4u*)Kb; const bf16* vg = Vb + (size_t)vd * SEQ + vc * 8;
    v4u sk0, sk1 = {0u, 0u, 0u, 0u}, sv;
    sk0 = kg[tid]; if (tid < 256) sk1 = kg[512 + tid]; sv = *(const v4u*)vg;
    __syncthreads();
    *(LAS v4u*)(lds + kl0) = sk0; if (tid < 256) *(LAS v4u*)(lds + kl1) = sk1;
    *(LAS v2u*)(lds + vl) = (v2u){sv.x, sv.y}; *(LAS v2u*)(lds + vl + 8) = (v2u){sv.z, sv.w};
    __syncthreads();
    float mrun = -1e30f, lrun = 0.f;
    f32x16 o0 = (f32x16){}, o1 = (f32x16){};
    for (int t = 0; t < 64; ++t) {
        const int cur = t & 1, nxt = cur ^ 1;
        if (t + 1 < 64) { const v4u* kgn = kg + (size_t)(t + 1) * 768; sk0 = kgn[tid]; if (tid < 256) sk1 = kgn[512 + tid]; sv = *(const v4u*)(vg + (t + 1) * 64); }
        const LAS unsigned char* kb_ = lds + cur * AK_BYTES; const LAS unsigned char* vb_ = lds + AV_OFF + cur * AV_BYTES;
        f32x16 p0 = (f32x16){}, p1 = (f32x16){};
#pragma unroll
        for (int d0 = 0; d0 < 6; ++d0) {
            const bf16x8 a0 = *(const LAS bf16x8*)(kb_ + r32 * AK_STRIDE + 32 * d0 + 16 * hi), a1 = *(const LAS bf16x8*)(kb_ + (32 + r32) * AK_STRIDE + 32 * d0 + 16 * hi);
            p0 = MFMA32(a0, qf[d0], p0); p1 = MFMA32(a1, qf[d0], p1); }
        float mx = fmaxf(p0[0], p1[0]);
#pragma unroll
        for (int r = 1; r < 16; ++r) mx = fmaxf(mx, fmaxf(p0[r], p1[r]));
        mx = fmaxf(mx, __shfl_xor(mx, 32));
        const float mnew = fmaxf(mrun, mx), alpha = __builtin_amdgcn_exp2f(mrun - mnew);
        mrun = mnew;
        float ls = 0.f;
#pragma unroll
        for (int r = 0; r < 16; ++r) { p0[r] = __builtin_amdgcn_exp2f(p0[r] - mnew); p1[r] = __builtin_amdgcn_exp2f(p1[r] - mnew); ls += p0[r] + p1[r]; }
        lrun = lrun * alpha + ls;
#pragma unroll
        for (int r = 0; r < 16; ++r) { o0[r] *= alpha; o1[r] *= alpha; }
        v4u pb[4];
        pb[0] = (v4u){pk2(p0[0], p0[1]), pk2(p0[2], p0[3]), pk2(p0[4], p0[5]), pk2(p0[6], p0[7])};
        pb[1] = (v4u){pk2(p0[8], p0[9]), pk2(p0[10], p0[11]), pk2(p0[12], p0[13]), pk2(p0[14], p0[15])};
        pb[2] = (v4u){pk2(p1[0], p1[1]), pk2(p1[2], p1[3]), pk2(p1[4], p1[5]), pk2(p1[6], p1[7])};
        pb[3] = (v4u){pk2(p1[8], p1[9]), pk2(p1[10], p1[11]), pk2(p1[12], p1[13]), pk2(p1[14], p1[15])};
#pragma unroll
        for (int sl = 0; sl < 4; ++sl) {
            const LAS unsigned char* va = vb_ + r32 * AV_STRIDE + 2 * (16 * sl + 4 * hi);
            const v2u x0 = *(const LAS v2u*)va, x1 = *(const LAS v2u*)(va + 16), y0 = *(const LAS v2u*)(va + 32 * AV_STRIDE), y1 = *(const LAS v2u*)(va + 32 * AV_STRIDE + 16);
            const bf16x8 pbf = __builtin_bit_cast(bf16x8, pb[sl]);
            o0 = MFMA32(__builtin_bit_cast(bf16x8, ((v4u){x0.x, x0.y, x1.x, x1.y})), pbf, o0);
            o1 = MFMA32(__builtin_bit_cast(bf16x8, ((v4u){y0.x, y0.y, y1.x, y1.y})), pbf, o1); }
        if (t + 1 < 64) { LAS unsigned char* kn = lds + nxt * AK_BYTES; LAS unsigned char* vn = lds + nxt * AV_BYTES;
            *(LAS v4u*)(kn + kl0) = sk0; if (tid < 256) *(LAS v4u*)(kn + kl1) = sk1;
            *(LAS v2u*)(vn + vl) = (v2u){sv.x, sv.y}; *(LAS v2u*)(vn + vl + 8) = (v2u){sv.z, sv.w}; }
        __syncthreads();
    }
    lrun += __shfl_xor(lrun, 32);
    const float inv = 1.f / lrun;
    const int b = bh >> 3, h = bh & 7;
    bf16* op = (bf16*)(F.ws + WS_OA) + ((size_t)b * SEQ + qb * 256 + wid * 32 + r32) * 512 + h * 64;
#pragma unroll
    for (int g4 = 0; g4 < 4; ++g4) {
        *(v2u*)(op + 8 * g4 + 4 * hi) = (v2u){pk2(o0[4 * g4] * inv, o0[4 * g4 + 1] * inv), pk2(o0[4 * g4 + 2] * inv, o0[4 * g4 + 3] * inv)};
        *(v2u*)(op + 32 + 8 * g4 + 4 * hi) = (v2u){pk2(o1[4 * g4] * inv, o1[4 * g4 + 1] * inv), pk2(o1[4 * g4 + 2] * inv, o1[4 * g4 + 3] * inv)}; }
}

constexpr int SC_STEP = 1408, SC_BUF = 32 * SC_STEP, SC_OB = 2 * SC_BUF;
__device__ __forceinline__ float ffma_s(float a, float b, float c) { float d; asm("v_fma_f32 %0, %1, %2, %3" : "=v"(d) : "v"(a), "v"(b), "v"(c)); return d; }
__device__ __forceinline__ float fmul_s(float a, float b) { float d; asm("v_mul_f32_e32 %0, %1, %2" : "=v"(d) : "v"(a), "v"(b)); return d; }
__device__ __forceinline__ void scan_item(Frame& F, int item) {
    const int b = item >> 5, h = (item >> 2) & 7, dir = (item >> 1) & 1, half = item & 1;
    const int tid = F.tid, lane = F.lane, wid = F.wave;
    LAS unsigned char* lds = F.lds;
    const bf16* RKV = (const bf16*)(F.ws + WS_RKV); const bf16* ASIG = (const bf16*)(F.ws + WS_ASIG);
    const bf16* DEC = (const bf16*)(F.ws + (dir ? WS_DECB : WS_DECF)); bf16* OUT = (bf16*)(F.ws + (dir ? WS_OB : WS_OF));
    const bool loader = wid >= 4;
    const int lt = tid - 256, lj = lt >> 3, lg = lt & 7;
    float kk8[8], ka8[8];
    if (loader) {
#pragma unroll
        for (int i = 0; i < 8; ++i) { kk8[i] = F.in[19][h * 64 + 8 * lg + i]; ka8[i] = F.in[20][h * 64 + 8 * lg + i]; } }
    auto tok = [&](int c, int j) { const int s = dir ? (SEQ - 1 - (32 * c + j)) : (32 * c + j); return b * SEQ + s; };
    v4u g_r8, g_k8, g_a8, g_w8, g_v8 = {0u, 0u, 0u, 0u};
    auto issue_chunk = [&](int c) {
        const size_t m = (size_t)tok(c, lj); const int col = h * 64 + 8 * lg;
        g_r8 = *(const v4u*)(RKV + m * 1536 + col); g_k8 = *(const v4u*)(RKV + m * 1536 + 512 + col); g_a8 = *(const v4u*)(ASIG + m * 512 + col); g_w8 = *(const v4u*)(DEC + m * 512 + col);
        if (lg < 4) g_v8 = *(const v4u*)(RKV + m * 1536 + 1024 + h * 64 + half * 32 + 8 * lg);
    };
    auto commit_chunk = [&](int bufi) {
        f32x4 r0, r1, k0, k1, a0, a1, w0, w1; unpack8(g_r8, r0, r1); unpack8(g_k8, k0, k1); unpack8(g_a8, a0, a1); unpack8(g_w8, w0, w1);
        float kf[8], ss = 0.f;
#pragma unroll
        for (int i = 0; i < 4; ++i) { kf[i] = k0[i] * kk8[i]; kf[4 + i] = k1[i] * kk8[4 + i]; }
#pragma unroll
        for (int i = 0; i < 8; ++i) ss += kf[i] * kf[i];
        ss = red8(ss);
        const float inv = 1.f / fmaxf(sqrtf(ss), 1e-12f);
        f32x4 na0, na1, bb0, bb1, kp0, kp1, d0, d1;
#pragma unroll
        for (int i = 0; i < 4; ++i) { const float q0 = kf[i] * inv, q1 = kf[4 + i] * inv; na0[i] = -q0; na1[i] = -q1; bb0[i] = q0 * a0[i]; bb1[i] = q1 * a1[i];
            kp0[i] = k0[i] * (1.f + (a0[i] - 1.f) * ka8[i]); kp1[i] = k1[i] * (1.f + (a1[i] - 1.f) * ka8[4 + i]); d0[i] = fexp(w0[i]); d1[i] = fexp(w1[i]); }
        LAS float* sp = (LAS float*)(lds + bufi * SC_BUF + lj * SC_STEP) + 8 * lg;
        *(LAS f32x4*)(sp) = r0; *(LAS f32x4*)(sp + 4) = r1; *(LAS f32x4*)(sp + 64) = d0; *(LAS f32x4*)(sp + 68) = d1; *(LAS f32x4*)(sp + 128) = kp0; *(LAS f32x4*)(sp + 132) = kp1;
        *(LAS f32x4*)(sp + 192) = na0; *(LAS f32x4*)(sp + 196) = na1; *(LAS f32x4*)(sp + 256) = bb0; *(LAS f32x4*)(sp + 260) = bb1;
        if (lg < 4) { f32x4 v0, v1; unpack8(g_v8, v0, v1); *(LAS f32x4*)(sp + 320) = v0; *(LAS f32x4*)(sp + 324) = v1; }
    };
    auto flush_chunk = [&](int c, int bufi) {
        if (lg < 4) { const LAS float* ob = (const LAS float*)(lds + SC_OB + bufi * 4096) + lj * 32 + 8 * lg; const f32x4 x0 = *(const LAS f32x4*)ob, x1 = *(const LAS f32x4*)(ob + 4);
            *(v4u*)(OUT + (size_t)tok(c, lj) * 512 + h * 64 + half * 32 + 8 * lg) = pack8(x0, x1); }
    };
    f32x2 S[4]; S[0] = S[1] = S[2] = S[3] = (f32x2){0.f, 0.f};
    const int rowl = wid * 8 + (lane >> 3), jj = lane & 7;
#define SC_BAR() do { asm volatile("s_waitcnt lgkmcnt(0)" ::: "memory"); __builtin_amdgcn_s_barrier(); asm volatile("" ::: "memory"); } while (0)
    __syncthreads();
    if (loader) { issue_chunk(0); commit_chunk(0); issue_chunk(1); }
    SC_BAR();
    for (int c = 0; c < 128; ++c) {
        if (loader) { if (c + 1 < 128) commit_chunk((c + 1) & 1); if (c + 2 < 128) issue_chunk(c + 2); if (c > 0) flush_chunk(c - 1, (c - 1) & 1); }
        else {
            const LAS float* base = (const LAS float*)(lds + (c & 1) * SC_BUF) + 8 * jj; LAS float* ob = (LAS float*)(lds + SC_OB + (c & 1) * 4096) + rowl;
#define SC_LOAD(X, j) do { const LAS float* p_ = base + (j) * (SC_STEP / 4); \
                X##r0 = *(const LAS f32x4*)p_; X##r1 = *(const LAS f32x4*)(p_ + 4); X##w0 = *(const LAS f32x4*)(p_ + 64); X##w1 = *(const LAS f32x4*)(p_ + 68); X##k0 = *(const LAS f32x4*)(p_ + 128); X##k1 = *(const LAS f32x4*)(p_ + 132); \
                X##a0 = *(const LAS f32x4*)(p_ + 192); X##a1 = *(const LAS f32x4*)(p_ + 196); X##b0 = *(const LAS f32x4*)(p_ + 256); X##b1 = *(const LAS f32x4*)(p_ + 260); X##v = p_[320 - 8 * jj + rowl]; } while (0)
#define SC_COMP(X, j) do { \
                f32x2 t_ = S[0] * (f32x2){X##a0[0], X##a0[1]} + S[1] * (f32x2){X##a0[2], X##a0[3]}; f32x2 t2_ = S[2] * (f32x2){X##a1[0], X##a1[1]} + S[3] * (f32x2){X##a1[2], X##a1[3]}; t_ = t_ + t2_; \
                const float sa_ = red8(t_.x + t_.y); const f32x2 sa2_ = {sa_, sa_}, v2_ = {X##v, X##v}; \
                S[0] = S[0] * (f32x2){X##w0[0], X##w0[1]} + (sa2_ * (f32x2){X##b0[0], X##b0[1]} + v2_ * (f32x2){X##k0[0], X##k0[1]}); \
                S[1] = S[1] * (f32x2){X##w0[2], X##w0[3]} + (sa2_ * (f32x2){X##b0[2], X##b0[3]} + v2_ * (f32x2){X##k0[2], X##k0[3]}); \
                S[2] = S[2] * (f32x2){X##w1[0], X##w1[1]} + (sa2_ * (f32x2){X##b1[0], X##b1[1]} + v2_ * (f32x2){X##k1[0], X##k1[1]}); \
                S[3] = S[3] * (f32x2){X##w1[2], X##w1[3]} + (sa2_ * (f32x2){X##b1[2], X##b1[3]} + v2_ * (f32x2){X##k1[2], X##k1[3]}); \
                f32x2 q_ = S[0] * (f32x2){X##r0[0], X##r0[1]} + S[1] * (f32x2){X##r0[2], X##r0[3]}; f32x2 q2_ = S[2] * (f32x2){X##r1[0], X##r1[1]} + S[3] * (f32x2){X##r1[2], X##r1[3]}; q_ = q_ + q2_; \
                const float o_ = red8(q_.x + q_.y); if (jj == 0) ob[(j) * 32] = o_; } while (0)
            f32x4 Ar0, Ar1, Aw0, Aw1, Ak0, Ak1, Aa0, Aa1, Ab0, Ab1, Br0, Br1, Bw0, Bw1, Bk0, Bk1, Ba0, Ba1, Bb0, Bb1; float Av, Bv;
            SC_LOAD(A, 0);
#pragma unroll 2
            for (int j = 0; j < 32; j += 2) {
                SC_LOAD(B, j + 1);
                __builtin_amdgcn_sched_barrier(0);
                SC_COMP(A, j);
                if (j + 2 < 32) SC_LOAD(A, j + 2);
                __builtin_amdgcn_sched_barrier(0);
                SC_COMP(B, j + 1);
            }
#undef SC_LOAD
#undef SC_COMP
        }
        SC_BAR();
    }
    if (loader) flush_chunk(127, 1);
    __syncthreads();
}

constexpr int FV_STRIDE = 144, FV_BYTES = 64 * FV_STRIDE;
constexpr int FS_STEP = 896;
constexpr int FS_ABUF = 0, FS_SBUF = 45056, FS_SBYTES = 16 * FS_STEP, FS_OBUF = FS_SBUF + 2 * FS_SBYTES, FS_OBYTES = 16 * 256 * 4;
typedef _Float16 h4 __attribute__((ext_vector_type(4)));
template <int HL> __device__ __forceinline__ float mixfma(unsigned h, float s, float c) { float d;
    if (HL) asm("v_fma_mix_f32 %0, %1, %2, %3 op_sel:[1,0,0] op_sel_hi:[1,0,0]" : "=v"(d) : "v"(h), "v"(s), "v"(c));
    else    asm("v_fma_mix_f32 %0, %1, %2, %3 op_sel:[0,0,0] op_sel_hi:[1,0,0]" : "=v"(d) : "v"(h), "v"(s), "v"(c));
    return d; }
template <int HL> __device__ __forceinline__ float mixmul(unsigned h, float s) { float d;
    if (HL) asm("v_fma_mix_f32 %0, %1, %2, 0 op_sel:[1,0,0] op_sel_hi:[1,0,0]" : "=v"(d) : "v"(h), "v"(s));
    else    asm("v_fma_mix_f32 %0, %1, %2, 0 op_sel:[0,0,0] op_sel_hi:[1,0,0]" : "=v"(d) : "v"(h), "v"(s));
    return d; }
__device__ __forceinline__ float red16(float x) { x += dppf<0xB1>(x); x += dppf<0x4E>(x); x += dppf<0x141>(x); x += dppf<0x140>(x); return x; }
template <int MODE  > __device__ __forceinline__ void p4_fused(Frame& F) {
    const int tid = F.tid, lane = F.lane, wid = F.wave, r32 = lane & 31, hi = lane >> 5;
    LAS unsigned char* lds = F.lds;
    const int vb = ((F.bid & 7) << 5) | (F.bid >> 3);
    const int item = vb, sb = item >> 5, sh = (item >> 2) & 7, dir = (item >> 1) & 1, half = item & 1;
    const bf16* RKV = (const bf16*)(F.ws + WS_RKV); const bf16* ASIG = (const bf16*)(F.ws + WS_ASIG);
    const bf16* DEC = (const bf16*)(F.ws + (dir ? WS_DECB : WS_DECF)); bf16* OUT = (bf16*)(F.ws + (dir ? WS_OB : WS_OF));
    const bool loader = wid < 4;
    const int lt = tid & 255, lj = lt >> 4, lg = lt & 15;
    const bool stager = !loader;
    float kk4[4], ka4[4];
    if (stager) {
#pragma unroll
        for (int i = 0; i < 4; ++i) { kk4[i] = F.in[19][sh * 64 + 4 * lg + i]; ka4[i] = F.in[20][sh * 64 + 4 * lg + i]; } }
    auto tok = [&](int c, int j) { const int s = dir ? (SEQ - 1 - (16 * c + j)) : (16 * c + j); return sb * SEQ + s; };
    v2u g_r, g_k, g_a, g_w, g_v = {0u, 0u};
    auto issue_chunk = [&](int c) {
        const size_t m = (size_t)tok(c, lj); const int col = sh * 64 + 4 * lg;
        g_r = *(const v2u*)(RKV + m * 1536 + col); g_k = *(const v2u*)(RKV + m * 1536 + 512 + col); g_a = *(const v2u*)(ASIG + m * 512 + col); g_w = *(const v2u*)(DEC + m * 512 + col);
        if (lg < 8) g_v = *(const v2u*)(RKV + m * 1536 + 1024 + sh * 64 + half * 32 + 4 * lg);
    };
    auto commit_chunk = [&](int bufi) {
        const f32x4 r = {bflo(g_r.x), bfhi(g_r.x), bflo(g_r.y), bfhi(g_r.y)}, k = {bflo(g_k.x), bfhi(g_k.x), bflo(g_k.y), bfhi(g_k.y)},
                    a = {bflo(g_a.x), bfhi(g_a.x), bflo(g_a.y), bfhi(g_a.y)}, w = {bflo(g_w.x), bfhi(g_w.x), bflo(g_w.y), bfhi(g_w.y)};
        float kf[4], ss = 0.f;
#pragma unroll
        for (int i = 0; i < 4; ++i) { kf[i] = k[i] * kk4[i]; ss += kf[i] * kf[i]; }
        ss = red16(ss);
        const float inv = __builtin_amdgcn_rsqf(fmaxf(ss, 1e-24f));
        f32x4 na, bb, kp, d;
#pragma unroll
        for (int i = 0; i < 4; ++i) { const float q = kf[i] * inv; na[i] = -q; bb[i] = q * a[i]; kp[i] = k[i] * (1.f + (a[i] - 1.f) * ka4[i]); d[i] = fexp(w[i]); }
        LAS unsigned char* sp = lds + FS_SBUF + bufi * FS_SBYTES + lj * FS_STEP;
        *(LAS h4*)(sp + 8 * lg) = (h4){(_Float16)r[0], (_Float16)r[1], (_Float16)r[2], (_Float16)r[3]};
        *(LAS h4*)(sp + 128 + 8 * lg) = (h4){(_Float16)kp[0], (_Float16)kp[1], (_Float16)kp[2], (_Float16)kp[3]};
        *(LAS h4*)(sp + 256 + 8 * lg) = (h4){(_Float16)na[0], (_Float16)na[1], (_Float16)na[2], (_Float16)na[3]};
        *(LAS h4*)(sp + 384 + 8 * lg) = (h4){(_Float16)bb[0], (_Float16)bb[1], (_Float16)bb[2], (_Float16)bb[3]};
        *(LAS f32x4*)(sp + 512 + 16 * lg) = d;
        if (lg < 8) *(LAS f32x4*)(sp + 768 + 16 * lg) = (f32x4){bflo(g_v.x), bfhi(g_v.x), bflo(g_v.y), bfhi(g_v.y)};
    };
    auto flush_chunk = [&](int c, int bufi) {
        const LAS float* ob = (const LAS float*)(lds + FS_OBUF + bufi * FS_OBYTES) + lj * 256 + 16 * lg;
        const f32x4 x0 = *(const LAS f32x4*)ob, x1 = *(const LAS f32x4*)(ob + 4), x2 = *(const LAS f32x4*)(ob + 8), x3 = *(const LAS f32x4*)(ob + 12);
        const float ra = ((x0[0] + x0[1]) + (x0[2] + x0[3])) + ((x1[0] + x1[1]) + (x1[2] + x1[3])), rb = ((x2[0] + x2[1]) + (x2[2] + x2[3])) + ((x3[0] + x3[1]) + (x3[2] + x3[3]));
        *(unsigned*)(OUT + (size_t)tok(c, lj) * 512 + sh * 64 + half * 32 + 2 * lg) = pk2(ra, rb);
    };
    float Sx[8];
#pragma unroll
    for (int i = 0; i < 8; ++i) Sx[i] = 0.f;
    const int rowl = (wid & 3) * 8 + (lane >> 3), jj = lane & 7;
    const int at = tid & 255;
    const int qb = vb & 15, bh0 = vb >> 4;
    auto kptr = [&](int ss_) { const int bh = bh0 + 16 * (ss_ >> 6); return (const v4u*)((const bf16*)(F.ws + WS_K) + (size_t)bh * SEQ * 96) + (size_t)(ss_ & 63) * 768; };
    auto vptr = [&](int ss_, int c) { const int bh = bh0 + 16 * (ss_ >> 6); return (const v4u*)((const bf16*)(F.ws + WS_VT) + (size_t)bh * 64 * SEQ + (size_t)(c >> 3) * SEQ + (c & 7) * 8 + (ss_ & 63) * 64); };
    auto klds = [&](int c) { return (c / 12) * AK_STRIDE + (c % 12) * 16; };
    auto vlds = [&](int c) { return AV_OFF + (c >> 3) * FV_STRIDE + ((c & 7) >> 1) * 32 + (c & 1) * 8; };
    v4u sk0, sk1, sk2, sv0, sv1;
    __syncthreads();
    if (loader) {
        if (MODE & 2) {
        const v4u* kg = kptr(0); sk0 = kg[at]; sk1 = kg[at + 256]; sk2 = kg[at + 512]; sv0 = *vptr(0, at); sv1 = *vptr(0, at + 256);
        *(LAS v4u*)(lds + klds(at)) = sk0; *(LAS v4u*)(lds + klds(at + 256)) = sk1; *(LAS v4u*)(lds + klds(at + 512)) = sk2;
        *(LAS v2u*)(lds + vlds(at)) = (v2u){sv0.x, sv0.y}; *(LAS v2u*)(lds + vlds(at) + 16) = (v2u){sv0.z, sv0.w};
        *(LAS v2u*)(lds + vlds(at + 256)) = (v2u){sv1.x, sv1.y}; *(LAS v2u*)(lds + vlds(at + 256) + 16) = (v2u){sv1.z, sv1.w}; }
    }
    if (stager && (MODE & 1)) { issue_chunk(0); commit_chunk(0); issue_chunk(1); }
    SC_BAR();
    if (loader) {
        __builtin_amdgcn_s_setprio(3);
        for (int ss = 0; ss < 256; ++ss) {
            const int cur = ss & 1, nxt = cur ^ 1;
            if ((MODE & 2) && ss + 1 < 256) { const v4u* kgn = kptr(ss + 1); sk0 = kgn[at]; sk1 = kgn[at + 256]; sk2 = kgn[at + 512]; sv0 = *vptr(ss + 1, at); sv1 = *vptr(ss + 1, at + 256); }
            const LAS unsigned char* base = lds + FS_SBUF + cur * FS_SBYTES + 16 * jj; LAS float* ob = (LAS float*)(lds + FS_OBUF + cur * FS_OBYTES) + (tid & 255);
#define SC_LOAD(X, j) do { const LAS unsigned char* p_ = base + (j) * FS_STEP; \
                X##r = *(const LAS v4u*)p_; X##k = *(const LAS v4u*)(p_ + 128); X##a = *(const LAS v4u*)(p_ + 256); X##b = *(const LAS v4u*)(p_ + 384); \
                X##w0 = *(const LAS f32x4*)(p_ + 512 + 16 * jj); X##w1 = *(const LAS f32x4*)(p_ + 528 + 16 * jj); X##v = *(const LAS float*)(p_ + 768 - 16 * jj + 4 * rowl); } while (0)
#define SC_EL(X, i, d, hl, wv) do { float u_ = mixmul<hl>(X##k[d], X##v); u_ = mixfma<hl>(X##b[d], sa_, u_); Sx[i] = fmaf(Sx[i], wv, u_); } while (0)
#define SC_COMP(X, j) do { \
                float t0_ = mixmul<0>(X##a[0], Sx[0]), t1_ = mixmul<1>(X##a[0], Sx[1]); t0_ = mixfma<0>(X##a[1], Sx[2], t0_); t1_ = mixfma<1>(X##a[1], Sx[3], t1_); \
                t0_ = mixfma<0>(X##a[2], Sx[4], t0_); t1_ = mixfma<1>(X##a[2], Sx[5], t1_); t0_ = mixfma<0>(X##a[3], Sx[6], t0_); t1_ = mixfma<1>(X##a[3], Sx[7], t1_); \
                const float sa_ = red8(t0_ + t1_); \
                SC_EL(X, 0, 0, 0, X##w0[0]); SC_EL(X, 1, 0, 1, X##w0[1]); SC_EL(X, 2, 1, 0, X##w0[2]); SC_EL(X, 3, 1, 1, X##w0[3]); \
                SC_EL(X, 4, 2, 0, X##w1[0]); SC_EL(X, 5, 2, 1, X##w1[1]); SC_EL(X, 6, 3, 0, X##w1[2]); SC_EL(X, 7, 3, 1, X##w1[3]); \
                float q0_ = mixmul<0>(X##r[0], Sx[0]), q1_ = mixmul<1>(X##r[0], Sx[1]); q0_ = mixfma<0>(X##r[1], Sx[2], q0_); q1_ = mixfma<1>(X##r[1], Sx[3], q1_); \
                q0_ = mixfma<0>(X##r[2], Sx[4], q0_); q1_ = mixfma<1>(X##r[2], Sx[5], q1_); q0_ = mixfma<0>(X##r[3], Sx[6], q0_); q1_ = mixfma<1>(X##r[3], Sx[7], q1_); \
                ob[(j) * 256] = q0_ + q1_; } while (0)
            v4u Ar, Ak, Aa, Ab, Br, Bk, Ba, Bb; f32x4 Aw0, Aw1, Bw0, Bw1; float Av, Bv;
            if (MODE & 1) {
            SC_LOAD(A, 0);
#pragma unroll
            for (int j = 0; j < 16; j += 2) {
                SC_LOAD(B, j + 1);
                __builtin_amdgcn_sched_barrier(0);
                SC_COMP(A, j);
                if (j + 2 < 16) SC_LOAD(A, j + 2);
                __builtin_amdgcn_sched_barrier(0);
                SC_COMP(B, j + 1);
            }
            }
#undef SC_LOAD
#undef SC_EL
#undef SC_COMP
            if ((MODE & 2) && ss + 1 < 256) { LAS unsigned char* kn = lds + nxt * AK_BYTES; LAS unsigned char* vn = lds + nxt * FV_BYTES;
                *(LAS v4u*)(kn + klds(at)) = sk0; *(LAS v4u*)(kn + klds(at + 256)) = sk1; *(LAS v4u*)(kn + klds(at + 512)) = sk2;
                *(LAS v2u*)(vn + vlds(at)) = (v2u){sv0.x, sv0.y}; *(LAS v2u*)(vn + vlds(at) + 16) = (v2u){sv0.z, sv0.w};
                *(LAS v2u*)(vn + vlds(at + 256)) = (v2u){sv1.x, sv1.y}; *(LAS v2u*)(vn + vlds(at + 256) + 16) = (v2u){sv1.z, sv1.w}; }
            SC_BAR();
        }
        __builtin_amdgcn_s_setprio(0);
    } else {
        bf16x8 qf[2][6]; float mrun[2], lrun[2]; f32x16 o0[2], o1[2];
        const int aw = wid - 4;
        for (int ss = 0; ss < 256; ++ss) {
            const int t = ss & 63, bh = bh0 + 16 * (ss >> 6), cur = ss & 1, nxt = cur ^ 1;
            if ((MODE & 1) && ss + 1 < 256) commit_chunk(nxt);
            if ((MODE & 1) && ss + 2 < 256) issue_chunk(ss + 2);
            if ((MODE & 1) && ss > 0) flush_chunk(ss - 1, nxt);
            if (MODE & 2) {
            if (t == 0) {
#pragma unroll
                for (int qq = 0; qq < 2; ++qq) { const bf16* Qp = (const bf16*)(F.ws + WS_Q) + ((size_t)bh * SEQ + qb * 256 + aw * 64 + qq * 32 + r32) * 96;
#pragma unroll
                    for (int d0 = 0; d0 < 6; ++d0) qf[qq][d0] = *(const bf16x8*)(Qp + 16 * d0 + 8 * hi);
                    mrun[qq] = -1e30f; lrun[qq] = 0.f; o0[qq] = (f32x16){}; o1[qq] = (f32x16){}; } }
            const LAS unsigned char* kb_ = lds + cur * AK_BYTES; const LAS unsigned char* vb_ = lds + AV_OFF + cur * FV_BYTES;
#pragma unroll
            for (int qq = 0; qq < 2; ++qq) {
                f32x16 p0, p1;
#pragma unroll
                for (int r = 0; r < 16; ++r) { p0[r] = -8.f; p1[r] = -8.f; }
#pragma unroll
                for (int d0 = 0; d0 < 6; ++d0) {
                    const bf16x8 a0 = *(const LAS bf16x8*)(kb_ + r32 * AK_STRIDE + 32 * d0 + 16 * hi), a1 = *(const LAS bf16x8*)(kb_ + (32 + r32) * AK_STRIDE + 32 * d0 + 16 * hi);
                    p0 = MFMA32(a0, qf[qq][d0], p0); p1 = MFMA32(a1, qf[qq][d0], p1); }
                float ls = 0.f;
#pragma unroll
                for (int r = 0; r < 16; ++r) { p0[r] = __builtin_amdgcn_exp2f(p0[r]); p1[r] = __builtin_amdgcn_exp2f(p1[r]); ls += p0[r] + p1[r]; }
                lrun[qq] += ls;
                v4u pb[4];
                pb[0] = (v4u){pk2(p0[0], p0[1]), pk2(p0[2], p0[3]), pk2(p0[4], p0[5]), pk2(p0[6], p0[7])};
                pb[1] = (v4u){pk2(p0[8], p0[9]), pk2(p0[10], p0[11]), pk2(p0[12], p0[13]), pk2(p0[14], p0[15])};
                pb[2] = (v4u){pk2(p1[0], p1[1]), pk2(p1[2], p1[3]), pk2(p1[4], p1[5]), pk2(p1[6], p1[7])};
                pb[3] = (v4u){pk2(p1[8], p1[9]), pk2(p1[10], p1[11]), pk2(p1[12], p1[13]), pk2(p1[14], p1[15])};
#pragma unroll
                for (int sl = 0; sl < 4; ++sl) {
                    const LAS unsigned char* va = vb_ + r32 * FV_STRIDE + 32 * sl + 16 * hi;
                    const bf16x8 vx = *(const LAS bf16x8*)va, vy = *(const LAS bf16x8*)(va + 32 * FV_STRIDE);
                    const bf16x8 pbf = __builtin_bit_cast(bf16x8, pb[sl]);
                    o0[qq] = MFMA32(vx, pbf, o0[qq]);
                    o1[qq] = MFMA32(vy, pbf, o1[qq]); }
                if (t == 63) {
                    const float lt_ = lrun[qq] + __shfl_xor(lrun[qq], 32);
                    const float inv = 1.f / lt_;
                    bf16* op = (bf16*)(F.ws + WS_OA) + ((size_t)(bh >> 3) * SEQ + qb * 256 + aw * 64 + qq * 32 + r32) * 512 + (bh & 7) * 64;
#pragma unroll
                    for (int g4 = 0; g4 < 4; ++g4) {
                        *(v2u*)(op + 8 * g4 + 4 * hi) = (v2u){pk2(o0[qq][4 * g4] * inv, o0[qq][4 * g4 + 1] * inv), pk2(o0[qq][4 * g4 + 2] * inv, o0[qq][4 * g4 + 3] * inv)};
                        *(v2u*)(op + 32 + 8 * g4 + 4 * hi) = (v2u){pk2(o1[qq][4 * g4] * inv, o1[qq][4 * g4 + 1] * inv), pk2(o1[qq][4 * g4 + 2] * inv, o1[qq][4 * g4 + 3] * inv)}; } }
            }
            }
            SC_BAR();
        }
        if (MODE & 1) flush_chunk(255, 1);
    }
    __syncthreads();
}

template <int MODE> __device__ __forceinline__ void p4_fused2(Frame& F) {
    const int tid = F.tid, lane = F.lane, wid = F.wave, r32 = lane & 31, hi = lane >> 5;
    LAS unsigned char* lds = F.lds;
    const int item = F.bid, sb = item >> 5, sh = (item >> 2) & 7, dir = (item >> 1) & 1, half = item & 1;
    const bf16* RKV = (const bf16*)(F.ws + WS_RKV); const bf16* ASIG = (const bf16*)(F.ws + WS_ASIG);
    const bf16* DEC = (const bf16*)(F.ws + (dir ? WS_DECB : WS_DECF)); bf16* OUT = (bf16*)(F.ws + (dir ? WS_OB : WS_OF));
    const bool isScan = wid < 2, isHelp = (wid == 2) || (wid == 3);
    const int ht = tid & 127, lj = ht >> 3, lg = ht & 7;
    const int qb = F.bid & 15, bh0 = F.bid >> 4;
    auto tok = [&](int c, int j) { const int s = dir ? (SEQ - 1 - (16 * c + j)) : (16 * c + j); return sb * SEQ + s; };
    auto kptr = [&](int ss_) { const int bh = bh0 + 16 * (ss_ >> 6); return (const v4u*)((const bf16*)(F.ws + WS_K) + (size_t)bh * SEQ * 96) + (size_t)(ss_ & 63) * 768; };
    auto vptr = [&](int ss_, int c) { const int bh = bh0 + 16 * (ss_ >> 6); return (const v4u*)((const bf16*)(F.ws + WS_VT) + (size_t)bh * 64 * SEQ + (size_t)(c >> 3) * SEQ + (c & 7) * 8 + (ss_ & 63) * 64); };
    auto klds = [&](int c) { return (c / 12) * AK_STRIDE + (c % 12) * 16; };
    auto vlds = [&](int c) { return AV_OFF + (c >> 3) * AV_STRIDE + (c & 7) * 16; };
    __syncthreads();
    if (isHelp) {
        float kk8[8], ka8[8];
#pragma unroll
        for (int i = 0; i < 8; ++i) { kk8[i] = F.in[19][sh * 64 + 8 * lg + i]; ka8[i] = F.in[20][sh * 64 + 8 * lg + i]; }
        v4u g_r8, g_k8, g_a8, g_w8, g_v8 = {0u, 0u, 0u, 0u};
        v4u sk[6], sv[4];
        auto issue_chunk = [&](int c) {
            const size_t m = (size_t)tok(c, lj); const int col = sh * 64 + 8 * lg;
            g_r8 = *(const v4u*)(RKV + m * 1536 + col); g_k8 = *(const v4u*)(RKV + m * 1536 + 512 + col); g_a8 = *(const v4u*)(ASIG + m * 512 + col); g_w8 = *(const v4u*)(DEC + m * 512 + col);
            if (lg < 4) g_v8 = *(const v4u*)(RKV + m * 1536 + 1024 + sh * 64 + half * 32 + 8 * lg);
        };
        auto commit_chunk = [&](int bufi) {
            f32x4 r0, r1, k0, k1, a0, a1, w0, w1; unpack8(g_r8, r0, r1); unpack8(g_k8, k0, k1); unpack8(g_a8, a0, a1); unpack8(g_w8, w0, w1);
            float kf[8], ss = 0.f;
#pragma unroll
            for (int i = 0; i < 4; ++i) { kf[i] = k0[i] * kk8[i]; kf[4 + i] = k1[i] * kk8[4 + i]; }
#pragma unroll
            for (int i = 0; i < 8; ++i) ss += kf[i] * kf[i];
            ss = red8(ss);
            const float inv = 1.f / fmaxf(sqrtf(ss), 1e-12f);
            f32x4 na0, na1, bb0, bb1, kp0, kp1, d0, d1;
#pragma unroll
            for (int i = 0; i < 4; ++i) { const float q0 = kf[i] * inv, q1 = kf[4 + i] * inv; na0[i] = -q0; na1[i] = -q1; bb0[i] = q0 * a0[i]; bb1[i] = q1 * a1[i];
                kp0[i] = k0[i] * (1.f + (a0[i] - 1.f) * ka8[i]); kp1[i] = k1[i] * (1.f + (a1[i] - 1.f) * ka8[4 + i]); d0[i] = fexp(w0[i]); d1[i] = fexp(w1[i]); }
            LAS float* sp = (LAS float*)(lds + FS_SBUF + bufi * FS_SBYTES + lj * SC_STEP) + 8 * lg;
            *(LAS f32x4*)(sp) = r0; *(LAS f32x4*)(sp + 4) = r1; *(LAS f32x4*)(sp + 64) = d0; *(LAS f32x4*)(sp + 68) = d1; *(LAS f32x4*)(sp + 128) = kp0; *(LAS f32x4*)(sp + 132) = kp1;
            *(LAS f32x4*)(sp + 192) = na0; *(LAS f32x4*)(sp + 196) = na1; *(LAS f32x4*)(sp + 256) = bb0; *(LAS f32x4*)(sp + 260) = bb1;
            if (lg < 4) { f32x4 v0, v1; unpack8(g_v8, v0, v1); *(LAS f32x4*)(sp + 320) = v0; *(LAS f32x4*)(sp + 324) = v1; }
        };
        auto flush_chunk = [&](int c, int bufi) {
            const LAS float* ob = (const LAS float*)(lds + FS_OBUF + bufi * FS_OBYTES) + lj * 256 + 32 * lg;
            float rs[4];
#pragma unroll
            for (int q = 0; q < 4; ++q) { const f32x4 x0 = *(const LAS f32x4*)(ob + 8 * q), x1 = *(const LAS f32x4*)(ob + 8 * q + 4); rs[q] = ((x0[0] + x0[1]) + (x0[2] + x0[3])) + ((x1[0] + x1[1]) + (x1[2] + x1[3])); }
            *(v2u*)(OUT + (size_t)tok(c, lj) * 512 + sh * 64 + half * 32 + 4 * lg) = (v2u){pk2(rs[0], rs[1]), pk2(rs[2], rs[3])};
        };
        auto kv_issue = [&](int ss_) { const v4u* kg = kptr(ss_);
#pragma unroll
            for (int i = 0; i < 6; ++i) sk[i] = kg[ht + 128 * i];
#pragma unroll
            for (int i = 0; i < 4; ++i) sv[i] = *vptr(ss_, ht + 128 * i); };
        auto kv_commit = [&](int bufi) { LAS unsigned char* kn = lds + bufi * AK_BYTES; LAS unsigned char* vn = lds + bufi * AV_BYTES;
#pragma unroll
            for (int i = 0; i < 6; ++i) *(LAS v4u*)(kn + klds(ht + 128 * i)) = sk[i];
#pragma unroll
            for (int i = 0; i < 4; ++i) { *(LAS v2u*)(vn + vlds(ht + 128 * i)) = (v2u){sv[i].x, sv[i].y}; *(LAS v2u*)(vn + vlds(ht + 128 * i) + 8) = (v2u){sv[i].z, sv[i].w}; } };
        if (MODE & 2) { kv_issue(0); kv_commit(0); }
        if (MODE & 1) { issue_chunk(0); commit_chunk(0); issue_chunk(1); }
        SC_BAR();
        for (int ss = 0; ss < 256; ++ss) {
            const int nxt = (ss & 1) ^ 1;
            if ((MODE & 2) && ss + 1 < 256) kv_issue(ss + 1);
            if ((MODE & 1) && ss + 1 < 256) commit_chunk(nxt);
            if ((MODE & 1) && ss + 2 < 256) issue_chunk(ss + 2);
            if ((MODE & 1) && ss > 0) flush_chunk(ss - 1, nxt);
            if ((MODE & 2) && ss + 1 < 256) kv_commit(nxt);
            SC_BAR();
        }
        if (MODE & 1) flush_chunk(255, 1);
    } else if (isScan) {
        __builtin_amdgcn_s_setprio(3);
        f32x2 SA[4], SB[4];
#pragma unroll
        for (int i = 0; i < 4; ++i) { SA[i] = (f32x2){0.f, 0.f}; SB[i] = (f32x2){0.f, 0.f}; }
        const int jj = lane & 7, rowA = wid * 16 + (lane >> 3), rowB = rowA + 8;
        SC_BAR();
        for (int ss = 0; ss < 256; ++ss) {
            const int cur = ss & 1;
            if (MODE & 1) {
            const LAS float* base = (const LAS float*)(lds + FS_SBUF + cur * FS_SBYTES) + 8 * jj; LAS float* ob = (LAS float*)(lds + FS_OBUF + cur * FS_OBYTES) + wid * 128 + lane;
#define SC_LOAD(X, j) do { const LAS float* p_ = base + (j) * (SC_STEP / 4); \
                X##r0 = *(const LAS f32x4*)p_; X##r1 = *(const LAS f32x4*)(p_ + 4); X##w0 = *(const LAS f32x4*)(p_ + 64); X##w1 = *(const LAS f32x4*)(p_ + 68); X##k0 = *(const LAS f32x4*)(p_ + 128); X##k1 = *(const LAS f32x4*)(p_ + 132); \
                X##a0 = *(const LAS f32x4*)(p_ + 192); X##a1 = *(const LAS f32x4*)(p_ + 196); X##b0 = *(const LAS f32x4*)(p_ + 256); X##b1 = *(const LAS f32x4*)(p_ + 260); \
                X##va = p_[320 - 8 * jj + rowA]; X##vb = p_[320 - 8 * jj + rowB]; } while (0)
#define SC_ROW(S, X, vv, oidx) do { \
                f32x2 t_ = S[0] * (f32x2){X##a0[0], X##a0[1]} + S[1] * (f32x2){X##a0[2], X##a0[3]}; f32x2 t2_ = S[2] * (f32x2){X##a1[0], X##a1[1]} + S[3] * (f32x2){X##a1[2], X##a1[3]}; t_ = t_ + t2_; \
                const float sa_ = red8(t_.x + t_.y); const f32x2 sa2_ = {sa_, sa_}, v2_ = {vv, vv}; \
                S[0] = S[0] * (f32x2){X##w0[0], X##w0[1]} + (sa2_ * (f32x2){X##b0[0], X##b0[1]} + v2_ * (f32x2){X##k0[0], X##k0[1]}); \
                S[1] = S[1] * (f32x2){X##w0[2], X##w0[3]} + (sa2_ * (f32x2){X##b0[2], X##b0[3]} + v2_ * (f32x2){X##k0[2], X##k0[3]}); \
                S[2] = S[2] * (f32x2){X##w1[0], X##w1[1]} + (sa2_ * (f32x2){X##b1[0], X##b1[1]} + v2_ * (f32x2){X##k1[0], X##k1[1]}); \
                S[3] = S[3] * (f32x2){X##w1[2], X##w1[3]} + (sa2_ * (f32x2){X##b1[2], X##b1[3]} + v2_ * (f32x2){X##k1[2], X##k1[3]}); \
                f32x2 q_ = S[0] * (f32x2){X##r0[0], X##r0[1]} + S[1] * (f32x2){X##r0[2], X##r0[3]}; f32x2 q2_ = S[2] * (f32x2){X##r1[0], X##r1[1]} + S[3] * (f32x2){X##r1[2], X##r1[3]}; q_ = q_ + q2_; \
                ob[(oidx)] = q_.x + q_.y; } while (0)
#define SC_COMP(X, j) do { SC_ROW(SA, X, X##va, (j) * 256); SC_ROW(SB, X, X##vb, (j) * 256 + 64); } while (0)
            f32x4 Ar0, Ar1, Aw0, Aw1, Ak0, Ak1, Aa0, Aa1, Ab0, Ab1, Br0, Br1, Bw0, Bw1, Bk0, Bk1, Ba0, Ba1, Bb0, Bb1; float Ava, Avb, Bva, Bvb;
            SC_LOAD(A, 0);
#pragma unroll
            for (int j = 0; j < 16; j += 2) {
                SC_LOAD(B, j + 1);
                __builtin_amdgcn_sched_barrier(0);
                SC_COMP(A, j);
                if (j + 2 < 16) SC_LOAD(A, j + 2);
                __builtin_amdgcn_sched_barrier(0);
                SC_COMP(B, j + 1);
            }
#undef SC_LOAD
#undef SC_ROW
#undef SC_COMP
            }
            SC_BAR();
        }
        __builtin_amdgcn_s_setprio(0);
    } else {
        SC_BAR();
        bf16x8 qf[2][6]; float mrun[2], lrun[2]; f32x16 o0[2], o1[2];
        const int aw = wid - 4;
        for (int ss = 0; ss < 256; ++ss) {
            const int t = ss & 63, bh = bh0 + 16 * (ss >> 6), cur = ss & 1;
            if (MODE & 2) {
            if (t == 0) {
#pragma unroll
                for (int qq = 0; qq < 2; ++qq) { const bf16* Qp = (const bf16*)(F.ws + WS_Q) + ((size_t)bh * SEQ + qb * 256 + aw * 64 + qq * 32 + r32) * 96;
#pragma unroll
                    for (int d0 = 0; d0 < 6; ++d0) qf[qq][d0] = *(const bf16x8*)(Qp + 16 * d0 + 8 * hi);
                    mrun[qq] = -1e30f; lrun[qq] = 0.f; o0[qq] = (f32x16){}; o1[qq] = (f32x16){}; } }
            const LAS unsigned char* kb_ = lds + cur * AK_BYTES; const LAS unsigned char* vb_ = lds + AV_OFF + cur * AV_BYTES;
#pragma unroll
            for (int qq = 0; qq < 2; ++qq) {
                f32x16 p0, p1;
#pragma unroll
                for (int r = 0; r < 16; ++r) { p0[r] = -8.f; p1[r] = -8.f; }
#pragma unroll
                for (int d0 = 0; d0 < 6; ++d0) {
                    const bf16x8 a0 = *(const LAS bf16x8*)(kb_ + r32 * AK_STRIDE + 32 * d0 + 16 * hi), a1 = *(const LAS bf16x8*)(kb_ + (32 + r32) * AK_STRIDE + 32 * d0 + 16 * hi);
                    p0 = MFMA32(a0, qf[qq][d0], p0); p1 = MFMA32(a1, qf[qq][d0], p1); }
                float ls = 0.f;
#pragma unroll
                for (int r = 0; r < 16; ++r) { p0[r] = __builtin_amdgcn_exp2f(p0[r]); p1[r] = __builtin_amdgcn_exp2f(p1[r]); ls += p0[r] + p1[r]; }
                lrun[qq] += ls;
                v4u pb[4];
                pb[0] = (v4u){pk2(p0[0], p0[1]), pk2(p0[2], p0[3]), pk2(p0[4], p0[5]), pk2(p0[6], p0[7])};
                pb[1] = (v4u){pk2(p0[8], p0[9]), pk2(p0[10], p0[11]), pk2(p0[12], p0[13]), pk2(p0[14], p0[15])};
                pb[2] = (v4u){pk2(p1[0], p1[1]), pk2(p1[2], p1[3]), pk2(p1[4], p1[5]), pk2(p1[6], p1[7])};
                pb[3] = (v4u){pk2(p1[8], p1[9]), pk2(p1[10], p1[11]), pk2(p1[12], p1[13]), pk2(p1[14], p1[15])};
#pragma unroll
                for (int sl = 0; sl < 4; ++sl) {
                    const LAS unsigned char* va = vb_ + r32 * AV_STRIDE + 2 * (16 * sl + 4 * hi);
                    const v2u x0 = *(const LAS v2u*)va, x1 = *(const LAS v2u*)(va + 16), y0 = *(const LAS v2u*)(va + 32 * AV_STRIDE), y1 = *(const LAS v2u*)(va + 32 * AV_STRIDE + 16);
                    const bf16x8 pbf = __builtin_bit_cast(bf16x8, pb[sl]);
                    o0[qq] = MFMA32(__builtin_bit_cast(bf16x8, ((v4u){x0.x, x0.y, x1.x, x1.y})), pbf, o0[qq]);
                    o1[qq] = MFMA32(__builtin_bit_cast(bf16x8, ((v4u){y0.x, y0.y, y1.x, y1.y})), pbf, o1[qq]); }
                if (t == 63) {
                    const float lt_ = lrun[qq] + __shfl_xor(lrun[qq], 32);
                    const float inv = 1.f / lt_;
                    bf16* op = (bf16*)(F.ws + WS_OA) + ((size_t)(bh >> 3) * SEQ + qb * 256 + aw * 64 + qq * 32 + r32) * 512 + (bh & 7) * 64;
#pragma unroll
                    for (int g4 = 0; g4 < 4; ++g4) {
                        *(v2u*)(op + 8 * g4 + 4 * hi) = (v2u){pk2(o0[qq][4 * g4] * inv, o0[qq][4 * g4 + 1] * inv), pk2(o0[qq][4 * g4 + 2] * inv, o0[qq][4 * g4 + 3] * inv)};
                        *(v2u*)(op + 32 + 8 * g4 + 4 * hi) = (v2u){pk2(o1[qq][4 * g4] * inv, o1[qq][4 * g4 + 1] * inv), pk2(o1[qq][4 * g4 + 2] * inv, o1[qq][4 * g4 + 3] * inv)}; } }
            }
            }
            SC_BAR();
        }
    }
    __syncthreads();
}

#define XB_TMO      128
#define XB_XCNT(j)  (256  + 64 * (j))
#define XB_XSUB(j)  (1280 + 64 * (j))
#define XB_XGEN(j)  (2304 + 64 * (j))
#define XB_TOP      3328
#define XB_TOPGEN   3392
#define XCD_BAR_WORDS 3456
#define XB_SPIN_CAP (1u << 18)

__device__ __forceinline__ unsigned xb_ld(unsigned* p)              { return __hip_atomic_load(p, __ATOMIC_RELAXED, __HIP_MEMORY_SCOPE_AGENT); }
__device__ __forceinline__ unsigned xb_add(unsigned* p, unsigned v) { return __hip_atomic_fetch_add(p, v, __ATOMIC_RELAXED, __HIP_MEMORY_SCOPE_AGENT); }
__device__ __forceinline__ unsigned xb_xcc_id() { return (unsigned)__builtin_amdgcn_s_getreg((3 << 11) | 20) & 0xFu; }
#define XB_SPIN(cond, bar) do { unsigned _sp = 0; while (cond) { __builtin_amdgcn_s_sleep(1); \
    if ((++_sp & 255u) == 0u) { if (xb_ld(&(bar)[XB_TMO])) break; if (_sp > XB_SPIN_CAP) { atomicAdd(&(bar)[XB_TMO], 1u); break; } } } } while (0)

struct XcdBarrier {
    unsigned* bar; unsigned x;
    volatile LAS unsigned* st;
};

__device__ __forceinline__ XcdBarrier xcd_barrier_post(unsigned* bar, volatile LAS unsigned* st) {
    XcdBarrier b; b.bar = bar; b.x = xb_xcc_id(); b.st = st;
    if (threadIdx.x == 0) (void)xb_add(&bar[XB_XCNT(b.x)], 1u);
    return b;
}
__device__ __forceinline__ void xcd_barrier_complete(unsigned* bar, unsigned x, unsigned& nloc, unsigned& nx) {
    const unsigned G = gridDim.x * gridDim.y * gridDim.z;
    unsigned sum, cnt, mine, sp = 0u;
    for (;;) {
        sum = 0u; cnt = 0u; mine = 0u;
#pragma unroll
        for (unsigned j = 0; j < 16; ++j) { const unsigned c = xb_ld(&bar[XB_XCNT(j)]); sum += c; cnt += (c > 0u) ? 1u : 0u; mine = (j == x) ? c : mine; }
        if (sum == G) break;
        __builtin_amdgcn_s_sleep(1);
        if ((++sp & 255u) == 0u) { if (xb_ld(&bar[XB_TMO])) break; if (sp > XB_SPIN_CAP) { atomicAdd(&bar[XB_TMO], 1u); break; } }
    }
    nloc = mine > 0u ? mine : 1u; nx = cnt > 0u ? cnt : 1u;
}

__device__ __forceinline__ void xcd_barrier(const XcdBarrier& b) {
    asm volatile("s_waitcnt vmcnt(0)" ::: "memory");
    __syncthreads();
    if (threadIdx.x == 0) {
        unsigned* bar = b.bar;
        __builtin_amdgcn_s_waitcnt(0);
        unsigned nloc = b.st[0], nx = b.st[1];
        if (nloc == 0u) { xcd_barrier_complete(bar, b.x, nloc, nx); b.st[0] = nloc; b.st[1] = nx; }
        const unsigned old = xb_add(&bar[XB_XSUB(b.x)], 1u);
        const unsigned gen = old / nloc;
        if (old + 1u == (gen + 1u) * nloc) {
            __builtin_amdgcn_fence(__ATOMIC_RELEASE, "agent");
            asm volatile("s_waitcnt vmcnt(0)" ::: "memory");
            const unsigned og = xb_add(&bar[XB_TOP], 1u);
            const unsigned tg = og / nx;
            if (og + 1u == (tg + 1u) * nx) xb_add(&bar[XB_TOPGEN], 1u);
            else XB_SPIN(xb_ld(&bar[XB_TOPGEN]) == tg, bar);
            __builtin_amdgcn_fence(__ATOMIC_ACQUIRE, "agent");
            xb_add(&bar[XB_XGEN(b.x)], 1u);
            asm volatile("s_waitcnt vmcnt(0)" ::: "memory");
        } else {
            XB_SPIN(xb_ld(&bar[XB_XGEN(b.x)]) == gen, bar);
            __builtin_amdgcn_fence(__ATOMIC_ACQUIRE, "agent");
            asm volatile("s_waitcnt vmcnt(0)" ::: "memory");
        }
    }
    __syncthreads();
}

constexpr int N_PHASES = 13;
__global__ void __launch_bounds__(512, 2) fwd_kernel(Args args) {
    extern __shared__ __attribute__((aligned(16))) unsigned char lds_raw[];
    cg::grid_group grid = cg::this_grid();
    Frame F;
    F.lds = (LAS unsigned char*)lds_raw;
    F.tid = threadIdx.x; F.lane = F.tid & 63; F.wave = __builtin_amdgcn_readfirstlane(F.tid >> 6); F.G = gridDim.x; F.bid = blockIdx.x;
#pragma unroll
    for (int i = 0; i < 32; ++i) F.in[i] = args.in[i];
    F.out = args.out; F.ws = args.ws;
    unsigned char* ws = args.ws;
    const int lo = args.ph_lo, hi = args.ph_hi;
#ifndef SKIPMASK
#define SKIPMASK 0
#endif
#define IN(k) (lo <= (k) && (k) < hi && !((SKIPMASK >> (k)) & 1))
    volatile LAS unsigned* xst = (volatile LAS unsigned*)(F.lds + 131072 + 64);
    if (F.tid == 0) { xst[0] = 0u; xst[1] = 0u; }
    __syncthreads();
    if (args.ph_hi < 0) grid.sync();
    const XcdBarrier xbar = xcd_barrier_post((unsigned*)ws, xst);
#define SEAM(k) do { if (IN(k) && IN((k) + 1)) { xcd_barrier(xbar); } } while (0)
#ifndef REPMASK
#define REPMASK 0
#endif
#define REP(k) for (int rep_ = 0; rep_ < 1 + ((REPMASK >> (k)) & 1); ++rep_)
    bf16* PG = (bf16*)F.out;
    if (IN(0)) REP(0) { p0_prologue(F); } SEAM(0);
    if (IN(1)) { run_gemm(F, (const bf16*)(ws + WS_XN), 1024, (const bf16*)(ws + WS_WIN), 1024, 4608, 1024, FnIn{PG, (bf16*)(ws + WS_PR), (bf16*)(ws + WS_PM), F.in[4]});
#ifdef DUP1
        run_gemm(F, (const bf16*)(ws + WS_XN), 1024, (const bf16*)(ws + WS_WIN), 1024, 4608, 1024, FnIn{PG, (bf16*)(ws + WS_PR), (bf16*)(ws + WS_PM), F.in[4]});
#endif
    } SEAM(1);
    if (IN(2)) REP(2) { if (!((SKIPMASK >> 13) & 1)) p2_shift(F); } SEAM(2);
    if (IN(3)) {
        if (!((SKIPMASK >> 14) & 1)) for (int it = (F.G == 256) ? (((F.bid & 7) << 5) | (F.bid >> 3)) : F.bid; it < 256; it += F.G) mla_item(F, it);
        run_gemm(F, (const bf16*)(ws + WS_LI), 256, (const bf16*)(ws + WS_WL1), 128, 1024, 128, FnLora1{(bf16*)(ws + WS_ASIG), (bf16*)(ws + WS_DECF), F.in[16], F.in[14]});
        run_gemm(F, (const bf16*)(ws + WS_LI) + 128, 256, (const bf16*)(ws + WS_WL2), 128, 512, 128, FnLora2{(bf16*)(ws + WS_DECB), F.in[14] + 512});

#ifdef DUP3
#if DUP3 & 1
        if (!((SKIPMASK >> 14) & 1)) for (int it = (F.G == 256) ? (((F.bid & 7) << 5) | (F.bid >> 3)) : F.bid; it < 256; it += F.G) mla_item(F, it);
#endif
#if DUP3 & 2
        run_gemm(F, (const bf16*)(ws + WS_LI), 256, (const bf16*)(ws + WS_WL1), 128, 1024, 128, FnLora1{(bf16*)(ws + WS_ASIG), (bf16*)(ws + WS_DECF), F.in[16], F.in[14]});
        run_gemm(F, (const bf16*)(ws + WS_LI) + 128, 256, (const bf16*)(ws + WS_WL2), 128, 512, 128, FnLora2{(bf16*)(ws + WS_DECB), F.in[14] + 512});


#endif
#endif
    } SEAM(3);
    if (IN(4)) {
#ifndef REP_SCAN
#define REP_SCAN 1
#endif
#ifndef REP_ATTN
#define REP_ATTN 1
#endif
#ifndef P4FORM
#define P4FORM 1
#endif
        if (F.G == 256) { if (P4FORM == 2) p4_fused2<3>(F); else p4_fused<3>(F);
#ifdef DUP4
            if (P4FORM == 2) p4_fused2<DUP4>(F); else p4_fused<DUP4>(F);
#endif
        }
        else {
        for (int rep = 0; rep < REP_SCAN; ++rep) for (int it = F.bid; it < 256; it += F.G) scan_item(F, it);
        for (int rep = 0; rep < REP_ATTN; ++rep) for (int u = F.bid; u < 1024; u += F.G) attn_unit(F, u >> 4, u & 15);
        }
    } SEAM(4);
    if (IN(5)) { p5_gn(F); } SEAM(5);
    if (IN(6)) {
        run_gemm(F, (const bf16*)(ws + WS_SG), 256, (const bf16*)(ws + WS_WGF), 128, 512, 128, FnMulAcc<0>{(bf16*)(ws + WS_OBC), 512, (const bf16*)(ws + WS_OF), 512, 0});
        run_gemm(F, (const bf16*)(ws + WS_SG) + 128, 256, (const bf16*)(ws + WS_WGB), 128, 512, 128, FnMulAcc<1>{(bf16*)(ws + WS_OBC), 512, (const bf16*)(ws + WS_OB), 512, 0});

#ifdef DUP67

        run_gemm(F, (const bf16*)(ws + WS_SG), 256, (const bf16*)(ws + WS_WGF), 128, 512, 128, FnMulAcc<0>{(bf16*)(ws + WS_OBC), 512, (const bf16*)(ws + WS_OF), 512, 0});
        run_gemm(F, (const bf16*)(ws + WS_SG) + 128, 256, (const bf16*)(ws + WS_WGB), 128, 512, 128, FnMulAcc<1>{(bf16*)(ws + WS_OBC), 512, (const bf16*)(ws + WS_OB), 512, 0});

#endif
    } SEAM(6);
    if (IN(7)) {
        run_gemm(F, (const bf16*)(ws + WS_OA), 512, (const bf16*)(ws + WS_WO), 1024, 1024, 512, FnMulAcc<0>{(bf16*)(ws + WS_M), 1024, PG, 2048, 0});
        run_gemm(F, (const bf16*)(ws + WS_OBC), 512, (const bf16*)(ws + WS_WO) + 512, 1024, 1024, 512, FnMulAcc<1>{(bf16*)(ws + WS_M), 1024, PG, 2048, 1024});

#ifdef DUP67

        run_gemm(F, (const bf16*)(ws + WS_OA), 512, (const bf16*)(ws + WS_WO), 1024, 1024, 512, FnMulAcc<0>{(bf16*)(ws + WS_M), 1024, PG, 2048, 0});
        run_gemm(F, (const bf16*)(ws + WS_OBC), 512, (const bf16*)(ws + WS_WO) + 512, 1024, 1024, 512, FnMulAcc<1>{(bf16*)(ws + WS_M), 1024, PG, 2048, 1024});

#endif
    } SEAM(7);
    if (IN(8)) { run_gemm(F, (const bf16*)(ws + WS_M), 1024, (const bf16*)(ws + WS_WM), 1024, 1024, 1024, FnResidNorm{F.in[0], F.out, (bf16*)(ws + WS_XN), (float*)(ws + WS_RSQ)}); } SEAM(8);
    if (IN(10)) { run_gemm(F, (const bf16*)(ws + WS_XN), 1024, (const bf16*)(ws + WS_WGU), 1024, 2816, 1024, FnStoreScaled{(bf16*)(ws + WS_GU), 2816, (const float*)(ws + WS_RSQ)});
#ifdef DUP10
        run_gemm(F, (const bf16*)(ws + WS_XN), 1024, (const bf16*)(ws + WS_WGU), 1024, 2816, 1024, FnStoreScaled{(bf16*)(ws + WS_GU), 2816, (const float*)(ws + WS_RSQ)});
#endif
    } SEAM(10);
    if (IN(11)) { run_gemm(F, (const bf16*)(ws + WS_XN), 1024, (const bf16*)(ws + WS_WGU) + (size_t)2816 * 1024, 1024, 2816, 1024, FnConvAct{(const bf16*)(ws + WS_GU), (bf16*)(ws + WS_ACT), F.in[29], F.in[30], (const float*)(ws + WS_RSQ)}); } SEAM(11);
    if (IN(12)) { run_gemm(F, (const bf16*)(ws + WS_ACT), 2816, (const bf16*)(ws + WS_WD), 2816, 1024, 2816, FnResidBf{(const bf16*)(ws + WS_XN), F.out}); }
#ifdef XSYNC
    for (int i = 0; i < XSYNC; ++i) xcd_barrier(xbar);
#endif
#undef IN
#undef SEAM
}

#ifndef MK_PER_PHASE
#define MK_PER_PHASE 0
#endif
extern "C" void kernel_launch(void* const* d_in, const int* in_sizes, int n_in, void* d_out, int out_size, void* d_ws, size_t ws_size, hipStream_t stream) {
    static int grid = 0;
    if (grid == 0) {
        if (n_in != 32 || out_size != NTOK * DM || ws_size < WS_END) { fprintf(stderr, "kernel_launch: unexpected problem (n_in %d out %d ws %zu)\n", n_in, out_size, ws_size); grid = -1; return; }
        int dev = 0, cus = 0, per_cu = 0;
        hipGetDevice(&dev); hipDeviceGetAttribute(&cus, hipDeviceAttributeMultiprocessorCount, dev);
        hipFuncSetAttribute((const void*)fwd_kernel, hipFuncAttributeMaxDynamicSharedMemorySize, LDS_BYTES);
        if (hipOccupancyMaxActiveBlocksPerMultiprocessor(&per_cu, (const void*)fwd_kernel, 512, LDS_BYTES) != hipSuccess || per_cu < 1) per_cu = 1;
        (void)hipGetLastError();
        grid = cus * per_cu;
    }
    if (grid < 0) return;
    Args a{};
    for (int i = 0; i < 32; ++i) a.in[i] = (const float*)d_in[i];
    a.out = (float*)d_out; a.ws = (unsigned char*)d_ws;
    if (hipMemsetAsync(d_ws, 0, 16384, stream) != hipSuccess) { fprintf(stderr, "kernel_launch: memset of the barrier word failed\n"); return; }
    void* params[] = {&a};
#if MK_PER_PHASE
    for (int p = 0; p < N_PHASES; ++p) { a.ph_lo = p; a.ph_hi = p + 1;
        hipError_t e = hipLaunchCooperativeKernel((void*)fwd_kernel, dim3(grid), dim3(512), params, LDS_BYTES, stream);
        if (e != hipSuccess) { fprintf(stderr, "launch %d failed: %s\n", p, hipGetErrorString(e)); break; } }
#else
    a.ph_lo = 0; a.ph_hi = N_PHASES;
    hipError_t e = hipLaunchCooperativeKernel((void*)fwd_kernel, dim3(grid), dim3(512), params, LDS_BYTES, stream);
    if (e != hipSuccess) fprintf(stderr, "cooperative launch failed: %s (grid %d)\n", hipGetErrorString(e), grid);
#endif
}
```
